# Optimizing an MI355X kernel written in HIP

```python
import functools
import jax, jax.numpy as jnp
from jax import lax
import numpy as np

D_MODEL = 1024
BATCH = 4
SEQ = 8192
DEPTH = 1

GRID_W = 64
CTX_LEN = 256
D_CONV = 1024
CONV_W = 3
D_LRU = 1024
LRU_BLOCKS = 16
LRU_BLOCK_W = D_LRU // LRU_BLOCKS
LRU_CONV_W = 4
LRU_C = 8.0
N_BRANCH = 2
N_EXPERTS = 32
TOP_K = 4
D_EXPERT = 1024
SWIGLU_LIMIT = 7.0
SWIGLU_ALPHA = 1.702
MOE_BLOCK = 512
N_MOD = 6
EPS = 1e-6
IN_COLS = 3 * D_CONV + 2 * D_LRU + N_BRANCH * D_MODEL
SPLIT_AT = (D_CONV, 2 * D_CONV, 3 * D_CONV, 3 * D_CONV + D_LRU, 3 * D_CONV + 2 * D_LRU,
            3 * D_CONV + 2 * D_LRU + D_MODEL)

kernel_name = "hybrid_conv_rglru_moe_diffusion_block"


def rmsnorm(x, g):
    xf = x.astype(jnp.float32)
    y = xf * lax.rsqrt(jnp.mean(xf * xf, axis=-1, keepdims=True) + EPS)
    return (y * g.astype(jnp.float32)).astype(x.dtype)


def modulate(h, shift, scale):
    return h * (1 + scale) + shift


def adaln_params(silu_cond, w, b):
    m = silu_cond @ w + b
    m = m.reshape(m.shape[0], 1, N_MOD, D_MODEL)
    return tuple(m[:, :, i] for i in range(N_MOD))


def seq_conv3(u, w):
    L = u.shape[1]
    up = jnp.pad(u, ((0, 0), (1, 1), (0, 0)))
    return sum(w[k] * up[:, k:k + L] for k in range(CONV_W))


def grid_conv3(u, w, rows):
    B_, L, C = u.shape
    half = C // 2
    g = u.reshape(B_, rows, GRID_W, C)
    gh = jnp.pad(g[..., :half], ((0, 0), (0, 0), (1, 1), (0, 0)))
    gv = jnp.pad(g[..., half:], ((0, 0), (1, 1), (0, 0), (0, 0)))
    yh = sum(w[k, :half] * gh[:, :, k:k + GRID_W] for k in range(CONV_W))
    yv = sum(w[k, half:] * gv[:, k:k + rows] for k in range(CONV_W))
    return jnp.concatenate([yh, yv], axis=-1).reshape(B_, L, C)


def directional_conv4(u, w, b, reverse):
    L = u.shape[1]
    k = LRU_CONV_W
    if reverse:
        up = jnp.pad(u, ((0, 0), (0, k - 1), (0, 0)))
        return b + sum(w[j] * up[:, k - 1 - j:k - 1 - j + L] for j in range(k))
    up = jnp.pad(u, ((0, 0), (k - 1, 0), (0, 0)))
    return b + sum(w[j] * up[:, j:j + L] for j in range(k))


def rglru_coeffs(v, wa, ba, wx, bx, lam):
    B_, L, C = v.shape
    vb = v.reshape(B_, L, LRU_BLOCKS, LRU_BLOCK_W)
    r = jax.nn.sigmoid(jnp.einsum('blnk,nkj->blnj', vb, wa).reshape(B_, L, C) + ba)
    i = jax.nn.sigmoid(jnp.einsum('blnk,nkj->blnj', vb, wx).reshape(B_, L, C) + bx)
    log_a = (-LRU_C * jax.nn.softplus(-lam.astype(jnp.float32))) * r.astype(jnp.float32)
    a = jnp.exp(log_a)
    b = jnp.sqrt(-jnp.expm1(2.0 * log_a)) * (i * v).astype(jnp.float32)
    return a, b


def linear_scan(a, b, h0, reverse):
    edge = -1 if reverse else 0
    b = b.at[:, edge].add(a[:, edge] * h0)

    def comb(lhs, rhs):
        return (lhs[0] * rhs[0], rhs[0] * lhs[1] + rhs[1])

    _, h = lax.associative_scan(comb, (a, b), reverse=reverse, axis=1)
    return h


def lru_direction(u, conv_w, conv_b, wa, ba, wx, bx, lam, h0, reverse):
    v = directional_conv4(u, conv_w, conv_b, reverse)
    a, b = rglru_coeffs(v, wa, ba, wx, bx, lam)
    return linear_scan(a, b, h0, reverse)


def merge_branches(cols, conv_fn, h_lru, conv_w, w_out_a, w_out_b, b_merge, w_o):
    gate_b, gate_c, xc, _, lru_gate, m_a, m_b = cols
    y_a = (gate_b * conv_fn(gate_c * xc, conv_w)) @ w_out_a
    y_b = (jax.nn.gelu(lru_gate) * h_lru.astype(lru_gate.dtype)) @ w_out_b
    merged = jax.nn.sigmoid(m_a + b_merge[0]) * y_a + jax.nn.sigmoid(m_b + b_merge[1]) * y_b
    return merged @ w_o


def moe(xt, router_w, router_b, w1, b1, w2, b2):
    T, D = xt.shape
    logits = xt.astype(jnp.float32) @ router_w.astype(jnp.float32) + router_b.astype(jnp.float32)
    top_val, top_idx = lax.top_k(logits, TOP_K)
    gates = jax.nn.softmax(top_val, axis=-1)
    flat_e = top_idx.reshape(-1)
    flat_tok = jnp.arange(T * TOP_K, dtype=jnp.int32) // TOP_K
    flat_g = gates.reshape(-1)
    order = jnp.argsort(flat_e)
    se, stok, sg = flat_e[order], flat_tok[order], flat_g[order]
    counts = jnp.bincount(flat_e, length=N_EXPERTS)
    starts = jnp.cumsum(counts) - counts
    pcounts = ((counts + MOE_BLOCK - 1) // MOE_BLOCK) * MOE_BLOCK
    pends = jnp.cumsum(pcounts)
    pstarts = pends - pcounts
    dest = pstarts[se] + (jnp.arange(T * TOP_K, dtype=jnp.int32) - starts[se])
    n_blocks = (T * TOP_K + MOE_BLOCK - 1) // MOE_BLOCK + N_EXPERTS
    n_rows = n_blocks * MOE_BLOCK
    row_tok = jnp.zeros((n_rows,), jnp.int32).at[dest].set(stok)
    row_g = jnp.zeros((n_rows,), xt.dtype).at[dest].set(sg.astype(xt.dtype))
    block_e = jnp.clip(jnp.searchsorted(pends, jnp.arange(n_blocks) * MOE_BLOCK, side='right'),
                       0, N_EXPERTS - 1)

    def run_block(args):
        tok, e = args
        h = xt[tok] @ w1[e] + b1[e]
        glu = jnp.minimum(h[:, ::2], SWIGLU_LIMIT)
        lin = jnp.clip(h[:, 1::2], -SWIGLU_LIMIT, SWIGLU_LIMIT)
        act = glu * jax.nn.sigmoid(SWIGLU_ALPHA * glu) * (lin + 1)
        return act @ w2[e] + b2[e]

    y = lax.map(run_block, (row_tok.reshape(n_blocks, MOE_BLOCK), block_e))
    y = y.reshape(n_rows, D) * row_g[:, None]
    return jax.ops.segment_sum(y, row_tok, num_segments=T)


def setup_inputs(seed: int = 0) -> dict:
    key = jax.random.key(seed)
    ks = jax.random.split(key, 32)
    f32 = jnp.float32

    def nrm(k, shape, scale):
        return jax.random.normal(k, shape, f32) * scale

    u = jax.random.uniform(ks[16], (DEPTH, 2, D_LRU), f32, 0.9, 0.999)
    a0 = u ** (1.0 / LRU_C)
    lam = jnp.log(a0) - jnp.log1p(-a0)
    return {
        "x": nrm(ks[0], (BATCH, SEQ, D_MODEL), 1.0),
        "c": nrm(ks[1], (BATCH, D_MODEL), 1.0),
        "ctx": nrm(ks[2], (BATCH, CTX_LEN, D_MODEL), 1.0),
        "c_ctx": nrm(ks[3], (D_MODEL,), 1.0),
        "w_ada": nrm(ks[4], (DEPTH, D_MODEL, N_MOD * D_MODEL), D_MODEL ** -0.5),
        "b_ada": nrm(ks[5], (DEPTH, N_MOD * D_MODEL), 0.02),
        "norm_mix": 1.0 + nrm(ks[6], (DEPTH, D_MODEL), 0.02),
        "w_in": nrm(ks[7], (DEPTH, D_MODEL, IN_COLS), D_MODEL ** -0.5),
        "conv_a_w": nrm(ks[8], (DEPTH, CONV_W, D_CONV), CONV_W ** -0.5),
        "w_out_a": nrm(ks[9], (DEPTH, D_CONV, D_MODEL), D_CONV ** -0.5),
        "lru_conv_w": nrm(ks[10], (DEPTH, 2, LRU_CONV_W, D_LRU), LRU_CONV_W ** -0.5),
        "lru_conv_b": nrm(ks[11], (DEPTH, 2, D_LRU), 0.02),
        "lru_wa": nrm(ks[12], (DEPTH, 2, LRU_BLOCKS, LRU_BLOCK_W, LRU_BLOCK_W), LRU_BLOCK_W ** -0.5),
        "lru_ba": nrm(ks[13], (DEPTH, 2, D_LRU), 0.02),
        "lru_wx": nrm(ks[14], (DEPTH, 2, LRU_BLOCKS, LRU_BLOCK_W, LRU_BLOCK_W), LRU_BLOCK_W ** -0.5),
        "lru_bx": nrm(ks[15], (DEPTH, 2, D_LRU), 0.02),
        "lru_lambda": lam,
        "w_out_b": nrm(ks[17], (DEPTH, D_LRU, D_MODEL), D_LRU ** -0.5),
        "b_merge": nrm(ks[18], (DEPTH, N_BRANCH, D_MODEL), 0.02),
        "w_o": nrm(ks[19], (DEPTH, D_MODEL, D_MODEL), D_MODEL ** -0.5),
        "norm_ffn": 1.0 + nrm(ks[20], (DEPTH, D_MODEL), 0.02),
        "router_w": nrm(ks[21], (DEPTH, D_MODEL, N_EXPERTS), D_MODEL ** -0.5),
        "router_b": nrm(ks[22], (DEPTH, N_EXPERTS), 0.01),
        "w1": nrm(ks[23], (DEPTH, N_EXPERTS, D_MODEL, 2 * D_EXPERT), D_MODEL ** -0.5),
        "b1": nrm(ks[24], (DEPTH, N_EXPERTS, 2 * D_EXPERT), 0.02),
        "w2": nrm(ks[25], (DEPTH, N_EXPERTS, D_EXPERT, D_MODEL), D_EXPERT ** -0.5),
        "b2": nrm(ks[26], (DEPTH, N_EXPERTS, D_MODEL), 0.02),
        "norm_final": 1.0 + nrm(ks[27], (D_MODEL,), 0.02),
    }


def reference(x, c, ctx, c_ctx, w_ada, b_ada, norm_mix, w_in, conv_a_w, w_out_a, lru_conv_w,
              lru_conv_b, lru_wa, lru_ba, lru_wx, lru_bx, lru_lambda, w_out_b, b_merge, w_o,
              norm_ffn, router_w, router_b, w1, b1, w2, b2, norm_final):
    B_, S, D = x.shape
    rows = S // GRID_W
    latent_conv = functools.partial(grid_conv3, rows=rows)
    silu_c = jax.nn.silu(c)
    silu_cc = jax.nn.silu(c_ctx)[None]
    split_cols = lambda p: jnp.split(p, SPLIT_AT, axis=-1)
    for l in range(DEPTH):
        last = l == DEPTH - 1
        mx = adaln_params(silu_c, w_ada[l], b_ada[l])
        mc = adaln_params(silu_cc, w_ada[l], b_ada[l])

        hx = modulate(rmsnorm(x, norm_mix[l]), mx[0], mx[1])
        hc = modulate(rmsnorm(ctx, norm_mix[l]), mc[0], mc[1])
        xs = split_cols(jnp.einsum('bld,de->ble', hx, w_in[l]))
        cs = split_cols(jnp.einsum('bld,de->ble', hc, w_in[l]))
        fwd = (lru_conv_w[l, 0], lru_conv_b[l, 0], lru_wa[l, 0], lru_ba[l, 0],
               lru_wx[l, 0], lru_bx[l, 0], lru_lambda[l, 0])
        bwd = (lru_conv_w[l, 1], lru_conv_b[l, 1], lru_wa[l, 1], lru_ba[l, 1],
               lru_wx[l, 1], lru_bx[l, 1], lru_lambda[l, 1])
        h_zero = jnp.zeros((B_, D_LRU), jnp.float32)
        hcf = lru_direction(cs[3], *fwd, h0=h_zero, reverse=False)
        hcb = lru_direction(cs[3], *bwd, h0=h_zero, reverse=True)
        hxf = lru_direction(xs[3], *fwd, h0=hcf[:, -1], reverse=False)
        hxb = lru_direction(xs[3], *bwd, h0=hcb[:, 0], reverse=True)
        mix_x = merge_branches(xs, latent_conv, hxf + hxb, conv_a_w[l], w_out_a[l], w_out_b[l],
                               b_merge[l], w_o[l])
        x = x + mx[2] * mix_x
        if not last:
            mix_c = merge_branches(cs, seq_conv3, hcf + hcb, conv_a_w[l], w_out_a[l], w_out_b[l],
                                   b_merge[l], w_o[l])
            ctx = ctx + mc[2] * mix_c

        fx = modulate(rmsnorm(x, norm_ffn[l]), mx[3], mx[4]).reshape(-1, D)
        if last:
            y = moe(fx, router_w[l], router_b[l], w1[l], b1[l], w2[l], b2[l])
            x = x + mx[5] * y.reshape(x.shape)
        else:
            fc = modulate(rmsnorm(ctx, norm_ffn[l]), mc[3], mc[4]).reshape(-1, D)
            y = moe(jnp.concatenate([fx, fc], axis=0), router_w[l], router_b[l], w1[l], b1[l],
                    w2[l], b2[l])
            n_lat = fx.shape[0]
            x = x + mx[5] * y[:n_lat].reshape(x.shape)
            ctx = ctx + mc[5] * y[n_lat:].reshape(ctx.shape)
    return rmsnorm(x, norm_final)
```

```cpp
#include <hip/hip_runtime.h>
#include <stdint.h>
#include <cstdio>

typedef unsigned short bf16;
__device__ __forceinline__ float bf2f(bf16 v) { return __uint_as_float(((unsigned)v) << 16); }
__device__ __forceinline__ bf16 f2bf(float f) { unsigned u = __float_as_uint(f); u += 0x7fffu + ((u >> 16) & 1u); return (bf16)(u >> 16); }

constexpr int NB = 4, SEQ = 8192, D = 1024, M = NB * SEQ, CTX = 256, MC = NB * CTX, INC = 7168;
constexpr int NE = 32, TOPK = 4, DE = 1024, GW = 64, GROWS = SEQ / GW;
constexpr float EPS = 1e-6f;
constexpr size_t MiB = 1u << 20;
constexpr size_t WS_CTL = 0, CTL_BYTES = 1 * MiB;
constexpr int CW_CNT = 16384;
constexpr size_t WS_MX = 1 * MiB;
constexpr size_t WS_TOK = 2 * MiB, WS_GATE = 6 * MiB, WS_INV = 10 * MiB;
constexpr size_t WS_CS3 = 11 * MiB, WS_HC = 13 * MiB;
constexpr size_t WS_WIN = 16 * MiB, WS_WAB = 30 * MiB, WS_WO = 34 * MiB, WS_W1 = 36 * MiB, WS_W2 = 164 * MiB;
constexpr size_t WS_HX = 228 * MiB, WS_GB = 292 * MiB, WS_U = 356 * MiB, WS_ULRU = 420 * MiB, WS_GG = 484 * MiB;
constexpr size_t WS_ACT = 228 * MiB;
constexpr size_t WS_RAT = 548 * MiB, WS_SBG = 612 * MiB, WS_Z = 676 * MiB, WS_MG = 804 * MiB;
constexpr size_t WS_FX = 548 * MiB, WS_OUTP = 548 * MiB;
constexpr size_t WS_HF = WS_HX, WS_HB = WS_MG;
constexpr size_t WS_END = 868 * MiB;

struct P {
    const float *x, *c, *ctx, *c_ctx, *w_ada, *b_ada, *norm_mix, *w_in, *conv_a_w, *w_out_a, *lru_conv_w, *lru_conv_b, *lru_wa, *lru_ba, *lru_wx, *lru_bx,
        *lru_lambda, *w_out_b, *b_merge, *w_o, *norm_ffn, *router_w, *router_b, *w1, *b1, *w2, *b2, *norm_final;
    float* out; unsigned char* ws;
};

__device__ __forceinline__ float wave_sum(float v) {
#pragma unroll
    for (int o = 1; o < 64; o <<= 1) v += __shfl_xor(v, o);
    return v;
}
__device__ __forceinline__ float sigmoidf_(float v) { return 1.0f / (1.0f + __expf(-v)); }
__device__ __forceinline__ float gelu_tanh(float v) { const float u = 0.7978845608028654f * (v + 0.044715f * v * v * v); return v * sigmoidf_(2.0f * u); }
__device__ __forceinline__ int pad256(int v) { return (v + 255) & ~255; }

__global__ __launch_bounds__(256) void nv_adaln(P p) {
    __shared__ float sc[5][D];
    for (int i = threadIdx.x; i < 5 * D; i += 256) { const int r = i / D, k = i % D; const float v = r < 4 ? p.c[r * D + k] : p.c_ctx[k]; sc[r][k] = v * sigmoidf_(v); }
    __syncthreads();
    const int n = blockIdx.x * 256 + threadIdx.x;
    float a[5] = {0, 0, 0, 0, 0};
    for (int k = 0; k < D; ++k) { const float w = p.w_ada[(size_t)k * 6144 + n];
#pragma unroll
        for (int r = 0; r < 5; ++r) a[r] += sc[r][k] * w; }
    float* mx = (float*)(p.ws + WS_MX);
#pragma unroll
    for (int r = 0; r < 5; ++r) mx[r * 6144 + n] = a[r] + p.b_ada[n];
}
__global__ __launch_bounds__(256) void nv_hx(P p) {
    const int row = blockIdx.x * 4 + (threadIdx.x >> 6), lane = threadIdx.x & 63;
    const float* mx = (const float*)(p.ws + WS_MX);
    const float* src; bf16* dst; const float* md;
    if (row < M) { src = p.x + (size_t)row * D; dst = (bf16*)(p.ws + WS_HX) + (size_t)row * D; md = mx + (row / SEQ) * 6144; }
    else { const int r = row - M; src = p.ctx + (size_t)r * D; dst = (bf16*)(p.ws + WS_HC) + (size_t)r * D; md = mx + 4 * 6144; }
    float v[16]; float s = 0.f;
#pragma unroll
    for (int j = 0; j < 16; ++j) { v[j] = src[lane + 64 * j]; s += v[j] * v[j]; }
    const float rstd = rsqrtf(wave_sum(s) * (1.0f / D) + EPS);
#pragma unroll
    for (int j = 0; j < 16; ++j) { const int k = lane + 64 * j; dst[k] = f2bf(v[j] * rstd * p.norm_mix[k] * (1.0f + md[1024 + k]) + md[k]); }
}

template <bool DUAL, class F>
__global__ __launch_bounds__(256) void nv_gemm(F f) {
    const int K = f.K;
    __shared__ float As[2][16][128 + 4], Bs[2][16][128 + 4];
    const int z = blockIdx.z, m0 = blockIdx.y * 128, n0 = blockIdx.x * 128, tid = threadIdx.x, tx = tid & 15, ty = tid >> 4;
    if (m0 >= f.rows(z)) return;
    float acc[8][8], acc2[8][8];
#pragma unroll
    for (int i = 0; i < 8; ++i)
#pragma unroll
        for (int j = 0; j < 8; ++j) { acc[i][j] = 0.f; acc2[i][j] = 0.f; }
    for (int k0 = 0; k0 < K; k0 += 16) {
#pragma unroll
        for (int i = 0; i < 8; ++i) { const int idx = tid + 256 * i; const int mm = idx >> 4, kk = idx & 15; As[0][kk][mm] = f.a(z, m0 + mm, k0 + kk); if (DUAL) As[1][kk][mm] = f.a2(z, m0 + mm, k0 + kk); }
#pragma unroll
        for (int i = 0; i < 8; ++i) { const int idx = tid + 256 * i; const int kk = idx >> 7, nn = idx & 127; Bs[0][kk][nn] = f.b(z, k0 + kk, n0 + nn); if (DUAL) Bs[1][kk][nn] = f.b2(z, k0 + kk, n0 + nn); }
        __syncthreads();
#pragma unroll
        for (int kk = 0; kk < 16; ++kk) {
            float av[8], bv[8];
#pragma unroll
            for (int i = 0; i < 8; ++i) { av[i] = As[0][kk][ty + 16 * i]; bv[i] = Bs[0][kk][tx + 16 * i]; }
#pragma unroll
            for (int i = 0; i < 8; ++i)
#pragma unroll
                for (int j = 0; j < 8; ++j) acc[i][j] += av[i] * bv[j];
            if (DUAL) {
#pragma unroll
                for (int i = 0; i < 8; ++i) { av[i] = As[1][kk][ty + 16 * i]; bv[i] = Bs[1][kk][tx + 16 * i]; }
#pragma unroll
                for (int i = 0; i < 8; ++i)
#pragma unroll
                    for (int j = 0; j < 8; ++j) acc2[i][j] += av[i] * bv[j];
            }
        }
        __syncthreads();
    }
#pragma unroll
    for (int i = 0; i < 8; ++i)
#pragma unroll
        for (int j = 0; j < 8; ++j) f.ep(z, m0 + ty + 16 * i, n0 + tx + 16 * j, acc[i][j], acc2[i][j]);
}
struct FInProj {
    P p; int mode, K;
    __device__ int rows(int) const { return mode == 5 ? MC : M; }
    __device__ float a(int, int m, int k) const { const bf16* A = (const bf16*)(p.ws + (mode == 5 ? WS_HC : WS_HX)); return bf2f(A[(size_t)m * D + k]); }
    __device__ float a2(int z, int m, int k) const { return a(z, m, k); }
    __device__ int col1() const { return mode == 0 ? 0 : mode == 1 ? 1024 : mode == 2 ? 3072 : mode == 3 ? 4096 : mode == 4 ? 5120 : 3072; }
    __device__ float b(int, int k, int n) const { return p.w_in[(size_t)k * INC + col1() + n]; }
    __device__ float b2(int, int k, int n) const { return p.w_in[(size_t)k * INC + col1() + 1024 + n]; }
    __device__ void ep(int, int m, int n, float v, float v2) const {
        const size_t o = (size_t)m * D + n;
        if (mode == 0) ((bf16*)(p.ws + WS_GB))[o] = f2bf(v);
        else if (mode == 1) ((bf16*)(p.ws + WS_U))[o] = f2bf(v * v2);
        else if (mode == 2) ((bf16*)(p.ws + WS_ULRU))[o] = f2bf(v);
        else if (mode == 3) ((bf16*)(p.ws + WS_GG))[o] = f2bf(gelu_tanh(v));
        else if (mode == 4) { const float sa = sigmoidf_(v + p.b_merge[n]), sb = sigmoidf_(v2 + p.b_merge[D + n]); ((bf16*)(p.ws + WS_RAT))[o] = f2bf(sa / sb); ((bf16*)(p.ws + WS_SBG))[o] = f2bf(sb); }
        else ((bf16*)(p.ws + WS_CS3))[o] = f2bf(v);
    }
};
struct FMerge {
    P p; int K, pad;
    __device__ int rows(int) const { return M; }
    __device__ float a(int, int m, int k) const { return bf2f(((const bf16*)(p.ws + WS_Z))[(size_t)m * 2048 + k]); }
    __device__ float a2(int, int m, int k) const { return bf2f(((const bf16*)(p.ws + WS_Z))[(size_t)m * 2048 + 1024 + k]); }
    __device__ float b(int, int k, int n) const { return p.w_out_a[(size_t)k * D + n]; }
    __device__ float b2(int, int k, int n) const { return p.w_out_b[(size_t)k * D + n]; }
    __device__ void ep(int, int m, int n, float v, float v2) const {
        const size_t o = (size_t)m * D + n; const float rat = bf2f(((const bf16*)(p.ws + WS_RAT))[o]), sb = bf2f(((const bf16*)(p.ws + WS_SBG))[o]);
        ((bf16*)(p.ws + WS_MG))[o] = f2bf((v * rat + v2) * sb);
    }
};
struct FWo {
    P p; int K, pad;
    __device__ int rows(int) const { return M; }
    __device__ float a(int, int m, int k) const { return bf2f(((const bf16*)(p.ws + WS_MG))[(size_t)m * D + k]); }
    __device__ float a2(int, int, int) const { return 0.f; }
    __device__ float b(int, int k, int n) const { return p.w_o[(size_t)k * D + n]; }
    __device__ float b2(int, int, int) const { return 0.f; }
    __device__ void ep(int, int m, int n, float v, float) const { const float* mx = (const float*)(p.ws + WS_MX); const size_t o = (size_t)m * D + n; p.out[o] = p.x[o] + mx[(m / SEQ) * 6144 + 2 * 1024 + n] * v; }
};
__device__ __forceinline__ int expert_base(const unsigned* cnt, int e) { int b = 0; for (int i = 0; i < e; ++i) b += pad256((int)cnt[i]); return b; }
struct FMoe1 {
    P p; int K, pad;
    __device__ const unsigned* cnt() const { return (const unsigned*)(p.ws + WS_CTL) + CW_CNT; }
    __device__ int rows(int z) const { return (int)cnt()[z]; }
    __device__ float a(int z, int m, int k) const { if (m >= rows(z)) return 0.f; const int tok = ((const int*)(p.ws + WS_TOK))[(size_t)z * M + m]; return bf2f(((const bf16*)(p.ws + WS_FX))[(size_t)tok * D + k]); }
    __device__ float a2(int z, int m, int k) const { return a(z, m, k); }
    __device__ float b(int z, int k, int n) const { return p.w1[((size_t)z * D + k) * 2048 + 2 * n]; }
    __device__ float b2(int z, int k, int n) const { return p.w1[((size_t)z * D + k) * 2048 + 2 * n + 1]; }
    __device__ void ep(int z, int m, int n, float v, float v2) const {
        if (m >= rows(z)) return;
        const float hg = v + p.b1[(size_t)z * 2048 + 2 * n], hl = v2 + p.b1[(size_t)z * 2048 + 2 * n + 1];
        const float glu = fminf(hg, 7.0f), lin = fminf(fmaxf(hl, -7.0f), 7.0f);
        const float act = glu * sigmoidf_(1.702f * glu) * (lin + 1.0f);
        ((bf16*)(p.ws + WS_ACT))[(size_t)(expert_base(cnt(), z) + m) * DE + n] = f2bf(act);
    }
};
struct FMoe2 {
    P p; int K, pad;
    __device__ const unsigned* cnt() const { return (const unsigned*)(p.ws + WS_CTL) + CW_CNT; }
    __device__ int rows(int z) const { return (int)cnt()[z]; }
    __device__ float a(int z, int m, int k) const { if (m >= rows(z)) return 0.f; return bf2f(((const bf16*)(p.ws + WS_ACT))[(size_t)(expert_base(cnt(), z) + m) * DE + k]); }
    __device__ float a2(int, int, int) const { return 0.f; }
    __device__ float b(int z, int k, int n) const { return p.w2[((size_t)z * DE + k) * D + n]; }
    __device__ float b2(int, int, int) const { return 0.f; }
    __device__ void ep(int z, int m, int n, float v, float) const {
        if (m >= rows(z)) return;
        const float g = ((const float*)(p.ws + WS_GATE))[(size_t)z * M + m];
        ((bf16*)(p.ws + WS_OUTP))[(size_t)(expert_base(cnt(), z) + m) * D + n] = f2bf((v + p.b2[(size_t)z * D + n]) * g);
    }
};

__global__ __launch_bounds__(64) void nv_lru(P p) {
    __shared__ float vs[64];
    const int j = threadIdx.x, blk = blockIdx.x & 15, dir = (blockIdx.x >> 4) & 1, b = blockIdx.x >> 5, ch = blk * 64 + j;
    float wa[64], wx[64];
    const float* WA = p.lru_wa + ((size_t)(dir * 16 + blk) * 64) * 64; const float* WX = p.lru_wx + ((size_t)(dir * 16 + blk) * 64) * 64;
#pragma unroll
    for (int k = 0; k < 64; ++k) { wa[k] = WA[k * 64 + j]; wx[k] = WX[k * 64 + j]; }
    const float ba = p.lru_ba[dir * D + ch], bx = p.lru_bx[dir * D + ch], cb = p.lru_conv_b[dir * D + ch];
    float cw[4];
#pragma unroll
    for (int q = 0; q < 4; ++q) cw[q] = p.lru_conv_w[(size_t)(dir * 4 + q) * D + ch];
    const float lam = p.lru_lambda[dir * D + ch];
    const float c1 = -8.0f * log1pf(__expf(-lam));
    float h = 0.f;
    bf16* hout = (bf16*)(p.ws + (dir == 0 ? WS_HF : WS_HB));
    for (int seq = 0; seq < 2; ++seq) {
        const int L = seq == 0 ? CTX : SEQ;
        const bf16* u = seq == 0 ? (const bf16*)(p.ws + WS_CS3) + (size_t)b * CTX * D : (const bf16*)(p.ws + WS_ULRU) + (size_t)b * SEQ * D;
        for (int step = 0; step < L; ++step) {
            const int t = dir == 0 ? step : L - 1 - step;
            float v = cb;
#pragma unroll
            for (int q = 0; q < 4; ++q) { const int tt = dir == 0 ? t + q - 3 : t + 3 - q; if (tt >= 0 && tt < L) v += cw[q] * bf2f(u[(size_t)tt * D + ch]); }
            vs[j] = v;
            __syncthreads();
            float r = ba, i = bx;
#pragma unroll
            for (int k = 0; k < 64; ++k) { const float vk = vs[k]; r += vk * wa[k]; i += vk * wx[k]; }
            __syncthreads();
            r = sigmoidf_(r); i = sigmoidf_(i);
            const float la = c1 * r, a = __expf(la), bb = sqrtf(fmaxf(1.0f - __expf(2.0f * la), 0.f)) * (i * v);
            h = a * h + bb;
            if (seq == 1) hout[((size_t)b * SEQ + t) * D + ch] = f2bf(h);
        }
    }
}
__global__ __launch_bounds__(256) void nv_mix(P p) {
    const size_t idx = (size_t)blockIdx.x * 256 + threadIdx.x; const int m = (int)(idx / D), ch = (int)(idx % D);
    const int tb = m % SEQ, row = tb / GW, col = tb % GW;
    const bf16* U = (const bf16*)(p.ws + WS_U);
    float s = 0.f;
#pragma unroll
    for (int k = 0; k < 3; ++k) {
        const float w = p.conv_a_w[k * D + ch]; int mm; bool ok;
        if (ch < 512) { const int c2 = col + k - 1; ok = c2 >= 0 && c2 < GW; mm = m + k - 1; }
        else { const int r2 = row + k - 1; ok = r2 >= 0 && r2 < GROWS; mm = m + (k - 1) * GW; }
        if (ok) s += w * bf2f(U[(size_t)mm * D + ch]);
    }
    bf16* Z = (bf16*)(p.ws + WS_Z);
    Z[(size_t)m * 2048 + ch] = f2bf(bf2f(((const bf16*)(p.ws + WS_GB))[idx]) * s);
    const float hh = bf2f(((const bf16*)(p.ws + WS_HF))[idx]) + bf2f(((const bf16*)(p.ws + WS_HB))[idx]);
    Z[(size_t)m * 2048 + 1024 + ch] = f2bf(bf2f(((const bf16*)(p.ws + WS_GG))[idx]) * hh);
}
__global__ __launch_bounds__(256) void nv_route(P p) {
    const int row = blockIdx.x * 4 + (threadIdx.x >> 6), lane = threadIdx.x & 63;
    const float* mx = (const float*)(p.ws + WS_MX) + (row / SEQ) * 6144;
    const float* src = p.out + (size_t)row * D;
    float v[16]; float s = 0.f;
#pragma unroll
    for (int j = 0; j < 16; ++j) { v[j] = src[lane + 64 * j]; s += v[j] * v[j]; }
    const float rstd = rsqrtf(wave_sum(s) * (1.0f / D) + EPS);
    bf16* fx = (bf16*)(p.ws + WS_FX) + (size_t)row * D;
#pragma unroll
    for (int j = 0; j < 16; ++j) { const int k = lane + 64 * j; v[j] = v[j] * rstd * p.norm_ffn[k] * (1.0f + mx[4 * 1024 + k]) + mx[3 * 1024 + k]; fx[k] = f2bf(v[j]); }
    float lg[NE];
#pragma unroll
    for (int e = 0; e < NE; ++e) { float a = 0.f;
#pragma unroll
        for (int j = 0; j < 16; ++j) a += v[j] * p.router_w[(size_t)(lane + 64 * j) * NE + e];
        lg[e] = wave_sum(a) + p.router_b[e]; }
    if (lane == 0) {
        int idx[TOPK]; float val[TOPK]; unsigned used = 0u;
#pragma unroll
        for (int t = 0; t < TOPK; ++t) { int bi = -1; float bv = -3.0e38f;
#pragma unroll
            for (int e = 0; e < NE; ++e) { const bool free_ = !((used >> e) & 1u); if (free_ && lg[e] > bv) { bv = lg[e]; bi = e; } }
            idx[t] = bi; val[t] = bv; used |= 1u << bi; }
        float ex[TOPK], se = 0.f;
#pragma unroll
        for (int t = 0; t < TOPK; ++t) { ex[t] = __expf(val[t] - val[0]); se += ex[t]; }
        unsigned* cnt = (unsigned*)(p.ws + WS_CTL) + CW_CNT;
#pragma unroll
        for (int t = 0; t < TOPK; ++t) {
            const int e = idx[t]; const unsigned slot = atomicAdd(&cnt[e], 1u);
            ((int*)(p.ws + WS_TOK))[(size_t)e * M + slot] = row;
            ((float*)(p.ws + WS_GATE))[(size_t)e * M + slot] = ex[t] / se;
            ((int*)(p.ws + WS_INV))[(size_t)row * 4 + t] = e * M + (int)slot;
        }
    }
}
__global__ __launch_bounds__(256) void nv_final(P p) {
    const int row = blockIdx.x * 4 + (threadIdx.x >> 6), lane = threadIdx.x & 63;
    const float* mx = (const float*)(p.ws + WS_MX) + (row / SEQ) * 6144 + 5 * 1024;
    const unsigned* cnt = (const unsigned*)(p.ws + WS_CTL) + CW_CNT;
    const int* inv = (const int*)(p.ws + WS_INV) + (size_t)row * 4;
    const bf16* op[TOPK];
#pragma unroll
    for (int t = 0; t < TOPK; ++t) { const int e = inv[t] / M, slot = inv[t] % M; op[t] = (const bf16*)(p.ws + WS_OUTP) + (size_t)(expert_base(cnt, e) + slot) * D; }
    float* xo = p.out + (size_t)row * D;
    float v[16]; float s = 0.f;
#pragma unroll
    for (int j = 0; j < 16; ++j) { const int k = lane + 64 * j; float y = 0.f;
#pragma unroll
        for (int t = 0; t < TOPK; ++t) y += bf2f(op[t][k]);
        v[j] = xo[k] + mx[k] * y; s += v[j] * v[j]; }
    const float rstd = rsqrtf(wave_sum(s) * (1.0f / D) + EPS);
#pragma unroll
    for (int j = 0; j < 16; ++j) { const int k = lane + 64 * j; xo[k] = v[j] * rstd * p.norm_final[k]; }
}

extern "C" void kernel_launch(void* const* d_in, const int* in_sizes, int n_in, void* d_out, int out_size, void* d_ws, size_t ws_size, hipStream_t stream) {
    if (n_in != 28 || out_size != M * D || ws_size < WS_END) { fprintf(stderr, "kernel_launch: unexpected shapes n_in %d out %d ws %zu\n", n_in, out_size, ws_size); return; }
    P p{};
    const float** f = (const float**)&p;
    for (int i = 0; i < 28; ++i) f[i] = (const float*)d_in[i];
    p.out = (float*)d_out; p.ws = (unsigned char*)d_ws;
    (void)hipMemsetAsync((char*)d_ws + WS_CTL, 0, CTL_BYTES, stream);
    nv_adaln<<<6144 / 256, 256, 0, stream>>>(p);
    nv_hx<<<(M + MC) / 4, 256, 0, stream>>>(p);
    for (int mode = 0; mode < 6; ++mode) {
        FInProj fi{p, mode, D};
        const dim3 g(D / 128, (mode == 5 ? MC : M) / 128, 1);
        if (mode == 1 || mode == 4) nv_gemm<true, FInProj><<<g, 256, 0, stream>>>(fi); else nv_gemm<false, FInProj><<<g, 256, 0, stream>>>(fi);
    }
    nv_lru<<<NB * 2 * 16, 64, 0, stream>>>(p);
    nv_mix<<<(unsigned)((size_t)M * D / 256), 256, 0, stream>>>(p);
    { FMerge fm{p, D, 0}; nv_gemm<true, FMerge><<<dim3(D / 128, M / 128, 1), 256, 0, stream>>>(fm); }
    { FWo fw{p, D, 0}; nv_gemm<false, FWo><<<dim3(D / 128, M / 128, 1), 256, 0, stream>>>(fw); }
    nv_route<<<M / 4, 256, 0, stream>>>(p);
    { FMoe1 f1{p, D, 0}; nv_gemm<true, FMoe1><<<dim3(DE / 128, M / 128, NE), 256, 0, stream>>>(f1); }
    { FMoe2 f2{p, DE, 0}; nv_gemm<false, FMoe2><<<dim3(D / 128, M / 128, NE), 256, 0, stream>>>(f2); }
    nv_final<<<M / 4, 256, 0, stream>>>(p);
}
```

```cpp
#include <hip/hip_runtime.h>
#include <stdint.h>
#include <cstdio>

typedef unsigned short bf16;
__device__ __forceinline__ float bf2f(bf16 v) { return __uint_as_float(((unsigned)v) << 16); }
__device__ __forceinline__ bf16 f2bf(float f) { unsigned u = __float_as_uint(f); u += 0x7fffu + ((u >> 16) & 1u); return (bf16)(u >> 16); }

constexpr int NB = 4, SEQ = 8192, D = 1024, M = NB * SEQ, CTX = 256, MC = NB * CTX, INC = 7168;
constexpr int NE = 32, TOPK = 4, DE = 1024, GW = 64, GROWS = SEQ / GW;
constexpr float EPS = 1e-6f;
constexpr size_t MiB = 1u << 20;
constexpr size_t WS_CTL = 0, CTL_BYTES = 1 * MiB;
constexpr int CW_CNT = 16384;
constexpr size_t WS_MX = 1 * MiB;
constexpr size_t WS_TOK = 2 * MiB, WS_GATE = 6 * MiB, WS_INV = 10 * MiB;
constexpr size_t WS_CS3 = 11 * MiB, WS_HC = 13 * MiB;
constexpr size_t WS_WIN = 16 * MiB, WS_WAB = 30 * MiB, WS_WO = 34 * MiB, WS_W1 = 36 * MiB, WS_W2 = 164 * MiB;
constexpr size_t WS_HX = 228 * MiB, WS_GB = 292 * MiB, WS_U = 356 * MiB, WS_ULRU = 420 * MiB, WS_GG = 484 * MiB;
constexpr size_t WS_ACT = 228 * MiB;
constexpr size_t WS_RAT = 548 * MiB, WS_SBG = 612 * MiB, WS_Z = 676 * MiB, WS_MG = 804 * MiB;
constexpr size_t WS_FX = 548 * MiB, WS_OUTP = 548 * MiB;
constexpr size_t WS_HF = WS_HX, WS_HB = WS_MG;
constexpr size_t WS_END = 868 * MiB;

struct P {
    const float *x, *c, *ctx, *c_ctx, *w_ada, *b_ada, *norm_mix, *w_in, *conv_a_w, *w_out_a, *lru_conv_w, *lru_conv_b, *lru_wa, *lru_ba, *lru_wx, *lru_bx,
        *lru_lambda, *w_out_b, *b_merge, *w_o, *norm_ffn, *router_w, *router_b, *w1, *b1, *w2, *b2, *norm_final;
    float* out; unsigned char* ws;
};

__device__ __forceinline__ float wave_sum(float v) {
#pragma unroll
    for (int o = 1; o < 64; o <<= 1) v += __shfl_xor(v, o);
    return v;
}
__device__ __forceinline__ float sigmoidf_(float v) { return 1.0f / (1.0f + __expf(-v)); }
__device__ __forceinline__ float gelu_tanh(float v) { const float u = 0.7978845608028654f * (v + 0.044715f * v * v * v); return v * sigmoidf_(2.0f * u); }
__device__ __forceinline__ int pad256(int v) { return (v + 255) & ~255; }

__global__ __launch_bounds__(256) void nv_adaln(P p) {
    __shared__ float sc[5][D];
    for (int i = threadIdx.x; i < 5 * D; i += 256) { const int r = i / D, k = i % D; const float v = r < 4 ? p.c[r * D + k] : p.c_ctx[k]; sc[r][k] = v * sigmoidf_(v); }
    __syncthreads();
    const int n = blockIdx.x * 256 + threadIdx.x;
    float a[5] = {0, 0, 0, 0, 0};
    for (int k = 0; k < D; ++k) { const float w = p.w_ada[(size_t)k * 6144 + n];
#pragma unroll
        for (int r = 0; r < 5; ++r) a[r] += sc[r][k] * w; }
    float* mx = (float*)(p.ws + WS_MX);
#pragma unroll
    for (int r = 0; r < 5; ++r) mx[r * 6144 + n] = a[r] + p.b_ada[n];
}
__global__ __launch_bounds__(256) void nv_hx(P p) {
    const int row = blockIdx.x * 4 + (threadIdx.x >> 6), lane = threadIdx.x & 63;
    const float* mx = (const float*)(p.ws + WS_MX);
    const float* src; bf16* dst; const float* md;
    if (row < M) { src = p.x + (size_t)row * D; dst = (bf16*)(p.ws + WS_HX) + (size_t)row * D; md = mx + (row / SEQ) * 6144; }
    else { const int r = row - M; src = p.ctx + (size_t)r * D; dst = (bf16*)(p.ws + WS_HC) + (size_t)r * D; md = mx + 4 * 6144; }
    float v[16]; float s = 0.f;
#pragma unroll
    for (int j = 0; j < 16; ++j) { v[j] = src[lane + 64 * j]; s += v[j] * v[j]; }
    const float rstd = rsqrtf(wave_sum(s) * (1.0f / D) + EPS);
#pragma unroll
    for (int j = 0; j < 16; ++j) { const int k = lane + 64 * j; dst[k] = f2bf(v[j] * rstd * p.norm_mix[k] * (1.0f + md[1024 + k]) + md[k]); }
}

template <bool DUAL, class F>
__global__ __launch_bounds__(256) void nv_gemm(F f) {
    const int K = f.K;
    __shared__ float As[2][16][128 + 4], Bs[2][16][128 + 4];
    const int z = blockIdx.z, m0 = blockIdx.y * 128, n0 = blockIdx.x * 128, tid = threadIdx.x, tx = tid & 15, ty = tid >> 4;
    if (m0 >= f.rows(z)) return;
    float acc[8][8], acc2[8][8];
#pragma unroll
    for (int i = 0; i < 8; ++i)
#pragma unroll
        for (int j = 0; j < 8; ++j) { acc[i][j] = 0.f; acc2[i][j] = 0.f; }
    for (int k0 = 0; k0 < K; k0 += 16) {
#pragma unroll
        for (int i = 0; i < 8; ++i) { const int idx = tid + 256 * i; const int mm = idx >> 4, kk = idx & 15; As[0][kk][mm] = f.a(z, m0 + mm, k0 + kk); if (DUAL) As[1][kk][mm] = f.a2(z, m0 + mm, k0 + kk); }
#pragma unroll
        for (int i = 0; i < 8; ++i) { const int idx = tid + 256 * i; const int kk = idx >> 7, nn = idx & 127; Bs[0][kk][nn] = f.b(z, k0 + kk, n0 + nn); if (DUAL) Bs[1][kk][nn] = f.b2(z, k0 + kk, n0 + nn); }
        __syncthreads();
#pragma unroll
        for (int kk = 0; kk < 16; ++kk) {
            float av[8], bv[8];
#pragma unroll
            for (int i = 0; i < 8; ++i) { av[i] = As[0][kk][ty + 16 * i]; bv[i] = Bs[0][kk][tx + 16 * i]; }
#pragma unroll
            for (int i = 0; i < 8; ++i)
#pragma unroll
                for (int j = 0; j < 8; ++j) acc[i][j] += av[i] * bv[j];
            if (DUAL) {
#pragma unroll
                for (int i = 0; i < 8; ++i) { av[i] = As[1][kk][ty + 16 * i]; bv[i] = Bs[1][kk][tx + 16 * i]; }
#pragma unroll
                for (int i = 0; i < 8; ++i)
#pragma unroll
                    for (int j = 0; j < 8; ++j) acc2[i][j] += av[i] * bv[j];
            }
        }
        __syncthreads();
    }
#pragma unroll
    for (int i = 0; i < 8; ++i)
#pragma unroll
        for (int j = 0; j < 8; ++j) f.ep(z, m0 + ty + 16 * i, n0 + tx + 16 * j, acc[i][j], acc2[i][j]);
}
struct FInProj {
    P p; int mode, K;
    __device__ int rows(int) const { return mode == 5 ? MC : M; }
    __device__ float a(int, int m, int k) const { const bf16* A = (const bf16*)(p.ws + (mode == 5 ? WS_HC : WS_HX)); return bf2f(A[(size_t)m * D + k]); }
    __device__ float a2(int z, int m, int k) const { return a(z, m, k); }
    __device__ int col1() const { return mode == 0 ? 0 : mode == 1 ? 1024 : mode == 2 ? 3072 : mode == 3 ? 4096 : mode == 4 ? 5120 : 3072; }
    __device__ float b(int, int k, int n) const { return p.w_in[(size_t)k * INC + col1() + n]; }
    __device__ float b2(int, int k, int n) const { return p.w_in[(size_t)k * INC + col1() + 1024 + n]; }
    __device__ void ep(int, int m, int n, float v, float v2) const {
        const size_t o = (size_t)m * D + n;
        if (mode == 0) ((bf16*)(p.ws + WS_GB))[o] = f2bf(v);
        else if (mode == 1) ((bf16*)(p.ws + WS_U))[o] = f2bf(v * v2);
        else if (mode == 2) ((bf16*)(p.ws + WS_ULRU))[o] = f2bf(v);
        else if (mode == 3) ((bf16*)(p.ws + WS_GG))[o] = f2bf(gelu_tanh(v));
        else if (mode == 4) { const float sa = sigmoidf_(v + p.b_merge[n]), sb = sigmoidf_(v2 + p.b_merge[D + n]); ((bf16*)(p.ws + WS_RAT))[o] = f2bf(sa / sb); ((bf16*)(p.ws + WS_SBG))[o] = f2bf(sb); }
        else ((bf16*)(p.ws + WS_CS3))[o] = f2bf(v);
    }
};
struct FMerge {
    P p; int K, pad;
    __device__ int rows(int) const { return M; }
    __device__ float a(int, int m, int k) const { return bf2f(((const bf16*)(p.ws + WS_Z))[(size_t)m * 2048 + k]); }
    __device__ float a2(int, int m, int k) const { return bf2f(((const bf16*)(p.ws + WS_Z))[(size_t)m * 2048 + 1024 + k]); }
    __device__ float b(int, int k, int n) const { return p.w_out_a[(size_t)k * D + n]; }
    __device__ float b2(int, int k, int n) const { return p.w_out_b[(size_t)k * D + n]; }
    __device__ void ep(int, int m, int n, float v, float v2) const {
        const size_t o = (size_t)m * D + n; const float rat = bf2f(((const bf16*)(p.ws + WS_RAT))[o]), sb = bf2f(((const bf16*)(p.ws + WS_SBG))[o]);
        ((bf16*)(p.ws + WS_MG))[o] = f2bf((v * rat + v2) * sb);
    }
};
struct FWo {
    P p; int K, pad;
    __device__ int rows(int) const { return M; }
    __device__ float a(int, int m, int k) const { return bf2f(((const bf16*)(p.ws + WS_MG))[(size_t)m * D + k]); }
    __device__ float a2(int, int, int) const { return 0.f; }
    __device__ float b(int, int k, int n) const { return p.w_o[(size_t)k * D + n]; }
    __device__ float b2(int, int, int) const { return 0.f; }
    __device__ void ep(int, int m, int n, float v, float) const { const float* mx = (const float*)(p.ws + WS_MX); const size_t o = (size_t)m * D + n; p.out[o] = p.x[o] + mx[(m / SEQ) * 6144 + 2 * 1024 + n] * v; }
};
__device__ __forceinline__ int expert_base(const unsigned* cnt, int e) { int b = 0; for (int i = 0; i < e; ++i) b += pad256((int)cnt[i]); return b; }
struct FMoe1 {
    P p; int K, pad;
    __device__ const unsigned* cnt() const { return (const unsigned*)(p.ws + WS_CTL) + CW_CNT; }
    __device__ int rows(int z) const { return (int)cnt()[z]; }
    __device__ float a(int z, int m, int k) const { if (m >= rows(z)) return 0.f; const int tok = ((const int*)(p.ws + WS_TOK))[(size_t)z * M + m]; return bf2f(((const bf16*)(p.ws + WS_FX))[(size_t)tok * D + k]); }
    __device__ float a2(int z, int m, int k) const { return a(z, m, k); }
    __device__ float b(int z, int k, int n) const { return p.w1[((size_t)z * D + k) * 2048 + 2 * n]; }
    __device__ float b2(int z, int k, int n) const { return p.w1[((size_t)z * D + k) * 2048 + 2 * n + 1]; }
    __device__ void ep(int z, int m, int n, float v, float v2) const {
        if (m >= rows(z)) return;
        const float hg = v + p.b1[(size_t)z * 2048 + 2 * n], hl = v2 + p.b1[(size_t)z * 2048 + 2 * n + 1];
        const float glu = fminf(hg, 7.0f), lin = fminf(fmaxf(hl, -7.0f), 7.0f);
        const float act = glu * sigmoidf_(1.702f * glu) * (lin + 1.0f);
        ((bf16*)(p.ws + WS_ACT))[(size_t)(expert_base(cnt(), z) + m) * DE + n] = f2bf(act);
    }
};
struct FMoe2 {
    P p; int K, pad;
    __device__ const unsigned* cnt() const { return (const unsigned*)(p.ws + WS_CTL) + CW_CNT; }
    __device__ int rows(int z) const { return (int)cnt()[z]; }
    __device__ float a(int z, int m, int k) const { if (m >= rows(z)) return 0.f; return bf2f(((const bf16*)(p.ws + WS_ACT))[(size_t)(expert_base(cnt(), z) + m) * DE + k]); }
    __device__ float a2(int, int, int) const { return 0.f; }
    __device__ float b(int z, int k, int n) const { return p.w2[((size_t)z * DE + k) * D + n]; }
    __device__ float b2(int, int, int) const { return 0.f; }
    __device__ void ep(int z, int m, int n, float v, float) const {
        if (m >= rows(z)) return;
        const float g = ((const float*)(p.ws + WS_GATE))[(size_t)z * M + m];
        ((bf16*)(p.ws + WS_OUTP))[(size_t)(expert_base(cnt(), z) + m) * D + n] = f2bf((v + p.b2[(size_t)z * D + n]) * g);
    }
};

__global__ __launch_bounds__(64) void nv_lru(P p) {
    __shared__ float vs[64];
    const int j = threadIdx.x, blk = blockIdx.x & 15, dir = (blockIdx.x >> 4) & 1, b = blockIdx.x >> 5, ch = blk * 64 + j;
    float wa[64], wx[64];
    const float* WA = p.lru_wa + ((size_t)(dir * 16 + blk) * 64) * 64; const float* WX = p.lru_wx + ((size_t)(dir * 16 + blk) * 64) * 64;
#pragma unroll
    for (int k = 0; k < 64; ++k) { wa[k] = WA[k * 64 + j]; wx[k] = WX[k * 64 + j]; }
    const float ba = p.lru_ba[dir * D + ch], bx = p.lru_bx[dir * D + ch], cb = p.lru_conv_b[dir * D + ch];
    float cw[4];
#pragma unroll
    for (int q = 0; q < 4; ++q) cw[q] = p.lru_conv_w[(size_t)(dir * 4 + q) * D + ch];
    const float lam = p.lru_lambda[dir * D + ch];
    const float c1 = -8.0f * log1pf(__expf(-lam));
    float h = 0.f;
    bf16* hout = (bf16*)(p.ws + (dir == 0 ? WS_HF : WS_HB));
    for (int seq = 0; seq < 2; ++seq) {
        const int L = seq == 0 ? CTX : SEQ;
        const bf16* u = seq == 0 ? (const bf16*)(p.ws + WS_CS3) + (size_t)b * CTX * D : (const bf16*)(p.ws + WS_ULRU) + (size_t)b * SEQ * D;
        for (int step = 0; step < L; ++step) {
            const int t = dir == 0 ? step : L - 1 - step;
            float v = cb;
#pragma unroll
            for (int q = 0; q < 4; ++q) { const int tt = dir == 0 ? t + q - 3 : t + 3 - q; if (tt >= 0 && tt < L) v += cw[q] * bf2f(u[(size_t)tt * D + ch]); }
            vs[j] = v;
            __syncthreads();
            float r = ba, i = bx;
#pragma unroll
            for (int k = 0; k < 64; ++k) { const float vk = vs[k]; r += vk * wa[k]; i += vk * wx[k]; }
            __syncthreads();
            r = sigmoidf_(r); i = sigmoidf_(i);
            const float la = c1 * r, a = __expf(la), bb = sqrtf(fmaxf(1.0f - __expf(2.0f * la), 0.f)) * (i * v);
            h = a * h + bb;
            if (seq == 1) hout[((size_t)b * SEQ + t) * D + ch] = f2bf(h);
        }
    }
}
__global__ __launch_bounds__(256) void nv_mix(P p) {
    const size_t idx = (size_t)blockIdx.x * 256 + threadIdx.x; const int m = (int)(idx / D), ch = (int)(idx % D);
    const int tb = m % SEQ, row = tb / GW, col = tb % GW;
    const bf16* U = (const bf16*)(p.ws + WS_U);
    float s = 0.f;
#pragma unroll
    for (int k = 0; k < 3; ++k) {
        const float w = p.conv_a_w[k * D + ch]; int mm; bool ok;
        if (ch < 512) { const int c2 = col + k - 1; ok = c2 >= 0 && c2 < GW; mm = m + k - 1; }
        else { const int r2 = row + k - 1; ok = r2 >= 0 && r2 < GROWS; mm = m + (k - 1) * GW; }
        if (ok) s += w * bf2f(U[(size_t)mm * D + ch]);
    }
    bf16* Z = (bf16*)(p.ws + WS_Z);
    Z[(size_t)m * 2048 + ch] = f2bf(bf2f(((const bf16*)(p.ws + WS_GB))[idx]) * s);
    const float hh = bf2f(((const bf16*)(p.ws + WS_HF))[idx]) + bf2f(((const bf16*)(p.ws + WS_HB))[idx]);
    Z[(size_t)m * 2048 + 1024 + ch] = f2bf(bf2f(((const bf16*)(p.ws + WS_GG))[idx]) * hh);
}
__global__ __launch_bounds__(256) void nv_route(P p) {
    const int row = blockIdx.x * 4 + (threadIdx.x >> 6), lane = threadIdx.x & 63;
    const float* mx = (const float*)(p.ws + WS_MX) + (row / SEQ) * 6144;
    const float* src = p.out + (size_t)row * D;
    float v[16]; float s = 0.f;
#pragma unroll
    for (int j = 0; j < 16; ++j) { v[j] = src[lane + 64 * j]; s += v[j] * v[j]; }
    const float rstd = rsqrtf(wave_sum(s) * (1.0f / D) + EPS);
    bf16* fx = (bf16*)(p.ws + WS_FX) + (size_t)row * D;
#pragma unroll
    for (int j = 0; j < 16; ++j) { const int k = lane + 64 * j; v[j] = v[j] * rstd * p.norm_ffn[k] * (1.0f + mx[4 * 1024 + k]) + mx[3 * 1024 + k]; fx[k] = f2bf(v[j]); }
    float lg[NE];
#pragma unroll
    for (int e = 0; e < NE; ++e) { float a = 0.f;
#pragma unroll
        for (int j = 0; j < 16; ++j) a += v[j] * p.router_w[(size_t)(lane + 64 * j) * NE + e];
        lg[e] = wave_sum(a) + p.router_b[e]; }
    if (lane == 0) {
        int idx[TOPK]; float val[TOPK]; unsigned used = 0u;
#pragma unroll
        for (int t = 0; t < TOPK; ++t) { int bi = -1; float bv = -3.0e38f;
#pragma unroll
            for (int e = 0; e < NE; ++e) { const bool free_ = !((used >> e) & 1u); if (free_ && lg[e] > bv) { bv = lg[e]; bi = e; } }
            idx[t] = bi; val[t] = bv; used |= 1u << bi; }
        float ex[TOPK], se = 0.f;
#pragma unroll
        for (int t = 0; t < TOPK; ++t) { ex[t] = __expf(val[t] - val[0]); se += ex[t]; }
        unsigned* cnt = (unsigned*)(p.ws + WS_CTL) + CW_CNT;
#pragma unroll
        for (int t = 0; t < TOPK; ++t) {
            const int e = idx[t]; const unsigned slot = atomicAdd(&cnt[e], 1u);
            ((int*)(p.ws + WS_TOK))[(size_t)e * M + slot] = row;
            ((float*)(p.ws + WS_GATE))[(size_t)e * M + slot] = ex[t] / se;
            ((int*)(p.ws + WS_INV))[(size_t)row * 4 + t] = e * M + (int)slot;
        }
    }
}
__global__ __launch_bounds__(256) void nv_final(P p) {
    const int row = blockIdx.x * 4 + (threadIdx.x >> 6), lane = threadIdx.x & 63;
    const float* mx = (const float*)(p.ws + WS_MX) + (row / SEQ) * 6144 + 5 * 1024;
    const unsigned* cnt = (const unsigned*)(p.ws + WS_CTL) + CW_CNT;
    const int* inv = (const int*)(p.ws + WS_INV) + (size_t)row * 4;
    const bf16* op[TOPK];
#pragma unroll
    for (int t = 0; t < TOPK; ++t) { const int e = inv[t] / M, slot = inv[t] % M; op[t] = (const bf16*)(p.ws + WS_OUTP) + (size_t)(expert_base(cnt, e) + slot) * D; }
    float* xo = p.out + (size_t)row * D;
    float v[16]; float s = 0.f;
#pragma unroll
    for (int j = 0; j < 16; ++j) { const int k = lane + 64 * j; float y = 0.f;
#pragma unroll
        for (int t = 0; t < TOPK; ++t) y += bf2f(op[t][k]);
        v[j] = xo[k] + mx[k] * y; s += v[j] * v[j]; }
    const float rstd = rsqrtf(wave_sum(s) * (1.0f / D) + EPS);
#pragma unroll
    for (int j = 0; j < 16; ++j) { const int k = lane + 64 * j; xo[k] = v[j] * rstd * p.norm_final[k]; }
}

#define LAS __attribute__((address_space(3)))
#define GAS __attribute__((address_space(1)))
typedef short bf16x8 __attribute__((ext_vector_type(8)));
typedef float f32x4 __attribute__((ext_vector_type(4)));
typedef float f32x2 __attribute__((ext_vector_type(2)));
typedef unsigned u32x4 __attribute__((ext_vector_type(4)));
typedef unsigned u32x2 __attribute__((ext_vector_type(2)));
constexpr int NWAVES = 8, NTHR = 512;
constexpr int RING_BYTES = 131072, AUX_OFF = RING_BYTES, AUX_BYTES = 20480, MISC_OFF = AUX_OFF + AUX_BYTES, LDS_BYTES = MISC_OFF + 512;
constexpr int CW_BAR = 4096;
constexpr size_t CTL_ZERO_BYTES = 131072;

__device__ __forceinline__ unsigned cvt_pk_bf16(float lo, float hi) { unsigned r; asm volatile("v_cvt_pk_bf16_f32 %0, %1, %2" : "=v"(r) : "v"(lo), "v"(hi)); return r; }
__device__ __forceinline__ unsigned pk2(float lo, float hi) { return (unsigned)f2bf(lo) | ((unsigned)f2bf(hi) << 16); }
__device__ __forceinline__ float bflo(unsigned w) { return __uint_as_float(w << 16); }
__device__ __forceinline__ float bfhi(unsigned w) { return __uint_as_float(w & 0xffff0000u); }
__device__ __forceinline__ float fsig(float v) { return __builtin_amdgcn_rcpf(1.0f + __expf(-v)); }
#define LDS_WAIT() asm volatile("s_waitcnt lgkmcnt(0)" ::: "memory")
#define VM_WAIT() asm volatile("s_waitcnt vmcnt(0)" ::: "memory")

namespace pg8 {
constexpr int BM = 256, BK = 64, HALF = 128, HTB = HALF * BK * 2, STAGE_BYTES = 8 * HTB;
__host__ __device__ __forceinline__ int lds_byte(int r, int c) { const int st = (r >> 4) * 2 + (c >> 5), rr = r & 15, cc = c & 31, ob = rr * 64 + cc * 2; return st * 1024 + (ob ^ (((ob >> 9) & 1) << 5)); }
__host__ __device__ __forceinline__ void stage_rc(int b, int& R, int& C) { const int st = b / 1024, sb = b % 1024, swz = sb ^ (((sb >> 9) & 1) << 5); R = (st >> 1) * 16 + swz / 64; C = (st & 1) * 32 + (swz % 64) / 2; }
__host__ __device__ __forceinline__ int perm32(int rho) { const int n = rho >> 4, i = rho & 15; return 8 * (i >> 2) + 4 * n + (i & 3); }

struct Unit { const char* A; const char* B; const int* gat; int gcnt, grow0; int kind, row0, ocol, e, slot0; };

__device__ __forceinline__ void arows(const Unit& u, unsigned (&rp)[2]) {
    int R[2], C[2];
#pragma unroll
    for (int i = 0; i < 2; ++i) stage_rc((int)threadIdx.x * 16 + i * 8192, R[i], C[i]);
#pragma unroll
    for (int h = 0; h < 2; ++h) {
        int r[2];
#pragma unroll
        for (int i = 0; i < 2; ++i) { r[i] = h * HALF + R[i]; if (u.gat) { const int gr = u.grow0 + r[i]; r[i] = gr < u.gcnt ? u.gat[gr] : 0; } }
        rp[h] = (unsigned)r[0] | ((unsigned)r[1] << 16);
    }
}

template <class Epi, class Sched, bool MID>
__device__ __forceinline__ void gemm_phase(LAS unsigned char* lds, const int K, const Sched& S, const Epi& E) {
    const int tid = threadIdx.x, wid = __builtin_amdgcn_readfirstlane(tid >> 6), lane = tid & 63, wr = wid >> 2, wc = wid & 3, fr = lane & 15, fq = lane >> 4;
    const int nt = K / BK;
    unsigned voffB[2], cpk = 0u;
    const int kshift = (K == 2048) ? 12 : 11;
#pragma unroll
    for (int i = 0; i < 2; ++i) { int R, C; stage_rc(tid * 16 + i * 8192, R, C); const int Rb = Epi::PERM ? ((R & ~31) + perm32(R & 31)) : R; voffB[i] = (unsigned)(Rb * K + C) * 2u; cpk |= (unsigned)(C * 2) << (8 * i); }
    const size_t kstep = (size_t)(BK * 2);
    const size_t hstep = (size_t)HALF * K * 2;
    const unsigned ldsw = (unsigned)wid * 1024u;
    const int aoff = lds_byte(wr * 64 + fr, fq * 8), boff = lds_byte(wc * 32 + fr, fq * 8);
#define PG8_SA(b, h) (((b) * 2 + (h)) * HTB)
#define PG8_SB(b, h) ((4 + (b) * 2 + (h)) * HTB)
#define PG8_STAGE(bufoff, gbase, voff) do { _Pragma("unroll") for (int _i = 0; _i < 2; ++_i) \
        __builtin_amdgcn_global_load_lds((const unsigned*)((const char*)(gbase) + (voff)[_i]), (LAS unsigned*)(lds + (bufoff) + ldsw + _i * 8192), 16, 0, 0); } while (0)
#define PG8_STAGE_A(bufoff, gbase, rpk) do { _Pragma("unroll") for (int _i = 0; _i < 2; ++_i) \
        __builtin_amdgcn_global_load_lds((const unsigned*)((const char*)(gbase) + (((((rpk) >> (16 * _i)) & 0xffffu) << kshift) + ((cpk >> (8 * _i)) & 0xffu))), (LAS unsigned*)(lds + (bufoff) + ldsw + _i * 8192), 16, 0, 0); } while (0)
#define PG8_LDA(dst, b, h) do { _Pragma("unroll") for (int m = 0; m < 4; ++m) _Pragma("unroll") for (int k = 0; k < 2; ++k) dst[m][k] = *(const LAS bf16x8*)(lds + PG8_SA(b, h) + aoff + m * 2048 + k * 1024); } while (0)
#define PG8_LDB(dst, b, h) do { _Pragma("unroll") for (int n = 0; n < 2; ++n) _Pragma("unroll") for (int k = 0; k < 2; ++k) dst[n][k] = *(const LAS bf16x8*)(lds + PG8_SB(b, h) + boff + n * 2048 + k * 1024); } while (0)
#define PG8_MMA(ai, bj, At, Bt) do { __builtin_amdgcn_s_setprio(1); _Pragma("unroll") for (int m = 0; m < 4; ++m) _Pragma("unroll") for (int n = 0; n < 2; ++n) _Pragma("unroll") for (int k = 0; k < 2; ++k) \
        acc[ai][bj][m][n] = __builtin_amdgcn_mfma_f32_16x16x32_bf16(Bt[n][k], At[m][k], acc[ai][bj][m][n], 0, 0, 0); __builtin_amdgcn_s_setprio(0); } while (0)
#define PG8_WAIT_V(n) asm volatile("s_waitcnt vmcnt(" #n ")" ::: "memory")
#define PG8_WAIT_L(n) asm volatile("s_waitcnt lgkmcnt(" #n ")" ::: "memory")
#define PG8_BAR __builtin_amdgcn_s_barrier()
#define PG8_SCHED __builtin_amdgcn_sched_barrier(0)
    Unit cur, nxt; int ui = 0;
    if (!S.next(0, cur)) return;
    f32x4 acc[2][2][4][2];
#pragma unroll
    for (int a = 0; a < 2; ++a)
#pragma unroll
        for (int b = 0; b < 2; ++b)
#pragma unroll
            for (int m = 0; m < 4; ++m)
#pragma unroll
                for (int n = 0; n < 2; ++n) acc[a][b][m][n] = (f32x4){0.f, 0.f, 0.f, 0.f};
    bf16x8 At[4][2], B0[2][2], B1[2][2];
    unsigned oA[2];
    arows(cur, oA);
    const char* cA = cur.A; const char* cB = cur.B;
    PG8_STAGE(PG8_SB(0, 0), cB, voffB); PG8_STAGE(PG8_SB(0, 1), cB + hstep, voffB); PG8_STAGE_A(PG8_SA(0, 0), cA, oA[0]); PG8_STAGE_A(PG8_SA(0, 1), cA, oA[1]);
    if (wr == 1) PG8_BAR;
    PG8_WAIT_V(2); PG8_BAR;
    PG8_STAGE(PG8_SB(1, 0), cB + kstep, voffB); PG8_STAGE_A(PG8_SA(1, 0), cA + kstep, oA[0]); PG8_STAGE(PG8_SB(1, 1), cB + hstep + kstep, voffB);
    PG8_WAIT_V(6); PG8_BAR;
    for (;;) {
        const bool has_next = S.next(ui + 1, nxt);
        const char* nA = has_next ? nxt.A : cA; const char* nB = has_next ? nxt.B : cB;
        for (int t = 0; t < nt; t += 2) {
            const bool last = (t == nt - 2);
            if (MID && t == nt / 2) E.mid(acc, cur, wr, wc, fr, fq);
            const char* a1 = cA + (size_t)(t + 1) * kstep;
            const char* a2 = last ? nA : cA + (size_t)(t + 2) * kstep; const char* b2 = last ? nB : cB + (size_t)(t + 2) * kstep;
            const char* a3 = a2 + kstep; const char* b3 = b2 + kstep;
            unsigned nO[2];
            if (last) { if (has_next) arows(nxt, nO); else { nO[0] = oA[0]; nO[1] = oA[1]; } }
            PG8_LDB(B0, 0, 0); PG8_LDB(B1, 0, 1); PG8_SCHED; PG8_LDA(At, 0, 0); PG8_STAGE_A(PG8_SA(1, 1), a1, oA[1]);
            PG8_WAIT_V(8); PG8_WAIT_L(0); PG8_BAR; PG8_MMA(0, 0, At, B0); PG8_MMA(0, 1, At, B1); PG8_BAR; PG8_SCHED;
            if (last) { oA[0] = nO[0]; oA[1] = nO[1]; }
            PG8_LDA(At, 0, 1); PG8_STAGE(PG8_SB(0, 0), b2, voffB); PG8_STAGE(PG8_SB(0, 1), b2 + hstep, voffB); PG8_STAGE_A(PG8_SA(0, 0), a2, oA[0]);
            PG8_WAIT_V(8); PG8_WAIT_L(0); PG8_BAR; PG8_MMA(1, 0, At, B0); PG8_MMA(1, 1, At, B1); PG8_BAR; PG8_SCHED;
            PG8_LDB(B0, 1, 0); PG8_LDB(B1, 1, 1); PG8_SCHED; PG8_LDA(At, 1, 0); PG8_STAGE_A(PG8_SA(0, 1), a2, oA[1]);
            PG8_WAIT_V(8); PG8_WAIT_L(0); PG8_BAR; PG8_MMA(0, 0, At, B0); PG8_MMA(0, 1, At, B1); PG8_BAR; PG8_SCHED;
            PG8_LDA(At, 1, 1); PG8_STAGE(PG8_SB(1, 0), b3, voffB); PG8_STAGE(PG8_SB(1, 1), b3 + hstep, voffB); PG8_STAGE_A(PG8_SA(1, 0), a3, oA[0]);
            PG8_WAIT_V(8); PG8_WAIT_L(0); PG8_BAR; PG8_MMA(1, 0, At, B0); PG8_MMA(1, 1, At, B1); PG8_BAR; PG8_SCHED;
        }
        if (wr == 0) PG8_BAR;
        E(acc, cur, wr, wc, fr, fq);
        if (!has_next) break;
#pragma unroll
        for (int a = 0; a < 2; ++a)
#pragma unroll
            for (int b = 0; b < 2; ++b)
#pragma unroll
                for (int m = 0; m < 4; ++m)
#pragma unroll
                    for (int n = 0; n < 2; ++n) acc[a][b][m][n] = (f32x4){0.f, 0.f, 0.f, 0.f};
        cur = nxt; cA = nA; cB = nB; ++ui;
        if (wr == 1) PG8_BAR;
    }
    PG8_WAIT_V(0);
    PG8_BAR;
#undef PG8_SA
#undef PG8_SB
#undef PG8_STAGE
#undef PG8_STAGE_A
#undef PG8_LDA
#undef PG8_LDB
#undef PG8_MMA
#undef PG8_WAIT_V
#undef PG8_WAIT_L
#undef PG8_BAR
#undef PG8_SCHED
}
__device__ __forceinline__ void static_order(int L, int nM, int nN, int& pm, int& pn) {
    const int nwg = nM * nN; int wgid = L;
    { const int q = nwg / 8, r = nwg % 8, xcd = wgid % 8, off = wgid / 8; wgid = (xcd < r ? xcd * (q + 1) : r * (q + 1) + (xcd - r) * q) + off; }
    const int nig = 8 * nN, gid = wgid / nig, fm = gid * 8, gsz = (nM - fm) < 8 ? (nM - fm) : 8;
    pm = fm + ((wgid % nig) % gsz); pn = (wgid % nig) / gsz;
}
}
using pg8::Unit;

struct SchedInProj {
    const char *HX, *HC, *WIN; int G, c;
    __device__ __forceinline__ bool next(int i, Unit& u) const {
        const int L = i * G + c; if (L >= 3584 + 16) return false;
        int pm, pn; bool ctx = false;
        if (L < 3584) { pg8::static_order(L, 128, 28, pm, pn); u.A = HX + (size_t)pm * 256 * D * 2; }
        else { const int r = L - 3584; pm = r >> 2; pn = 12 + (r & 3); u.A = HC + (size_t)pm * 256 * D * 2; ctx = true; }
        u.B = WIN + (size_t)pn * 256 * D * 2; u.gat = nullptr; u.gcnt = 0; u.grow0 = 0; u.row0 = pm * 256; u.e = 0; u.slot0 = 0;
        if (pn < 4) { u.kind = 0; u.ocol = pn * 256; }
        else if (pn < 12) { u.kind = 1; u.ocol = (pn - 4) * 128; }
        else if (pn < 16) { u.kind = ctx ? 5 : 2; u.ocol = (pn - 12) * 256; }
        else if (pn < 20) { u.kind = 3; u.ocol = (pn - 16) * 256; }
        else { u.kind = 4; u.ocol = (pn - 20) * 128; }
        return true;
    }
};
struct SchedDense {
    const char *A, *B; int K, G, c;
    __device__ __forceinline__ bool next(int i, Unit& u) const {
        const int L = i * G + c; if (L >= 128 * 4) return false;
        int pm, pn; pg8::static_order(L, 128, 4, pm, pn);
        u.A = A + (size_t)pm * 256 * K * 2; u.B = B + (size_t)pn * 256 * K * 2; u.gat = nullptr; u.gcnt = 0; u.grow0 = 0; u.kind = 0; u.row0 = pm * 256; u.ocol = pn * 256; u.e = 0; u.slot0 = 0;
        return true;
    }
};
struct SchedMoe {
    const char *Abase, *W; const int* tok; const LAS int* tab; int npn, G, c, gather, wrows;
    __device__ __forceinline__ bool next(int i, Unit& u) const {
        const int L = i * G + c; if (L >= tab[32]) return false;
        int e = 0;
#pragma unroll
        for (int s = 16; s >= 1; s >>= 1) if (tab[e + s] <= L) e += s;
        const int cnt = tab[33 + e], tiles = (cnt + 255) >> 8, l = L - tab[e], pn = l / tiles, mt = l - pn * tiles, rb = tab[65 + e] + mt * 256;
        u.e = e; u.slot0 = mt * 256; u.row0 = rb; u.kind = 0; u.gcnt = cnt; u.grow0 = mt * 256;
        u.B = W + ((size_t)e * wrows + (size_t)pn * 256) * DE * 2;
        if (gather) { u.A = Abase; u.gat = tok + (size_t)e * M; u.ocol = pn * 128; }
        else { u.A = Abase + (size_t)rb * DE * 2; u.gat = nullptr; u.ocol = pn * 256; }
        return true;
    }
};
__device__ __forceinline__ void moe_tables(LAS int* tab, const unsigned* gcnt, int npn) {
    if (threadIdx.x == 0) { int pu = 0, pr = 0; for (int e = 0; e < NE; ++e) { const int c = (int)gcnt[e], t = (c + 255) >> 8; tab[e] = pu; tab[33 + e] = c; tab[65 + e] = pr; pu += t * npn; pr += t * 256; } tab[32] = pu; }
    __syncthreads();
}

struct EpiInProj {
    static constexpr bool PERM = true;
    unsigned char* ws; const float* bmerge;
    __device__ __forceinline__ void mid(f32x4 (&)[2][2][4][2], const Unit&, int, int, int, int) const {}
    __device__ __forceinline__ void operator()(const f32x4 (&acc)[2][2][4][2], const Unit& u, int wr, int wc, int fr, int fq) const {
        int row0 = u.row0 + wr * 64 + fr; asm volatile("" : "+v"(row0)); const int cl = wc * 32 + 8 * fq;
        if (u.kind == 1) {
            bf16* base = (bf16*)(ws + WS_U) + u.ocol + cl;
#pragma unroll
            for (int ai = 0; ai < 2; ++ai)
#pragma unroll
                for (int m = 0; m < 4; ++m) { const f32x4 v0 = acc[ai][0][m][0] * acc[ai][1][m][0], v1 = acc[ai][0][m][1] * acc[ai][1][m][1];
                    u32x4 w; w.x = cvt_pk_bf16(v0[0], v0[1]); w.y = cvt_pk_bf16(v0[2], v0[3]); w.z = cvt_pk_bf16(v1[0], v1[1]); w.w = cvt_pk_bf16(v1[2], v1[3]);
                    *(u32x4*)(base + (size_t)(row0 + ai * 128 + m * 16) * D) = w; }
        } else if (u.kind == 4) {
            bf16* rat = (bf16*)(ws + WS_RAT) + u.ocol + cl; bf16* sbg = (bf16*)(ws + WS_SBG) + u.ocol + cl;
            f32x4 ba[2], bb[2];
#pragma unroll
            for (int n = 0; n < 2; ++n) { ba[n] = *(const f32x4*)(bmerge + u.ocol + cl + 4 * n); bb[n] = *(const f32x4*)(bmerge + D + u.ocol + cl + 4 * n); }
#pragma unroll
            for (int ai = 0; ai < 2; ++ai)
#pragma unroll
                for (int m = 0; m < 4; ++m) { f32x4 r[2], s[2];
#pragma unroll
                    for (int n = 0; n < 2; ++n)
#pragma unroll
                        for (int j = 0; j < 4; ++j) { const float ea = __expf(-(acc[ai][0][m][n][j] + ba[n][j])), eb = __expf(-(acc[ai][1][m][n][j] + bb[n][j]));
                            s[n][j] = __builtin_amdgcn_rcpf(1.0f + eb); r[n][j] = (1.0f + eb) * __builtin_amdgcn_rcpf(1.0f + ea); }
                    u32x4 w; w.x = cvt_pk_bf16(r[0][0], r[0][1]); w.y = cvt_pk_bf16(r[0][2], r[0][3]); w.z = cvt_pk_bf16(r[1][0], r[1][1]); w.w = cvt_pk_bf16(r[1][2], r[1][3]);
                    u32x4 x; x.x = cvt_pk_bf16(s[0][0], s[0][1]); x.y = cvt_pk_bf16(s[0][2], s[0][3]); x.z = cvt_pk_bf16(s[1][0], s[1][1]); x.w = cvt_pk_bf16(s[1][2], s[1][3]);
                    const size_t o = (size_t)(row0 + ai * 128 + m * 16) * D; *(u32x4*)(rat + o) = w; *(u32x4*)(sbg + o) = x; }
        } else {
            bf16* base = (bf16*)(ws + (u.kind == 0 ? WS_GB : u.kind == 2 ? WS_ULRU : u.kind == 3 ? WS_GG : WS_CS3)) + u.ocol + cl;
            const bool gelu = u.kind == 3;
#pragma unroll
            for (int ai = 0; ai < 2; ++ai)
#pragma unroll
                for (int m = 0; m < 4; ++m)
#pragma unroll
                    for (int bj = 0; bj < 2; ++bj) { f32x4 v0 = acc[ai][bj][m][0], v1 = acc[ai][bj][m][1];
                        if (gelu) {
#pragma unroll
                            for (int j = 0; j < 4; ++j) { v0[j] = gelu_tanh(v0[j]); v1[j] = gelu_tanh(v1[j]); } }
                        u32x4 w; w.x = cvt_pk_bf16(v0[0], v0[1]); w.y = cvt_pk_bf16(v0[2], v0[3]); w.z = cvt_pk_bf16(v1[0], v1[1]); w.w = cvt_pk_bf16(v1[2], v1[3]);
                        *(u32x4*)(base + (size_t)(row0 + ai * 128 + m * 16) * D + bj * 128) = w; }
        }
    }
};
struct EpiMerge {
    static constexpr bool PERM = true;
    unsigned char* ws;
    __device__ __forceinline__ void mid(f32x4 (&acc)[2][2][4][2], const Unit& u, int wr, int wc, int fr, int fq) const {
        const bf16* rat = (const bf16*)(ws + WS_RAT) + u.ocol + wc * 32 + 8 * fq; int row0 = u.row0 + wr * 64 + fr; asm volatile("" : "+v"(row0));
#pragma unroll
        for (int ai = 0; ai < 2; ++ai)
#pragma unroll
            for (int m = 0; m < 4; ++m) {
#pragma unroll
                for (int bj = 0; bj < 2; ++bj) { const u32x4 w = *(const u32x4*)(rat + (size_t)(row0 + ai * 128 + m * 16) * D + bj * 128);
                    acc[ai][bj][m][0] *= (f32x4){bflo(w.x), bfhi(w.x), bflo(w.y), bfhi(w.y)}; acc[ai][bj][m][1] *= (f32x4){bflo(w.z), bfhi(w.z), bflo(w.w), bfhi(w.w)}; }
                asm volatile("" ::: "memory"); }
    }
    __device__ __forceinline__ void operator()(const f32x4 (&acc)[2][2][4][2], const Unit& u, int wr, int wc, int fr, int fq) const {
        const bf16* sbg = (const bf16*)(ws + WS_SBG) + u.ocol + wc * 32 + 8 * fq; bf16* mg = (bf16*)(ws + WS_MG) + u.ocol + wc * 32 + 8 * fq; int row0 = u.row0 + wr * 64 + fr; asm volatile("" : "+v"(row0));
#pragma unroll
        for (int ai = 0; ai < 2; ++ai)
#pragma unroll
            for (int m = 0; m < 4; ++m) {
#pragma unroll
                for (int bj = 0; bj < 2; ++bj) { const size_t o = (size_t)(row0 + ai * 128 + m * 16) * D + bj * 128; const u32x4 w = *(const u32x4*)(sbg + o);
                    const f32x4 v0 = acc[ai][bj][m][0] * (f32x4){bflo(w.x), bfhi(w.x), bflo(w.y), bfhi(w.y)}, v1 = acc[ai][bj][m][1] * (f32x4){bflo(w.z), bfhi(w.z), bflo(w.w), bfhi(w.w)};
                    u32x4 x; x.x = cvt_pk_bf16(v0[0], v0[1]); x.y = cvt_pk_bf16(v0[2], v0[3]); x.z = cvt_pk_bf16(v1[0], v1[1]); x.w = cvt_pk_bf16(v1[2], v1[3]);
                    *(u32x4*)(mg + o) = x; }
                asm volatile("" ::: "memory"); }
    }
};
struct EpiWo {
    static constexpr bool PERM = false;
    const float* x; float* out; const float* mx;
    __device__ __forceinline__ void mid(f32x4 (&)[2][2][4][2], const Unit&, int, int, int, int) const {}
    __device__ __forceinline__ void operator()(const f32x4 (&acc)[2][2][4][2], const Unit& u, int wr, int wc, int fr, int fq) const {
        int row0 = u.row0 + wr * 64 + fr; asm volatile("" : "+v"(row0)); const int col0 = u.ocol + wc * 32 + 4 * fq;
        const float* gp = mx + (u.row0 / SEQ) * 6144 + 2 * 1024 + col0;
        f32x4 g[2][2];
#pragma unroll
        for (int bj = 0; bj < 2; ++bj)
#pragma unroll
            for (int n = 0; n < 2; ++n) g[bj][n] = *(const f32x4*)(gp + bj * 128 + n * 16);
#pragma unroll
        for (int ai = 0; ai < 2; ++ai)
#pragma unroll
            for (int m = 0; m < 4; ++m) { const size_t o = (size_t)(row0 + ai * 128 + m * 16) * D + col0;
#pragma unroll
                for (int bj = 0; bj < 2; ++bj)
#pragma unroll
                    for (int n = 0; n < 2; ++n) { const f32x4 xv = *(const f32x4*)(x + o + bj * 128 + n * 16); *(f32x4*)(out + o + bj * 128 + n * 16) = xv + g[bj][n] * acc[ai][bj][m][n]; }
                asm volatile("" ::: "memory"); }
    }
};
struct EpiMoe1 {
    static constexpr bool PERM = true;
    unsigned char* ws; const float* b1;
    __device__ __forceinline__ void mid(f32x4 (&)[2][2][4][2], const Unit&, int, int, int, int) const {}
    __device__ __forceinline__ void operator()(const f32x4 (&acc)[2][2][4][2], const Unit& u, int wr, int wc, int fr, int fq) const {
        int row0 = u.row0 + wr * 64 + fr; asm volatile("" : "+v"(row0)); const int j0 = u.ocol + wc * 32 + 8 * fq;
        const float* bp = b1 + (size_t)u.e * 2048 + 2 * j0;
        f32x4 bv[4];
#pragma unroll
        for (int i = 0; i < 4; ++i) bv[i] = *(const f32x4*)(bp + 4 * i);
        bf16* base = (bf16*)(ws + WS_ACT) + j0;
#pragma unroll
        for (int ai = 0; ai < 2; ++ai)
#pragma unroll
            for (int m = 0; m < 4; ++m) { f32x4 a[2];
#pragma unroll
                for (int n = 0; n < 2; ++n)
#pragma unroll
                    for (int jj = 0; jj < 4; ++jj) { const float hg = acc[ai][0][m][n][jj] + bv[2 * n + (jj >> 1)][2 * (jj & 1)], hl = acc[ai][1][m][n][jj] + bv[2 * n + (jj >> 1)][2 * (jj & 1) + 1];
                        const float glu = fminf(hg, 7.0f), lin = fminf(fmaxf(hl, -7.0f), 7.0f);
                        a[n][jj] = glu * fsig(1.702f * glu) * (lin + 1.0f); }
                u32x4 w; w.x = cvt_pk_bf16(a[0][0], a[0][1]); w.y = cvt_pk_bf16(a[0][2], a[0][3]); w.z = cvt_pk_bf16(a[1][0], a[1][1]); w.w = cvt_pk_bf16(a[1][2], a[1][3]);
                *(u32x4*)(base + (size_t)(row0 + ai * 128 + m * 16) * DE) = w; }
    }
};
struct EpiMoe2 {
    static constexpr bool PERM = true;
    unsigned char* ws; const float* b2;
    __device__ __forceinline__ void mid(f32x4 (&)[2][2][4][2], const Unit&, int, int, int, int) const {}
    __device__ __forceinline__ void operator()(const f32x4 (&acc)[2][2][4][2], const Unit& u, int wr, int wc, int fr, int fq) const {
        int rl = wr * 64 + fr; asm volatile("" : "+v"(rl)); const int c0 = u.ocol + wc * 32 + 8 * fq;
        const float* bp = b2 + (size_t)u.e * D + c0; const float* gp = (const float*)(ws + WS_GATE) + (size_t)u.e * M + u.slot0 + rl;
        f32x4 bv[2][2];
#pragma unroll
        for (int bj = 0; bj < 2; ++bj)
#pragma unroll
            for (int n = 0; n < 2; ++n) bv[bj][n] = *(const f32x4*)(bp + bj * 128 + 4 * n);
        bf16* base = (bf16*)(ws + WS_OUTP) + c0;
#pragma unroll
        for (int ai = 0; ai < 2; ++ai)
#pragma unroll
            for (int m = 0; m < 4; ++m) { const float g = gp[ai * 128 + m * 16];
#pragma unroll
                for (int bj = 0; bj < 2; ++bj) { const f32x4 v0 = (acc[ai][bj][m][0] + bv[bj][0]) * g, v1 = (acc[ai][bj][m][1] + bv[bj][1]) * g;
                    u32x4 w; w.x = cvt_pk_bf16(v0[0], v0[1]); w.y = cvt_pk_bf16(v0[2], v0[3]); w.z = cvt_pk_bf16(v1[0], v1[1]); w.w = cvt_pk_bf16(v1[2], v1[3]);
                    *(u32x4*)(base + (size_t)(u.row0 + rl + ai * 128 + m * 16) * D + bj * 128) = w; } }
    }
};
#define XB_TMO      128
#define XB_XCNT(j)  (256  + 64 * (j))
#define XB_XSUB(j)  (1280 + 64 * (j))
#define XB_XGEN(j)  (2304 + 64 * (j))
#define XB_TOP      3328
#define XB_TOPGEN   3392
#define XCD_BAR_WORDS 3456
#define XB_SPIN_CAP (1u << 18)
__device__ __forceinline__ unsigned xb_ld(unsigned* p)              { return __hip_atomic_load(p, __ATOMIC_RELAXED, __HIP_MEMORY_SCOPE_AGENT); }
__device__ __forceinline__ unsigned xb_add(unsigned* p, unsigned v) { return __hip_atomic_fetch_add(p, v, __ATOMIC_RELAXED, __HIP_MEMORY_SCOPE_AGENT); }
__device__ __forceinline__ unsigned xb_xcc_id() { return (unsigned)__builtin_amdgcn_s_getreg((3 << 11) | 20) & 0xFu; }
#define XB_SPIN(cond, bar) do { unsigned _sp = 0; while (cond) { __builtin_amdgcn_s_sleep(1); \
    if ((++_sp & 255u) == 0u) { if (xb_ld(&(bar)[XB_TMO])) break; if (_sp > XB_SPIN_CAP) { atomicAdd(&(bar)[XB_TMO], 1u); break; } } } } while (0)
struct XcdBarrier { unsigned* bar; unsigned x; volatile LAS unsigned* st; };
__device__ __forceinline__ XcdBarrier xcd_barrier_post(unsigned* bar, volatile LAS unsigned* st) {
    XcdBarrier b; b.bar = bar; b.x = xb_xcc_id(); b.st = st;
    if (threadIdx.x == 0) (void)xb_add(&bar[XB_XCNT(b.x)], 1u);
    return b;
}
__device__ __forceinline__ void xcd_barrier_complete(unsigned* bar, unsigned x, unsigned& nloc, unsigned& nx) {
    const unsigned G = gridDim.x * gridDim.y * gridDim.z;
    unsigned sum, cnt, mine, sp = 0u;
    for (;;) {
        sum = 0u; cnt = 0u; mine = 0u;
#pragma unroll
        for (unsigned j = 0; j < 16; ++j) { const unsigned c = xb_ld(&bar[XB_XCNT(j)]); sum += c; cnt += (c > 0u) ? 1u : 0u; mine = (j == x) ? c : mine; }
        if (sum == G) break;
        __builtin_amdgcn_s_sleep(1);
        if ((++sp & 255u) == 0u) { if (xb_ld(&bar[XB_TMO])) break; if (sp > XB_SPIN_CAP) { atomicAdd(&bar[XB_TMO], 1u); break; } }
    }
    nloc = mine > 0u ? mine : 1u; nx = cnt > 0u ? cnt : 1u;
}
__device__ __forceinline__ void xcd_barrier(const XcdBarrier& b) {
    asm volatile("s_waitcnt vmcnt(0)" ::: "memory");
    __syncthreads();
    if (threadIdx.x == 0) {
        unsigned* bar = b.bar;
        __builtin_amdgcn_s_waitcnt(0);
        unsigned nloc = b.st[0], nx = b.st[1];
        if (nloc == 0u) { xcd_barrier_complete(bar, b.x, nloc, nx); b.st[0] = nloc; b.st[1] = nx; }
        const unsigned old = xb_add(&bar[XB_XSUB(b.x)], 1u);
        const unsigned gen = old / nloc;
        if (old + 1u == (gen + 1u) * nloc) {
            __builtin_amdgcn_fence(__ATOMIC_RELEASE, "agent");
            asm volatile("s_waitcnt vmcnt(0)" ::: "memory");
            const unsigned og = xb_add(&bar[XB_TOP], 1u);
            const unsigned tg = og / nx;
            if (og + 1u == (tg + 1u) * nx) xb_add(&bar[XB_TOPGEN], 1u);
            else XB_SPIN(xb_ld(&bar[XB_TOPGEN]) == tg, bar);
            __builtin_amdgcn_fence(__ATOMIC_ACQUIRE, "agent");
            xb_add(&bar[XB_XGEN(b.x)], 1u);
            asm volatile("s_waitcnt vmcnt(0)" ::: "memory");
        } else {
            XB_SPIN(xb_ld(&bar[XB_XGEN(b.x)]) == gen, bar);
            __builtin_amdgcn_fence(__ATOMIC_ACQUIRE, "agent");
            asm volatile("s_waitcnt vmcnt(0)" ::: "memory");
        }
    }
    __syncthreads();
}

struct Frame {
    LAS unsigned char* lds; const P& p;
    int tid, lane, wave, vcu, G;
};

template <class RowMap>
__device__ __forceinline__ void p0_transpose_item(const float* W, int N, bf16* WT, int ldt, int coloff, LAS float* scr, int kb, int nb, int lane, RowMap rm) {
    const int k0 = 64 * kb, n0 = 32 * nb;
    float v[32];
#pragma unroll
    for (int i = 0; i < 32; ++i) { const int kk = 2 * i + (lane >> 5); v[i] = W[(size_t)(k0 + kk) * N + n0 + (lane & 31)]; }
#pragma unroll
    for (int i = 0; i < 32; ++i) { const int kk = 2 * i + (lane >> 5); scr[kk * 33 + (lane & 31)] = v[i]; }
    LDS_WAIT(); asm volatile("" ::: "memory");
    const int c = lane & 7;
#pragma unroll
    for (int j = 0; j < 4; ++j) { const int n = (lane >> 3) + 8 * j; const LAS float* s = scr + (8 * c) * 33 + n;
        u32x4 o; o.x = pk2(s[0 * 33], s[1 * 33]); o.y = pk2(s[2 * 33], s[3 * 33]); o.z = pk2(s[4 * 33], s[5 * 33]); o.w = pk2(s[6 * 33], s[7 * 33]);
        *(u32x4*)(WT + (size_t)rm(n0 + n) * ldt + coloff + k0 + 8 * c) = o; }
    LDS_WAIT(); asm volatile("" ::: "memory");
}
struct RmId { __device__ __forceinline__ int operator()(int n) const { return n; } };
struct RmWin { __device__ __forceinline__ int operator()(int n) const { const int g = n >> 10, ch = n & 1023;
    return g == 0 ? ch : g == 1 ? 1024 + 256 * (ch >> 7) + (ch & 127) : g == 2 ? 1024 + 256 * (ch >> 7) + 128 + (ch & 127) : g == 3 ? 3072 + ch : g == 4 ? 4096 + ch : g == 5 ? 5120 + 256 * (ch >> 7) + (ch & 127) : 5120 + 256 * (ch >> 7) + 128 + (ch & 127); } };
struct RmW1 { __device__ __forceinline__ int operator()(int n) const { const int j = n >> 1, h = n & 1; return 256 * (j >> 7) + 128 * h + (j & 127); } };
struct RmGen { int kind, off; __device__ __forceinline__ int operator()(int n) const { return kind == 1 ? RmWin{}(n) : kind == 2 ? RmW1{}(n) : off + n; } };

constexpr int I_ADA = 96, I_WIN = 16 * 224, I_WA = 16 * 32, I_WO = 16 * 32, I_W1 = NE * 16 * 64, I_W2 = NE * 16 * 32, I_LG = 2 * 16 * 2 * 2;
constexpr int P0_ITEMS = I_ADA + I_WIN + 2 * I_WA + I_WO + I_W1 + I_W2 + I_LG;
constexpr size_t WS_WG = 15 * MiB + 512 * 1024;

__device__ __forceinline__ void p0_prologue(Frame& F) {
    const P& p = F.p;
    LAS float* sil = (LAS float*)(F.lds + AUX_OFF);
    for (int i = F.tid; i < 5 * D; i += NTHR) { const int r = i >> 10, k = i & 1023; const float v = r < 4 ? p.c[r * D + k] : p.c_ctx[k]; sil[i] = v * sigmoidf_(v); }
    __syncthreads();
    LAS float* scr = (LAS float*)(F.lds + F.wave * 16384);
    const int gw = F.vcu * NWAVES + F.wave, NGW = F.G * NWAVES;
    for (int it = gw; it < P0_ITEMS; it += NGW) {
        int r = it;
        if (r < I_ADA) {
            const int n = 64 * r + F.lane; float a[5] = {0.f, 0.f, 0.f, 0.f, 0.f};
            for (int k = 0; k < D; k += 16) {
                float w[16];
#pragma unroll
                for (int j = 0; j < 16; ++j) w[j] = p.w_ada[(size_t)(k + j) * 6144 + n];
#pragma unroll
                for (int j4 = 0; j4 < 4; ++j4)
#pragma unroll
                    for (int rr = 0; rr < 5; ++rr) { const f32x4 s = *(const LAS f32x4*)(sil + rr * D + k + 4 * j4); a[rr] += s[0] * w[4 * j4] + s[1] * w[4 * j4 + 1] + s[2] * w[4 * j4 + 2] + s[3] * w[4 * j4 + 3]; }
            }
            float* mx = (float*)(p.ws + WS_MX);
#pragma unroll
            for (int rr = 0; rr < 5; ++rr) mx[rr * 6144 + n] = a[rr] + p.b_ada[n];
            continue;
        }
        r -= I_ADA;
        const float* W; int N, ldt, coloff, kb, nb, rmk = 0, roff = 0; bf16* WT;
        if (r < I_WIN) { W = p.w_in; N = INC; WT = (bf16*)(p.ws + WS_WIN); ldt = D; coloff = 0; kb = r / 224; nb = r % 224; rmk = 1; }
        else if ((r -= I_WIN) < I_WA) { W = p.w_out_a; N = D; WT = (bf16*)(p.ws + WS_WAB); ldt = 2048; coloff = 0; kb = r >> 5; nb = r & 31; }
        else if ((r -= I_WA) < I_WA) { W = p.w_out_b; N = D; WT = (bf16*)(p.ws + WS_WAB); ldt = 2048; coloff = 1024; kb = r >> 5; nb = r & 31; }
        else if ((r -= I_WA) < I_WO) { W = p.w_o; N = D; WT = (bf16*)(p.ws + WS_WO); ldt = D; coloff = 0; kb = r >> 5; nb = r & 31; }
        else if ((r -= I_WO) < I_W1) { const int e = r >> 10, l = r & 1023; W = p.w1 + (size_t)e * D * 2048; N = 2048; WT = (bf16*)(p.ws + WS_W1) + (size_t)e * 2048 * D; ldt = D; coloff = 0; kb = l >> 6; nb = l & 63; rmk = 2; }
        else if ((r -= I_W1) < I_W2) { const int e = r >> 9, l = r & 511; W = p.w2 + (size_t)e * DE * D; N = D; WT = (bf16*)(p.ws + WS_W2) + (size_t)e * D * DE; ldt = DE; coloff = 0; kb = l >> 5; nb = l & 31; }
        else { r -= I_W2; const int gate = (r >> 1) & 1, db = r >> 2;
            W = (gate ? p.lru_wx : p.lru_wa) + (size_t)db * 4096; N = 64; WT = (bf16*)(p.ws + WS_WG) + (size_t)db * 128 * 64; ldt = 64; coloff = 0; kb = 0; nb = r & 1; roff = gate * 64; }
        p0_transpose_item(W, N, WT, ldt, coloff, scr, kb, nb, F.lane, RmGen{rmk, roff});
    }
}

__device__ __forceinline__ void p1_rows(Frame& F) {
    const P& p = F.p; const float* mx = (const float*)(p.ws + WS_MX);
    const int gw = F.vcu * NWAVES + F.wave, NGW = F.G * NWAVES, lane = F.lane;
    for (int pass = 0; pass < 2; ++pass) {
        const int b = pass == 0 ? (gw & 3) : 4; const float* md = mx + b * 6144;
        f32x4 am[4], sh[4];
#pragma unroll
        for (int j = 0; j < 4; ++j) { const int k = 4 * lane + 256 * j; const f32x4 g = *(const f32x4*)(p.norm_mix + k), sc = *(const f32x4*)(md + 1024 + k); am[j] = g * (sc + 1.0f); sh[j] = *(const f32x4*)(md + k); }
        const int r0 = pass == 0 ? (gw >> 2) : gw, rstep = pass == 0 ? (NGW >> 2) : NGW, rend = pass == 0 ? SEQ : MC;
        for (int r = r0; r < rend; r += rstep) {
            const float* src = pass == 0 ? p.x + ((size_t)b * SEQ + r) * D : p.ctx + (size_t)r * D;
            bf16* dst = pass == 0 ? (bf16*)(p.ws + WS_HX) + ((size_t)b * SEQ + r) * D : (bf16*)(p.ws + WS_HC) + (size_t)r * D;
            f32x4 v[4]; float s = 0.f;
#pragma unroll
            for (int j = 0; j < 4; ++j) { v[j] = *(const f32x4*)(src + 4 * lane + 256 * j); s += (v[j][0] * v[j][0] + v[j][1] * v[j][1]) + (v[j][2] * v[j][2] + v[j][3] * v[j][3]); }
            const float rstd = rsqrtf(wave_sum(s) * (1.0f / D) + EPS);
#pragma unroll
            for (int j = 0; j < 4; ++j) { const f32x4 o = v[j] * rstd * am[j] + sh[j]; u32x2 w; w.x = cvt_pk_bf16(o[0], o[1]); w.y = cvt_pk_bf16(o[2], o[3]); *(u32x2*)(dst + 4 * lane + 256 * j) = w; }
        }
    }
}

__device__ __forceinline__ void p6_route(Frame& F) {
    const P& p = F.p; const int tid = F.tid, lane = F.lane, wave = F.wave;
    LAS f32x4* WR = (LAS f32x4*)F.lds;
    for (int i = tid; i < D * 8; i += NTHR) { const int k = i >> 3, c = i & 7, lk = (k & 255) >> 2; WR[(lk * 16 + 4 * (k >> 8) + (k & 3)) * 8 + (c ^ (lk & 7))] = *(const f32x4*)(p.router_w + (size_t)k * NE + 4 * c); }
    LAS int* cntl = (LAS int*)(F.lds + AUX_OFF);
    LAS int* basel = cntl + 32;
    LAS int* sel_e = cntl + 64; LAS int* sel_r = sel_e + 512; LAS float* sel_g = (LAS float*)(sel_r + 512);
    unsigned* gcnt = (unsigned*)(p.ws + WS_CTL) + CW_CNT;
    const float* mxall = (const float*)(p.ws + WS_MX);
    for (int rg = F.vcu; rg < M / 128; rg += F.G) {
        if (tid < 32) cntl[tid] = 0;
        __syncthreads();
        const int b = (rg * 128) / SEQ; const float* md = mxall + b * 6144;
        LAS f32x4* amsh = (LAS f32x4*)(F.lds + AUX_OFF + 8192);
        if (wave == 0) {
#pragma unroll
            for (int j = 0; j < 4; ++j) { const int k = 4 * lane + 256 * j; const f32x4 g = *(const f32x4*)(p.norm_ffn + k), sc = *(const f32x4*)(md + 4 * 1024 + k); amsh[j * 64 + lane] = g * (sc + 1.0f); amsh[(4 + j) * 64 + lane] = *(const f32x4*)(md + 3 * 1024 + k); }
        }
        __syncthreads();
        const float rb = p.router_b[lane >> 1];
        for (int ri = 0; ri < 16; ++ri) {
            const int rl = wave * 16 + ri, row = rg * 128 + rl;
            const float* src = p.out + (size_t)row * D; bf16* fx = (bf16*)(p.ws + WS_FX) + (size_t)row * D;
            f32x4 v[4]; float s = 0.f;
#pragma unroll
            for (int j = 0; j < 4; ++j) { v[j] = *(const f32x4*)(src + 4 * lane + 256 * j); s += (v[j][0] * v[j][0] + v[j][1] * v[j][1]) + (v[j][2] * v[j][2] + v[j][3] * v[j][3]); }
            const float rstd = rsqrtf(wave_sum(s) * (1.0f / D) + EPS);
#pragma unroll
            for (int j = 0; j < 4; ++j) { v[j] = v[j] * rstd * amsh[j * 64 + lane] + amsh[(4 + j) * 64 + lane]; u32x2 w; w.x = cvt_pk_bf16(v[j][0], v[j][1]); w.y = cvt_pk_bf16(v[j][2], v[j][3]); *(u32x2*)(fx + 4 * lane + 256 * j) = w; }
            float a[32];
#pragma unroll
            for (int e = 0; e < 32; ++e) a[e] = 0.f;
#pragma unroll
            for (int j = 0; j < 4; ++j)
#pragma unroll
                for (int i = 0; i < 4; ++i) { const float xv = v[j][i];
#pragma unroll
                    for (int c = 0; c < 8; ++c) { const f32x4 w = WR[(lane * 16 + 4 * j + i) * 8 + (c ^ (lane & 7))]; a[4 * c] += xv * w[0]; a[4 * c + 1] += xv * w[1]; a[4 * c + 2] += xv * w[2]; a[4 * c + 3] += xv * w[3]; } }
#pragma unroll
            for (int h = 16; h >= 1; h >>= 1) {
                const bool up = (lane & (2 * h)) != 0;
#pragma unroll
                for (int i = 0; i < h; ++i) { const float send = up ? a[i] : a[h + i], keep = up ? a[h + i] : a[i]; a[i] = keep + __shfl_xor(send, 2 * h); }
            }
            float lg = a[0] + __shfl_xor(a[0], 1) + rb;
            const int me = lane >> 1;
            int idx[TOPK]; float val[TOPK];
#pragma unroll
            for (int t = 0; t < TOPK; ++t) {
                float bv = lg; int bi = me;
#pragma unroll
                for (int o = 2; o < 64; o <<= 1) { const float ov = __shfl_xor(bv, o); const int oi = __shfl_xor(bi, o); if (ov > bv || (ov == bv && oi < bi)) { bv = ov; bi = oi; } }
                idx[t] = bi; val[t] = bv; if (me == bi) lg = -3.0e38f;
            }
            float ex[TOPK], se = 0.f;
#pragma unroll
            for (int t = 0; t < TOPK; ++t) { ex[t] = __expf(val[t] - val[0]); se += ex[t]; }
            const float inv = 1.0f / se;
            if (lane < TOPK) { const int e = lane == 0 ? idx[0] : lane == 1 ? idx[1] : lane == 2 ? idx[2] : idx[3]; const float g = (lane == 0 ? ex[0] : lane == 1 ? ex[1] : lane == 2 ? ex[2] : ex[3]) * inv;
                const int rank = __hip_atomic_fetch_add((int*)&cntl[e], 1, __ATOMIC_RELAXED, __HIP_MEMORY_SCOPE_WORKGROUP); sel_e[rl * 4 + lane] = e; sel_r[rl * 4 + lane] = rank; sel_g[rl * 4 + lane] = g; }
        }
        __syncthreads();
        if (tid < 32) basel[tid] = (int)atomicAdd(&gcnt[tid], (unsigned)cntl[tid]);
        __syncthreads();
        { const int rl = tid >> 2, t = tid & 3, row = rg * 128 + rl, e = sel_e[tid], slot = basel[e] + sel_r[tid];
          ((int*)(p.ws + WS_TOK))[(size_t)e * M + slot] = row; ((float*)(p.ws + WS_GATE))[(size_t)e * M + slot] = sel_g[tid]; ((int*)(p.ws + WS_INV))[(size_t)row * 4 + t] = e * M + slot; }
        __syncthreads();
    }
}

__device__ __forceinline__ void p9_final(Frame& F) {
    const P& p = F.p; const int lane = F.lane;
    LAS int* tab = (LAS int*)(F.lds + AUX_OFF);
    moe_tables(tab, (const unsigned*)(p.ws + WS_CTL) + CW_CNT, 1);
    const int gw = F.vcu * NWAVES + F.wave, NGW = F.G * NWAVES, b = gw & 3;
    const float* gp = (const float*)(p.ws + WS_MX) + b * 6144 + 5 * 1024;
    f32x4 g[4], nf[4];
#pragma unroll
    for (int j = 0; j < 4; ++j) { const int k = 8 * lane + 512 * (j >> 1) + 4 * (j & 1); g[j] = *(const f32x4*)(gp + k); nf[j] = *(const f32x4*)(p.norm_final + k); }
    for (int r = gw >> 2; r < SEQ; r += (NGW >> 2)) {
        const int row = b * SEQ + r;
        const int4 iv = *(const int4*)((const int*)(p.ws + WS_INV) + (size_t)row * 4);
        const int ivs[4] = {iv.x, iv.y, iv.z, iv.w};
        f32x4 y[4];
#pragma unroll
        for (int j = 0; j < 4; ++j) y[j] = (f32x4){0.f, 0.f, 0.f, 0.f};
#pragma unroll
        for (int t = 0; t < TOPK; ++t) { const int e = ivs[t] >> 15, slot = ivs[t] & (M - 1); const bf16* op = (const bf16*)(p.ws + WS_OUTP) + (size_t)(tab[65 + e] + slot) * D;
#pragma unroll
            for (int h = 0; h < 2; ++h) { const u32x4 w = *(const u32x4*)(op + 8 * lane + 512 * h);
                y[2 * h] += (f32x4){bflo(w.x), bfhi(w.x), bflo(w.y), bfhi(w.y)}; y[2 * h + 1] += (f32x4){bflo(w.z), bfhi(w.z), bflo(w.w), bfhi(w.w)}; } }
        float* xo = p.out + (size_t)row * D; f32x4 v[4]; float s = 0.f;
#pragma unroll
        for (int j = 0; j < 4; ++j) { const int k = 8 * lane + 512 * (j >> 1) + 4 * (j & 1); v[j] = *(const f32x4*)(xo + k) + g[j] * y[j]; s += (v[j][0] * v[j][0] + v[j][1] * v[j][1]) + (v[j][2] * v[j][2] + v[j][3] * v[j][3]); }
        const float rstd = rsqrtf(wave_sum(s) * (1.0f / D) + EPS);
#pragma unroll
        for (int j = 0; j < 4; ++j) { const int k = 8 * lane + 512 * (j >> 1) + 4 * (j & 1); *(f32x4*)(xo + k) = v[j] * rstd * nf[j]; }
    }
}
constexpr int P3_UT = 0, P3_UPITCH = 144, P3_VT = 37376, P3_GG = P3_VT + 32768, P3_HB = P3_GG + 16384, P3_OUT = P3_HB + 16384, P3_SUM = P3_OUT + 8192, P3_CW = P3_SUM + 2048;
static_assert(P3_UT + 259 * P3_UPITCH <= P3_VT && P3_CW + 5 * 256 <= RING_BYTES, "P3 LDS map");
struct P3It { int fwd, seq, t0, L; };
__device__ __forceinline__ P3It p3_iter(int it) { P3It r; const int d = it / 33, k = it - d * 33; r.fwd = d; r.seq = k > 0; r.L = k > 0 ? SEQ : CTX; r.t0 = k == 0 ? 0 : (d ? 256 * (k - 1) : SEQ - 256 * k); return r; }

__device__ __forceinline__ void p3_lru_item(Frame& F, int item) {
    const P& p = F.p; const int tid = F.tid, lane = F.lane, wave = F.wave;
    const int b = item >> 6, blk = (item >> 2) & 15, q = item & 3;
    LAS unsigned char* lds = F.lds;
    const int ch = lane & 15, qd = lane >> 4, gch = blk * 64 + q * 16 + ch;
    const int cchunk = tid & 7, trow = tid >> 3;
    const int srow = tid >> 1, shalf = tid & 1;
    bf16* Zb = (bf16*)(p.ws + WS_Z) + 1024 + blk * 64 + q * 16 + shalf * 8;
    const bf16* GGb = (const bf16*)(p.ws + WS_GG) + blk * 64 + q * 16 + shalf * 8;
    float ba = 0.f, bx = 0.f, c1 = 0.f, h_in = 0.f;
    bf16x8 wfa[2], wfx[2];
    u32x4 pu[4], ph, pg, pb;
#define P3_PREFETCH(I) do { \
        const bf16* U_ = ((I).seq ? (const bf16*)(p.ws + WS_ULRU) + (size_t)b * SEQ * D : (const bf16*)(p.ws + WS_CS3) + (size_t)b * CTX * D) + blk * 64; \
        _Pragma("unroll") for (int i_ = 0; i_ < 4; ++i_) { const int idx_ = tid + NTHR * i_, row_ = idx_ >> 3, c_ = idx_ & 7; pu[i_] = *(const u32x4*)(U_ + (size_t)((I).t0 + row_) * D + c_ * 8); } \
        ph = (u32x4){0u, 0u, 0u, 0u}; \
        if (tid < 24) { const int hr_ = tid >> 3, c_ = tid & 7, t_ = (I).fwd ? (I).t0 - 3 + hr_ : (I).t0 + 256 + hr_; if (t_ >= 0 && t_ < (I).L) ph = *(const u32x4*)(U_ + (size_t)t_ * D + c_ * 8); } \
        if ((I).seq) { const size_t m_ = (size_t)b * SEQ + (I).t0 + srow; pg = *(const u32x4*)(GGb + m_ * D); if ((I).fwd) pb = *(const u32x4*)(Zb + m_ * 2048); } \
    } while (0)
    P3It cur = p3_iter(0), prv = cur;
    pg = (u32x4){0u, 0u, 0u, 0u}; pb = pg;
    P3_PREFETCH(cur);
    for (int it = 0; it < 66; ++it) {
        if (it == 0 || it == 33) {
            const int dir = cur.fwd ? 0 : 1;
            __syncthreads();
            if (tid < 320) { const int d = tid >> 6, c = tid & 63;
                *(LAS float*)(lds + P3_CW + tid * 4) = d < 4 ? p.lru_conv_w[(size_t)(dir * 4 + (cur.fwd ? d : 3 - d)) * D + blk * 64 + c] : p.lru_conv_b[dir * D + blk * 64 + c]; }
            ba = p.lru_ba[dir * D + gch]; bx = p.lru_bx[dir * D + gch];
            c1 = -8.0f * log1pf(__expf(-p.lru_lambda[dir * D + gch]));
            const bf16* wg = (const bf16*)(p.ws + WS_WG) + (size_t)(dir * 16 + blk) * 128 * 64;
#pragma unroll
            for (int kk = 0; kk < 2; ++kk) { wfa[kk] = *(const bf16x8*)(wg + (size_t)(q * 16 + ch) * 64 + kk * 32 + 8 * qd); wfx[kk] = *(const bf16x8*)(wg + (size_t)(64 + q * 16 + ch) * 64 + kk * 32 + 8 * qd); }
            h_in = 0.f;
        }
        const int buf = it & 1;
#pragma unroll
        for (int i = 0; i < 4; ++i) { const int idx = tid + NTHR * i, row = idx >> 3, c = idx & 7; *(LAS u32x4*)(lds + P3_UT + ((cur.fwd ? 3 : 0) + row) * P3_UPITCH + c * 16) = pu[i]; }
        if (tid < 24) { const int hr = tid >> 3, c = tid & 7; *(LAS u32x4*)(lds + P3_UT + ((cur.fwd ? 0 : 256) + hr) * P3_UPITCH + c * 16) = ph; }
        if (cur.seq) { const int s = cur.fwd ? srow : 255 - srow; *(LAS u32x4*)(lds + P3_GG + buf * 8192 + s * 32 + shalf * 16) = pg; if (cur.fwd) *(LAS u32x4*)(lds + P3_HB + buf * 8192 + s * 32 + shalf * 16) = pb; }
        LDS_WAIT(); __syncthreads();
        if (it > 0 && prv.seq) { const int s = prv.fwd ? srow : 255 - srow; const u32x4 o = *(const LAS u32x4*)(lds + P3_OUT + s * 32 + shalf * 16);
            *(u32x4*)(Zb + ((size_t)b * SEQ + prv.t0 + srow) * 2048) = o; }
        if (it == 32 || it == 33) { VM_WAIT(); }
        P3It nxt = cur;
        if (it + 1 < 66) { nxt = p3_iter(it + 1); P3_PREFETCH(nxt); }
        {
            u32x4 ur[7];
#pragma unroll
            for (int d = 0; d < 7; ++d) ur[d] = *(const LAS u32x4*)(lds + P3_UT + (trow * 4 + d) * P3_UPITCH + cchunk * 16);
#pragma unroll
            for (int i = 0; i < 4; ++i) {
                const f32x4 cb0 = *(const LAS f32x4*)(lds + P3_CW + 4 * 256 + cchunk * 32), cb1 = *(const LAS f32x4*)(lds + P3_CW + 4 * 256 + cchunk * 32 + 16);
                float v[8] = {cb0[0], cb0[1], cb0[2], cb0[3], cb1[0], cb1[1], cb1[2], cb1[3]};
#pragma unroll
                for (int d = 0; d < 4; ++d) { const u32x4 w = ur[i + d];
                    const f32x4 c0 = *(const LAS f32x4*)(lds + P3_CW + d * 256 + cchunk * 32), c1_ = *(const LAS f32x4*)(lds + P3_CW + d * 256 + cchunk * 32 + 16);
                    v[0] += c0[0] * bflo(w.x); v[1] += c0[1] * bfhi(w.x); v[2] += c0[2] * bflo(w.y); v[3] += c0[3] * bfhi(w.y);
                    v[4] += c1_[0] * bflo(w.z); v[5] += c1_[1] * bfhi(w.z); v[6] += c1_[2] * bflo(w.w); v[7] += c1_[3] * bfhi(w.w); }
                const int tl = trow * 4 + i, s = cur.fwd ? tl : 255 - tl;
                u32x4 o; o.x = cvt_pk_bf16(v[0], v[1]); o.y = cvt_pk_bf16(v[2], v[3]); o.z = cvt_pk_bf16(v[4], v[5]); o.w = cvt_pk_bf16(v[6], v[7]);
                *(LAS u32x4*)(lds + P3_VT + s * 128 + ((cchunk ^ (s & 7)) << 4)) = o;
            }
        }
        LDS_WAIT(); __syncthreads();
        float Pi[2][4], Qi[2][4], Pe[2], Qe[2], PT[2], QT[2];
#pragma unroll
        for (int tl2 = 0; tl2 < 2; ++tl2) {
            const int T = wave * 2 + tl2, srow_a = T * 16 + (lane & 15);
            f32x4 ar = (f32x4){0.f, 0.f, 0.f, 0.f}, ai = ar;
#pragma unroll
            for (int kk = 0; kk < 2; ++kk) { const bf16x8 af = *(const LAS bf16x8*)(lds + P3_VT + srow_a * 128 + (((kk * 4 + qd) ^ (srow_a & 7)) << 4));
                ar = __builtin_amdgcn_mfma_f32_16x16x32_bf16(af, wfa[kk], ar, 0, 0, 0); ai = __builtin_amdgcn_mfma_f32_16x16x32_bf16(af, wfx[kk], ai, 0, 0, 0); }
            float Pl = 1.f, Ql = 0.f;
#pragma unroll
            for (int i = 0; i < 4; ++i) {
                const int s = T * 16 + 4 * qd + i, c = q * 16 + ch;
                const float v = bf2f(*(const LAS bf16*)(lds + P3_VT + s * 128 + ((((c >> 3) ^ (s & 7)) << 4)) + (c & 7) * 2));
                const float r = fsig(ar[i] + ba), ig = fsig(ai[i] + bx);
                const float a = __expf(c1 * r), bq = sqrtf(fmaxf(1.0f - a * a, 0.f)) * (ig * v);
                Ql = a * Ql + bq; Pl = Pl * a; Pi[tl2][i] = Pl; Qi[tl2][i] = Ql;
            }
            float Pt = Pl, Qt = Ql;
            { const float Pu = __shfl_up(Pt, 16), Qu = __shfl_up(Qt, 16); if (qd >= 1) { Qt = Pt * Qu + Qt; Pt = Pu * Pt; } }
            { const float Pu = __shfl_up(Pt, 32), Qu = __shfl_up(Qt, 32); if (qd >= 2) { Qt = Pt * Qu + Qt; Pt = Pu * Pt; } }
            { const float Pu = __shfl_up(Pt, 16), Qu = __shfl_up(Qt, 16); Pe[tl2] = qd >= 1 ? Pu : 1.f; Qe[tl2] = qd >= 1 ? Qu : 0.f; }
            PT[tl2] = __shfl(Pt, 48 + ch); QT[tl2] = __shfl(Qt, 48 + ch);
        }
        if (qd == 0) { *(LAS f32x2*)(lds + P3_SUM + buf * 1024 + (wave * 16 + ch) * 8) = (f32x2){PT[0] * PT[1], PT[1] * QT[0] + QT[1]}; }
        LDS_WAIT(); __syncthreads();
        float carry = h_in, full = h_in;
#pragma unroll
        for (int ww = 0; ww < 8; ++ww) { const f32x2 sq = *(const LAS f32x2*)(lds + P3_SUM + buf * 1024 + (ww * 16 + ch) * 8); full = sq.x * full + sq.y; if (ww < wave) carry = full; }
        h_in = full;
        if (cur.seq) {
#pragma unroll
            for (int tl2 = 0; tl2 < 2; ++tl2) {
                const float ct = tl2 == 0 ? carry : PT[0] * carry + QT[0];
                const float cl = Pe[tl2] * ct + Qe[tl2];
#pragma unroll
                for (int i = 0; i < 4; ++i) {
                    const int s = (wave * 2 + tl2) * 16 + 4 * qd + i;
                    float h = Pi[tl2][i] * cl + Qi[tl2][i];
                    if (cur.fwd) { const float gg = bf2f(*(const LAS bf16*)(lds + P3_GG + buf * 8192 + s * 32 + ch * 2)), hb = bf2f(*(const LAS bf16*)(lds + P3_HB + buf * 8192 + s * 32 + ch * 2)); h = gg * (h + hb); }
                    *(LAS bf16*)(lds + P3_OUT + s * 32 + ch * 2) = f2bf(h);
                }
            }
        }
        prv = cur; cur = nxt;
    }
    LDS_WAIT(); __syncthreads();
    if (prv.seq) { const int s = prv.fwd ? srow : 255 - srow; const u32x4 o = *(const LAS u32x4*)(lds + P3_OUT + s * 32 + shalf * 16); *(u32x4*)(Zb + ((size_t)b * SEQ + prv.t0 + srow) * 2048) = o; }
    __syncthreads();
}
__device__ __forceinline__ void p3_conv(Frame& F) {
    const P& p = F.p; const int c8 = (F.tid & 127) * 8, tsub = F.tid >> 7;
    float w[3][8];
#pragma unroll
    for (int k = 0; k < 3; ++k)
#pragma unroll
        for (int c = 0; c < 8; ++c) w[k][c] = p.conv_a_w[k * D + c8 + c];
    const bool horiz = c8 < 512; const int off = horiz ? 1 : GW;
    const bf16* U = (const bf16*)(p.ws + WS_U) + c8; const bf16* GBp = (const bf16*)(p.ws + WS_GB) + c8; bf16* Z = (bf16*)(p.ws + WS_Z) + c8;
    for (int m = F.vcu * 4 + tsub; m < M; m += F.G * 4) {
        const int tb = m & (SEQ - 1), row = tb >> 6, col = tb & 63;
        const bool okm = horiz ? col > 0 : row > 0, okp = horiz ? col < GW - 1 : row < GROWS - 1;
        const u32x4 z4 = (u32x4){0u, 0u, 0u, 0u};
        const u32x4 um = okm ? *(const u32x4*)(U + (size_t)(m - off) * D) : z4, u0 = *(const u32x4*)(U + (size_t)m * D), up = okp ? *(const u32x4*)(U + (size_t)(m + off) * D) : z4, gb = *(const u32x4*)(GBp + (size_t)m * D);
        const unsigned um_[4] = {um.x, um.y, um.z, um.w}, u0_[4] = {u0.x, u0.y, u0.z, u0.w}, up_[4] = {up.x, up.y, up.z, up.w}, gb_[4] = {gb.x, gb.y, gb.z, gb.w};
        unsigned o[4];
#pragma unroll
        for (int j = 0; j < 4; ++j) {
            const float lo = (w[0][2 * j] * bflo(um_[j]) + w[1][2 * j] * bflo(u0_[j]) + w[2][2 * j] * bflo(up_[j])) * bflo(gb_[j]);
            const float hi = (w[0][2 * j + 1] * bfhi(um_[j]) + w[1][2 * j + 1] * bfhi(u0_[j]) + w[2][2 * j + 1] * bfhi(up_[j])) * bfhi(gb_[j]);
            o[j] = cvt_pk_bf16(lo, hi);
        }
        *(u32x4*)(Z + (size_t)m * 2048) = (u32x4){o[0], o[1], o[2], o[3]};
    }
}

struct Args { P p; int ph_lo, ph_hi; };
constexpr int NPHASE = 10;
__global__ void __launch_bounds__(NTHR, 2) mega_fwd(Args args) {
    extern __shared__ __attribute__((aligned(16))) unsigned char lds_raw[];
    Frame F{(LAS unsigned char*)lds_raw, args.p, 0, 0, 0, 0, 0};
    F.tid = threadIdx.x; F.lane = F.tid & 63; F.wave = __builtin_amdgcn_readfirstlane(F.tid >> 6);
    F.G = gridDim.x; { const int bx = blockIdx.x; F.vcu = (F.G % 8 == 0) ? (bx % 8) * (F.G / 8) + bx / 8 : bx; }
    volatile LAS unsigned* MISC = (volatile LAS unsigned*)(F.lds + MISC_OFF);
    for (int u = F.tid; u < 128; u += NTHR) MISC[u] = 0u;
    __syncthreads();
    const int lo = args.ph_lo, hi = args.ph_hi;
    const P& p = F.p; unsigned char* ws = p.ws;
    XcdBarrier bar; bar.bar = (unsigned*)(ws + WS_CTL) + CW_BAR; bar.x = 0; bar.st = nullptr;
    if (hi - lo > 1) bar = xcd_barrier_post((unsigned*)(ws + WS_CTL) + CW_BAR, MISC + 8);
#ifndef CTM
#define CTM 0x3FFu
#endif
#define IN(k) (((CTM >> (k)) & 1u) && lo <= (k) && (k) < hi)
#define SEAM(k) do { if (IN(k) && IN((k) + 1)) xcd_barrier(bar); } while (0)
    if (IN(0)) { p0_prologue(F); } SEAM(0);
    if (IN(1)) { p1_rows(F); } SEAM(1);
    if (IN(2)) {
        SchedInProj S{(const char*)(ws + WS_HX), (const char*)(ws + WS_HC), (const char*)(ws + WS_WIN), F.G, (int)blockIdx.x};
        EpiInProj E{ws, p.b_merge};
        pg8::gemm_phase<EpiInProj, SchedInProj, false>(F.lds, D, S, E);
    } SEAM(2);
    if (IN(3)) { for (int item = F.vcu; item < 256; item += F.G) p3_lru_item(F, item); p3_conv(F); } SEAM(3);
    if (IN(4)) {
        SchedDense S{(const char*)(ws + WS_Z), (const char*)(ws + WS_WAB), 2048, F.G, (int)blockIdx.x};
        EpiMerge E{ws};
        pg8::gemm_phase<EpiMerge, SchedDense, true>(F.lds, 2048, S, E);
    } SEAM(4);
    if (IN(5)) {
        SchedDense S{(const char*)(ws + WS_MG), (const char*)(ws + WS_WO), D, F.G, (int)blockIdx.x};
        EpiWo E{p.x, p.out, (const float*)(ws + WS_MX)};
        pg8::gemm_phase<EpiWo, SchedDense, false>(F.lds, D, S, E);
    } SEAM(5);
    if (IN(6)) { p6_route(F); } SEAM(6);
    if (IN(7)) {
        LAS int* tab = (LAS int*)(F.lds + AUX_OFF);
        moe_tables(tab, (const unsigned*)(ws + WS_CTL) + CW_CNT, 8);
        SchedMoe S{(const char*)(ws + WS_FX), (const char*)(ws + WS_W1), (const int*)(ws + WS_TOK), tab, 8, F.G, (int)blockIdx.x, 1, 2048};
        EpiMoe1 E{ws, p.b1};
        pg8::gemm_phase<EpiMoe1, SchedMoe, false>(F.lds, D, S, E);
    } SEAM(7);
    if (IN(8)) {
        LAS int* tab = (LAS int*)(F.lds + AUX_OFF);
        __syncthreads();
        moe_tables(tab, (const unsigned*)(ws + WS_CTL) + CW_CNT, 4);
        SchedMoe S{(const char*)(ws + WS_ACT), (const char*)(ws + WS_W2), (const int*)(ws + WS_TOK), tab, 4, F.G, (int)blockIdx.x, 0, 1024};
        EpiMoe2 E{ws, p.b2};
        pg8::gemm_phase<EpiMoe2, SchedMoe, false>(F.lds, DE, S, E);
    } SEAM(8);
    if (IN(9)) { __syncthreads(); p9_final(F); }
#undef IN
#undef SEAM
}
#ifndef FAST_MASK
#define FAST_MASK 0x3FFu
#endif
#ifndef ONE_LAUNCH
#define ONE_LAUNCH 0
#endif
static void launch_mega(const P& p, int lo, int hi, int grid, hipStream_t stream) {
    Args a{}; a.p = p; a.ph_lo = lo; a.ph_hi = hi;
    hipLaunchKernelGGL(mega_fwd, dim3(grid), dim3(NTHR), LDS_BYTES, stream, a);
}
extern "C" void kernel_launch(void* const* d_in, const int* in_sizes, int n_in, void* d_out, int out_size, void* d_ws, size_t ws_size, hipStream_t stream) {
    static int grid = 0;
    if (grid == 0) {
        if (n_in != 28 || out_size != M * D || ws_size < WS_END) { fprintf(stderr, "kernel_launch: unexpected shapes n_in %d out %d ws %zu\n", n_in, out_size, ws_size); grid = -1; return; }
        int dev = 0, cus = 0, per_cu = 0;
        if (hipGetDevice(&dev) != hipSuccess || hipDeviceGetAttribute(&cus, hipDeviceAttributeMultiprocessorCount, dev) != hipSuccess) { grid = -1; return; }
        if (hipFuncSetAttribute((const void*)mega_fwd, hipFuncAttributeMaxDynamicSharedMemorySize, LDS_BYTES) != hipSuccess) { fprintf(stderr, "kernel_launch: hipFuncSetAttribute failed\n"); grid = -1; return; }
        if (hipOccupancyMaxActiveBlocksPerMultiprocessor(&per_cu, (const void*)mega_fwd, NTHR, LDS_BYTES) != hipSuccess || per_cu < 1) { fprintf(stderr, "kernel_launch: occupancy query reports %d blocks per CU\n", per_cu); }
        (void)hipGetLastError();
        grid = cus;
    }
    if (grid < 0) return;
    P p{};
    const float** f = (const float**)&p;
    for (int i = 0; i < 28; ++i) f[i] = (const float*)d_in[i];
    p.out = (float*)d_out; p.ws = (unsigned char*)d_ws;
    (void)hipMemsetAsync((char*)d_ws + WS_CTL, 0, CTL_ZERO_BYTES, stream);
    const unsigned fm = FAST_MASK;
    if (ONE_LAUNCH && fm == 0x3FFu) { launch_mega(p, 0, NPHASE, grid, stream); return; }
    for (int ph = 0; ph < NPHASE; ++ph) {
        if ((fm >> ph) & 1u) { launch_mega(p, ph, ph + 1, grid, stream); continue; }
        switch (ph) {
        case 0: nv_adaln<<<6144 / 256, 256, 0, stream>>>(p); if (fm & 0x1B4u) launch_mega(p, 0, 1, grid, stream); break;
        case 1: nv_hx<<<(M + MC) / 4, 256, 0, stream>>>(p); break;
        case 2: for (int mode = 0; mode < 6; ++mode) { FInProj fi{p, mode, D}; const dim3 g(D / 128, (mode == 5 ? MC : M) / 128, 1);
                    if (mode == 1 || mode == 4) nv_gemm<true, FInProj><<<g, 256, 0, stream>>>(fi); else nv_gemm<false, FInProj><<<g, 256, 0, stream>>>(fi); } break;
        case 3: nv_lru<<<NB * 2 * 16, 64, 0, stream>>>(p); nv_mix<<<(unsigned)((size_t)M * D / 256), 256, 0, stream>>>(p); break;
        case 4: { FMerge fm_{p, D, 0}; nv_gemm<true, FMerge><<<dim3(D / 128, M / 128, 1), 256, 0, stream>>>(fm_); } break;
        case 5: { FWo fw{p, D, 0}; nv_gemm<false, FWo><<<dim3(D / 128, M / 128, 1), 256, 0, stream>>>(fw); } break;
        case 6: nv_route<<<M / 4, 256, 0, stream>>>(p); break;
        case 7: { FMoe1 f1{p, D, 0}; nv_gemm<true, FMoe1><<<dim3(DE / 128, M / 128, NE), 256, 0, stream>>>(f1); } break;
        case 8: { FMoe2 f2{p, DE, 0}; nv_gemm<false, FMoe2><<<dim3(D / 128, M / 128, NE), 256, 0, stream>>>(f2); } break;
        case 9: nv_final<<<M / 4, 256, 0, stream>>>(p); break;
        }
    }
}
```

```cpp
#define UEW_ALL 1
#define PADX 64
#define P3_RSQ 1
#define P2_ALIGN false
#include <hip/hip_runtime.h>
#include <stdint.h>
#include <cstdio>

typedef unsigned short bf16;
__device__ __forceinline__ float bf2f(bf16 v) { return __uint_as_float(((unsigned)v) << 16); }
__device__ __forceinline__ bf16 f2bf(float f) { unsigned u = __float_as_uint(f); u += 0x7fffu + ((u >> 16) & 1u); return (bf16)(u >> 16); }

constexpr int NB = 4, SEQ = 8192, D = 1024, M = NB * SEQ, CTX = 256, MC = NB * CTX, INC = 7168;
constexpr int NE = 32, TOPK = 4, DE = 1024, GW = 64, GROWS = SEQ / GW;
constexpr float EPS = 1e-6f;
constexpr size_t MiB = 1u << 20;
constexpr size_t WS_CTL = 0, CTL_BYTES = 1 * MiB;
constexpr int CW_CNT = 16384;
constexpr size_t WS_MX = 1 * MiB;
constexpr size_t WS_TOK = 2 * MiB, WS_GATE = 6 * MiB, WS_INV = 10 * MiB;
#ifndef PADX
#define PADX 0
#endif
constexpr int PA = D + PADX;
constexpr size_t WS_CS3 = 11 * MiB, WS_HC = 13 * MiB;
constexpr size_t WS_WIN = (PADX ? 936 : 16) * MiB, WS_WAB = 30 * MiB, WS_WO = 34 * MiB, WS_W1 = 36 * MiB, WS_W2 = 164 * MiB;
constexpr size_t WS_HX = 228 * MiB, WS_GB = 292 * MiB, WS_U = 356 * MiB, WS_ULRU = 420 * MiB, WS_GG = 484 * MiB;
constexpr size_t WS_ACT = 228 * MiB;
constexpr size_t WS_RAT = 548 * MiB, WS_SBG = 612 * MiB, WS_Z = 676 * MiB, WS_MG = 804 * MiB;
constexpr size_t WS_FX = 548 * MiB, WS_OUTP = 548 * MiB;
constexpr size_t WS_HF = WS_HX, WS_HB = WS_MG;
constexpr size_t WS_END = (PADX ? 952 : 868) * MiB;
constexpr size_t WS_HXP = PADX ? 868 * MiB : WS_HX;

struct P {
    const float *x, *c, *ctx, *c_ctx, *w_ada, *b_ada, *norm_mix, *w_in, *conv_a_w, *w_out_a, *lru_conv_w, *lru_conv_b, *lru_wa, *lru_ba, *lru_wx, *lru_bx,
        *lru_lambda, *w_out_b, *b_merge, *w_o, *norm_ffn, *router_w, *router_b, *w1, *b1, *w2, *b2, *norm_final;
    float* out; unsigned char* ws;
};

__device__ __forceinline__ float wave_sum(float v) {
#pragma unroll
    for (int o = 1; o < 64; o <<= 1) v += __shfl_xor(v, o);
    return v;
}
__device__ __forceinline__ float sigmoidf_(float v) { return 1.0f / (1.0f + __expf(-v)); }
__device__ __forceinline__ float gelu_tanh(float v) { const float u = 0.7978845608028654f * (v + 0.044715f * v * v * v); return v * sigmoidf_(2.0f * u); }
__device__ __forceinline__ int pad256(int v) { return (v + 255) & ~255; }

__global__ __launch_bounds__(256) void nv_adaln(P p) {
    __shared__ float sc[5][D];
    for (int i = threadIdx.x; i < 5 * D; i += 256) { const int r = i / D, k = i % D; const float v = r < 4 ? p.c[r * D + k] : p.c_ctx[k]; sc[r][k] = v * sigmoidf_(v); }
    __syncthreads();
    const int n = blockIdx.x * 256 + threadIdx.x;
    float a[5] = {0, 0, 0, 0, 0};
    for (int k = 0; k < D; ++k) { const float w = p.w_ada[(size_t)k * 6144 + n];
#pragma unroll
        for (int r = 0; r < 5; ++r) a[r] += sc[r][k] * w; }
    float* mx = (float*)(p.ws + WS_MX);
#pragma unroll
    for (int r = 0; r < 5; ++r) mx[r * 6144 + n] = a[r] + p.b_ada[n];
}
__global__ __launch_bounds__(256) void nv_hx(P p) {
    const int row = blockIdx.x * 4 + (threadIdx.x >> 6), lane = threadIdx.x & 63;
    const float* mx = (const float*)(p.ws + WS_MX);
    const float* src; bf16* dst; const float* md;
    if (row < M) { src = p.x + (size_t)row * D; dst = (bf16*)(p.ws + WS_HX) + (size_t)row * D; md = mx + (row / SEQ) * 6144; }
    else { const int r = row - M; src = p.ctx + (size_t)r * D; dst = (bf16*)(p.ws + WS_HC) + (size_t)r * D; md = mx + 4 * 6144; }
    float v[16]; float s = 0.f;
#pragma unroll
    for (int j = 0; j < 16; ++j) { v[j] = src[lane + 64 * j]; s += v[j] * v[j]; }
    const float rstd = rsqrtf(wave_sum(s) * (1.0f / D) + EPS);
#pragma unroll
    for (int j = 0; j < 16; ++j) { const int k = lane + 64 * j; dst[k] = f2bf(v[j] * rstd * p.norm_mix[k] * (1.0f + md[1024 + k]) + md[k]); }
}

template <bool DUAL, class F>
__global__ __launch_bounds__(256) void nv_gemm(F f) {
    const int K = f.K;
    __shared__ float As[2][16][128 + 4], Bs[2][16][128 + 4];
    const int z = blockIdx.z, m0 = blockIdx.y * 128, n0 = blockIdx.x * 128, tid = threadIdx.x, tx = tid & 15, ty = tid >> 4;
    if (m0 >= f.rows(z)) return;
    float acc[8][8], acc2[8][8];
#pragma unroll
    for (int i = 0; i < 8; ++i)
#pragma unroll
        for (int j = 0; j < 8; ++j) { acc[i][j] = 0.f; acc2[i][j] = 0.f; }
    for (int k0 = 0; k0 < K; k0 += 16) {
#pragma unroll
        for (int i = 0; i < 8; ++i) { const int idx = tid + 256 * i; const int mm = idx >> 4, kk = idx & 15; As[0][kk][mm] = f.a(z, m0 + mm, k0 + kk); if (DUAL) As[1][kk][mm] = f.a2(z, m0 + mm, k0 + kk); }
#pragma unroll
        for (int i = 0; i < 8; ++i) { const int idx = tid + 256 * i; const int kk = idx >> 7, nn = idx & 127; Bs[0][kk][nn] = f.b(z, k0 + kk, n0 + nn); if (DUAL) Bs[1][kk][nn] = f.b2(z, k0 + kk, n0 + nn); }
        __syncthreads();
#pragma unroll
        for (int kk = 0; kk < 16; ++kk) {
            float av[8], bv[8];
#pragma unroll
            for (int i = 0; i < 8; ++i) { av[i] = As[0][kk][ty + 16 * i]; bv[i] = Bs[0][kk][tx + 16 * i]; }
#pragma unroll
            for (int i = 0; i < 8; ++i)
#pragma unroll
                for (int j = 0; j < 8; ++j) acc[i][j] += av[i] * bv[j];
            if (DUAL) {
#pragma unroll
                for (int i = 0; i < 8; ++i) { av[i] = As[1][kk][ty + 16 * i]; bv[i] = Bs[1][kk][tx + 16 * i]; }
#pragma unroll
                for (int i = 0; i < 8; ++i)
#pragma unroll
                    for (int j = 0; j < 8; ++j) acc2[i][j] += av[i] * bv[j];
            }
        }
        __syncthreads();
    }
#pragma unroll
    for (int i = 0; i < 8; ++i)
#pragma unroll
        for (int j = 0; j < 8; ++j) f.ep(z, m0 + ty + 16 * i, n0 + tx + 16 * j, acc[i][j], acc2[i][j]);
}
struct FInProj {
    P p; int mode, K;
    __device__ int rows(int) const { return mode == 5 ? MC : M; }
    __device__ float a(int, int m, int k) const { const bf16* A = (const bf16*)(p.ws + (mode == 5 ? WS_HC : WS_HX)); return bf2f(A[(size_t)m * D + k]); }
    __device__ float a2(int z, int m, int k) const { return a(z, m, k); }
    __device__ int col1() const { return mode == 0 ? 0 : mode == 1 ? 1024 : mode == 2 ? 3072 : mode == 3 ? 4096 : mode == 4 ? 5120 : 3072; }
    __device__ float b(int, int k, int n) const { return p.w_in[(size_t)k * INC + col1() + n]; }
    __device__ float b2(int, int k, int n) const { return p.w_in[(size_t)k * INC + col1() + 1024 + n]; }
    __device__ void ep(int, int m, int n, float v, float v2) const {
        const size_t o = (size_t)m * D + n;
        if (mode == 0) ((bf16*)(p.ws + WS_GB))[o] = f2bf(v);
        else if (mode == 1) ((bf16*)(p.ws + WS_U))[o] = f2bf(v * v2);
        else if (mode == 2) ((bf16*)(p.ws + WS_ULRU))[o] = f2bf(v);
        else if (mode == 3) ((bf16*)(p.ws + WS_GG))[o] = f2bf(gelu_tanh(v));
        else if (mode == 4) { const float sa = sigmoidf_(v + p.b_merge[n]), sb = sigmoidf_(v2 + p.b_merge[D + n]); ((bf16*)(p.ws + WS_RAT))[o] = f2bf(sa / sb); ((bf16*)(p.ws + WS_SBG))[o] = f2bf(sb); }
        else ((bf16*)(p.ws + WS_CS3))[o] = f2bf(v);
    }
};
struct FMerge {
    P p; int K, pad;
    __device__ int rows(int) const { return M; }
    __device__ float a(int, int m, int k) const { return bf2f(((const bf16*)(p.ws + WS_Z))[(size_t)m * 2048 + k]); }
    __device__ float a2(int, int m, int k) const { return bf2f(((const bf16*)(p.ws + WS_Z))[(size_t)m * 2048 + 1024 + k]); }
    __device__ float b(int, int k, int n) const { return p.w_out_a[(size_t)k * D + n]; }
    __device__ float b2(int, int k, int n) const { return p.w_out_b[(size_t)k * D + n]; }
    __device__ void ep(int, int m, int n, float v, float v2) const {
        const size_t o = (size_t)m * D + n; const float rat = bf2f(((const bf16*)(p.ws + WS_RAT))[o]), sb = bf2f(((const bf16*)(p.ws + WS_SBG))[o]);
        ((bf16*)(p.ws + WS_MG))[o] = f2bf((v * rat + v2) * sb);
    }
};
struct FWo {
    P p; int K, pad;
    __device__ int rows(int) const { return M; }
    __device__ float a(int, int m, int k) const { return bf2f(((const bf16*)(p.ws + WS_MG))[(size_t)m * D + k]); }
    __device__ float a2(int, int, int) const { return 0.f; }
    __device__ float b(int, int k, int n) const { return p.w_o[(size_t)k * D + n]; }
    __device__ float b2(int, int, int) const { return 0.f; }
    __device__ void ep(int, int m, int n, float v, float) const { const float* mx = (const float*)(p.ws + WS_MX); const size_t o = (size_t)m * D + n; p.out[o] = p.x[o] + mx[(m / SEQ) * 6144 + 2 * 1024 + n] * v; }
};
__device__ __forceinline__ int expert_base(const unsigned* cnt, int e) { int b = 0; for (int i = 0; i < e; ++i) b += pad256((int)cnt[i]); return b; }
struct FMoe1 {
    P p; int K, pad;
    __device__ const unsigned* cnt() const { return (const unsigned*)(p.ws + WS_CTL) + CW_CNT; }
    __device__ int rows(int z) const { return (int)cnt()[z]; }
    __device__ float a(int z, int m, int k) const { if (m >= rows(z)) return 0.f; const int tok = ((const int*)(p.ws + WS_TOK))[(size_t)z * M + m]; return bf2f(((const bf16*)(p.ws + WS_FX))[(size_t)tok * D + k]); }
    __device__ float a2(int z, int m, int k) const { return a(z, m, k); }
    __device__ float b(int z, int k, int n) const { return p.w1[((size_t)z * D + k) * 2048 + 2 * n]; }
    __device__ float b2(int z, int k, int n) const { return p.w1[((size_t)z * D + k) * 2048 + 2 * n + 1]; }
    __device__ void ep(int z, int m, int n, float v, float v2) const {
        if (m >= rows(z)) return;
        const float hg = v + p.b1[(size_t)z * 2048 + 2 * n], hl = v2 + p.b1[(size_t)z * 2048 + 2 * n + 1];
        const float glu = fminf(hg, 7.0f), lin = fminf(fmaxf(hl, -7.0f), 7.0f);
        const float act = glu * sigmoidf_(1.702f * glu) * (lin + 1.0f);
        ((bf16*)(p.ws + WS_ACT))[(size_t)(expert_base(cnt(), z) + m) * DE + n] = f2bf(act);
    }
};
struct FMoe2 {
    P p; int K, pad;
    __device__ const unsigned* cnt() const { return (const unsigned*)(p.ws + WS_CTL) + CW_CNT; }
    __device__ int rows(int z) const { return (int)cnt()[z]; }
    __device__ float a(int z, int m, int k) const { if (m >= rows(z)) return 0.f; return bf2f(((const bf16*)(p.ws + WS_ACT))[(size_t)(expert_base(cnt(), z) + m) * DE + k]); }
    __device__ float a2(int, int, int) const { return 0.f; }
    __device__ float b(int z, int k, int n) const { return p.w2[((size_t)z * DE + k) * D + n]; }
    __device__ float b2(int, int, int) const { return 0.f; }
    __device__ void ep(int z, int m, int n, float v, float) const {
        if (m >= rows(z)) return;
        const float g = ((const float*)(p.ws + WS_GATE))[(size_t)z * M + m];
        ((bf16*)(p.ws + WS_OUTP))[(size_t)(expert_base(cnt(), z) + m) * D + n] = f2bf((v + p.b2[(size_t)z * D + n]) * g);
    }
};

__global__ __launch_bounds__(64) void nv_lru(P p) {
    __shared__ float vs[64];
    const int j = threadIdx.x, blk = blockIdx.x & 15, dir = (blockIdx.x >> 4) & 1, b = blockIdx.x >> 5, ch = blk * 64 + j;
    float wa[64], wx[64];
    const float* WA = p.lru_wa + ((size_t)(dir * 16 + blk) * 64) * 64; const float* WX = p.lru_wx + ((size_t)(dir * 16 + blk) * 64) * 64;
#pragma unroll
    for (int k = 0; k < 64; ++k) { wa[k] = WA[k * 64 + j]; wx[k] = WX[k * 64 + j]; }
    const float ba = p.lru_ba[dir * D + ch], bx = p.lru_bx[dir * D + ch], cb = p.lru_conv_b[dir * D + ch];
    float cw[4];
#pragma unroll
    for (int q = 0; q < 4; ++q) cw[q] = p.lru_conv_w[(size_t)(dir * 4 + q) * D + ch];
    const float lam = p.lru_lambda[dir * D + ch];
    const float c1 = -8.0f * log1pf(__expf(-lam));
    float h = 0.f;
    bf16* hout = (bf16*)(p.ws + (dir == 0 ? WS_HF : WS_HB));
    for (int seq = 0; seq < 2; ++seq) {
        const int L = seq == 0 ? CTX : SEQ;
        const bf16* u = seq == 0 ? (const bf16*)(p.ws + WS_CS3) + (size_t)b * CTX * D : (const bf16*)(p.ws + WS_ULRU) + (size_t)b * SEQ * D;
        for (int step = 0; step < L; ++step) {
            const int t = dir == 0 ? step : L - 1 - step;
            float v = cb;
#pragma unroll
            for (int q = 0; q < 4; ++q) { const int tt = dir == 0 ? t + q - 3 : t + 3 - q; if (tt >= 0 && tt < L) v += cw[q] * bf2f(u[(size_t)tt * D + ch]); }
            vs[j] = v;
            __syncthreads();
            float r = ba, i = bx;
#pragma unroll
            for (int k = 0; k < 64; ++k) { const float vk = vs[k]; r += vk * wa[k]; i += vk * wx[k]; }
            __syncthreads();
            r = sigmoidf_(r); i = sigmoidf_(i);
            const float la = c1 * r, a = __expf(la), bb = sqrtf(fmaxf(1.0f - __expf(2.0f * la), 0.f)) * (i * v);
            h = a * h + bb;
            if (seq == 1) hout[((size_t)b * SEQ + t) * D + ch] = f2bf(h);
        }
    }
}
__global__ __launch_bounds__(256) void nv_mix(P p) {
    const size_t idx = (size_t)blockIdx.x * 256 + threadIdx.x; const int m = (int)(idx / D), ch = (int)(idx % D);
    const int tb = m % SEQ, row = tb / GW, col = tb % GW;
    const bf16* U = (const bf16*)(p.ws + WS_U);
    float s = 0.f;
#pragma unroll
    for (int k = 0; k < 3; ++k) {
        const float w = p.conv_a_w[k * D + ch]; int mm; bool ok;
        if (ch < 512) { const int c2 = col + k - 1; ok = c2 >= 0 && c2 < GW; mm = m + k - 1; }
        else { const int r2 = row + k - 1; ok = r2 >= 0 && r2 < GROWS; mm = m + (k - 1) * GW; }
        if (ok) s += w * bf2f(U[(size_t)mm * D + ch]);
    }
    bf16* Z = (bf16*)(p.ws + WS_Z);
    Z[(size_t)m * 2048 + ch] = f2bf(bf2f(((const bf16*)(p.ws + WS_GB))[idx]) * s);
    const float hh = bf2f(((const bf16*)(p.ws + WS_HF))[idx]) + bf2f(((const bf16*)(p.ws + WS_HB))[idx]);
    Z[(size_t)m * 2048 + 1024 + ch] = f2bf(bf2f(((const bf16*)(p.ws + WS_GG))[idx]) * hh);
}
__global__ __launch_bounds__(256) void nv_route(P p) {
    const int row = blockIdx.x * 4 + (threadIdx.x >> 6), lane = threadIdx.x & 63;
    const float* mx = (const float*)(p.ws + WS_MX) + (row / SEQ) * 6144;
    const float* src = p.out + (size_t)row * D;
    float v[16]; float s = 0.f;
#pragma unroll
    for (int j = 0; j < 16; ++j) { v[j] = src[lane + 64 * j]; s += v[j] * v[j]; }
    const float rstd = rsqrtf(wave_sum(s) * (1.0f / D) + EPS);
    bf16* fx = (bf16*)(p.ws + WS_FX) + (size_t)row * D;
#pragma unroll
    for (int j = 0; j < 16; ++j) { const int k = lane + 64 * j; v[j] = v[j] * rstd * p.norm_ffn[k] * (1.0f + mx[4 * 1024 + k]) + mx[3 * 1024 + k]; fx[k] = f2bf(v[j]); }
    float lg[NE];
#pragma unroll
    for (int e = 0; e < NE; ++e) { float a = 0.f;
#pragma unroll
        for (int j = 0; j < 16; ++j) a += v[j] * p.router_w[(size_t)(lane + 64 * j) * NE + e];
        lg[e] = wave_sum(a) + p.router_b[e]; }
    if (lane == 0) {
        int idx[TOPK]; float val[TOPK]; unsigned used = 0u;
#pragma unroll
        for (int t = 0; t < TOPK; ++t) { int bi = -1; float bv = -3.0e38f;
#pragma unroll
            for (int e = 0; e < NE; ++e) { const bool free_ = !((used >> e) & 1u); if (free_ && lg[e] > bv) { bv = lg[e]; bi = e; } }
            idx[t] = bi; val[t] = bv; used |= 1u << bi; }
        float ex[TOPK], se = 0.f;
#pragma unroll
        for (int t = 0; t < TOPK; ++t) { ex[t] = __expf(val[t] - val[0]); se += ex[t]; }
        unsigned* cnt = (unsigned*)(p.ws + WS_CTL) + CW_CNT;
#pragma unroll
        for (int t = 0; t < TOPK; ++t) {
            const int e = idx[t]; const unsigned slot = atomicAdd(&cnt[e], 1u);
            ((int*)(p.ws + WS_TOK))[(size_t)e * M + slot] = row;
            ((float*)(p.ws + WS_GATE))[(size_t)e * M + slot] = ex[t] / se;
            ((int*)(p.ws + WS_INV))[(size_t)row * 4 + t] = e * M + (int)slot;
        }
    }
}
__global__ __launch_bounds__(256) void nv_final(P p) {
    const int row = blockIdx.x * 4 + (threadIdx.x >> 6), lane = threadIdx.x & 63;
    const float* mx = (const float*)(p.ws + WS_MX) + (row / SEQ) * 6144 + 5 * 1024;
    const unsigned* cnt = (const unsigned*)(p.ws + WS_CTL) + CW_CNT;
    const int* inv = (const int*)(p.ws + WS_INV) + (size_t)row * 4;
    const bf16* op[TOPK];
#pragma unroll
    for (int t = 0; t < TOPK; ++t) { const int e = inv[t] / M, slot = inv[t] % M; op[t] = (const bf16*)(p.ws + WS_OUTP) + (size_t)(expert_base(cnt, e) + slot) * D; }
    float* xo = p.out + (size_t)row * D;
    float v[16]; float s = 0.f;
#pragma unroll
    for (int j = 0; j < 16; ++j) { const int k = lane + 64 * j; float y = 0.f;
#pragma unroll
        for (int t = 0; t < TOPK; ++t) y += bf2f(op[t][k]);
        v[j] = xo[k] + mx[k] * y; s += v[j] * v[j]; }
    const float rstd = rsqrtf(wave_sum(s) * (1.0f / D) + EPS);
#pragma unroll
    for (int j = 0; j < 16; ++j) { const int k = lane + 64 * j; xo[k] = v[j] * rstd * p.norm_final[k]; }
}

#define LAS __attribute__((address_space(3)))
#define GAS __attribute__((address_space(1)))
typedef short bf16x8 __attribute__((ext_vector_type(8)));
typedef float f32x4 __attribute__((ext_vector_type(4)));
typedef float f32x2 __attribute__((ext_vector_type(2)));
typedef unsigned u32x4 __attribute__((ext_vector_type(4)));
typedef unsigned u32x2 __attribute__((ext_vector_type(2)));
typedef int i32x4 __attribute__((ext_vector_type(4)));
typedef int i32x8 __attribute__((ext_vector_type(8)));
constexpr size_t WS_X1 = WS_GG;
constexpr size_t WS_FX8 = 612 * MiB;
__device__ __forceinline__ unsigned pk4_fp8(float a, float b, float c, float d) { int w = 0; w = __builtin_amdgcn_cvt_pk_fp8_f32(a, b, w, false); w = __builtin_amdgcn_cvt_pk_fp8_f32(c, d, w, true); return (unsigned)w; }
constexpr int NWAVES = 8, NTHR = 512;
constexpr int RING_BYTES = 131072, AUX_OFF = RING_BYTES, AUX_BYTES = 28672, MISC_OFF = AUX_OFF + AUX_BYTES, LDS_BYTES = MISC_OFF + 512;
constexpr size_t WS_ZERO = WS_CTL + 66048;
constexpr int CW_BAR = 4096;
constexpr size_t CTL_ZERO_BYTES = 131072;

__device__ __forceinline__ unsigned cvt_pk_bf16(float lo, float hi) { unsigned r; asm volatile("v_cvt_pk_bf16_f32 %0, %1, %2" : "=v"(r) : "v"(lo), "v"(hi)); return r; }
__device__ __forceinline__ unsigned pk2(float lo, float hi) { return (unsigned)f2bf(lo) | ((unsigned)f2bf(hi) << 16); }
__device__ __forceinline__ float bflo(unsigned w) { return __uint_as_float(w << 16); }
__device__ __forceinline__ float bfhi(unsigned w) { return __uint_as_float(w & 0xffff0000u); }
__device__ __forceinline__ float gelu_fast(float v) { const float t = v * (-2.3022082f - 0.10294324f * v * v); return v * __builtin_amdgcn_rcpf(1.0f + __builtin_amdgcn_exp2f(t)); }
__device__ __forceinline__ float fsig(float v) { return __builtin_amdgcn_rcpf(1.0f + __expf(-v)); }
__device__ __forceinline__ void mfma_f8_inplace(f32x4& acc, const i32x8& a, const i32x8& b, int sa, int sb) {
    asm volatile("v_mfma_scale_f32_16x16x128_f8f6f4 %0, %1, %2, %0, %3, %4 op_sel_hi:[0,0,0]" : "+v"(acc) : "v"(a), "v"(b), "v"(sa), "v"(sb));
}
__device__ __forceinline__ void mfma_bf16_inplace(f32x4& acc, const bf16x8& a, const bf16x8& b) {
    asm volatile("v_mfma_f32_16x16x32_bf16 %0, %1, %2, %0" : "+v"(acc) : "v"(a), "v"(b));
}
#define LDS_WAIT() asm volatile("s_waitcnt lgkmcnt(0)" ::: "memory")
#define VM_WAIT() asm volatile("s_waitcnt vmcnt(0)" ::: "memory")

namespace pg8 {
constexpr int BM = 256, BK = 64, HALF = 128, HTB = HALF * BK * 2, STAGE_BYTES = 8 * HTB;
__host__ __device__ __forceinline__ int lds_byte(int r, int c) { const int st = (r >> 4) * 2 + (c >> 5), rr = r & 15, cc = c & 31, ob = rr * 64 + cc * 2; return st * 1024 + (ob ^ (((ob >> 9) & 1) << 5)); }
__host__ __device__ __forceinline__ void stage_rc(int b, int& R, int& C) { const int st = b / 1024, sb = b % 1024, swz = sb ^ (((sb >> 9) & 1) << 5); R = (st >> 1) * 16 + swz / 64; C = (st & 1) * 32 + (swz % 64) / 2; }
__host__ __device__ __forceinline__ int perm32(int rho) { const int n = rho >> 4, i = rho & 15; return 8 * (i >> 2) + 4 * n + (i & 3); }

struct Unit { const char* A; const char* B; const int* gat; int gcnt, grow0; int kind, row0, ocol, e, slot0; };

__device__ __forceinline__ void arows(const Unit& u, unsigned (&rp)[2]) {
    int R[2], C[2]; int tx = (int)threadIdx.x; asm volatile("" : "+v"(tx));
#pragma unroll
    for (int i = 0; i < 2; ++i) stage_rc(tx * 16 + i * 8192, R[i], C[i]);
#pragma unroll
    for (int h = 0; h < 2; ++h) {
        int r[2];
#pragma unroll
        for (int i = 0; i < 2; ++i) { r[i] = h * HALF + R[i]; if (u.gat) { const int gr = u.grow0 + r[i]; r[i] = gr < u.gcnt ? u.gat[gr] : 0; } }
        rp[h] = (unsigned)r[0] | ((unsigned)r[1] << 16);
    }
}
__device__ __forceinline__ void arows_issue(const Unit& u, LAS unsigned char* idx) {
    int R[2], C[2]; int tx = (int)threadIdx.x; asm volatile("" : "+v"(tx));
    const unsigned wofs = (unsigned)__builtin_amdgcn_readfirstlane(tx >> 6) * 256u;
#pragma unroll
    for (int i = 0; i < 2; ++i) stage_rc(tx * 16 + i * 8192, R[i], C[i]);
#pragma unroll
    for (int h = 0; h < 2; ++h)
#pragma unroll
        for (int i = 0; i < 2; ++i) { int gr = u.grow0 + h * HALF + R[i]; gr = gr < u.gcnt ? gr : u.gcnt - 1;
            __builtin_amdgcn_global_load_lds((const unsigned*)(u.gat + gr), (LAS unsigned*)(idx + (h * 2 + i) * 2048 + wofs), 4, 0, 0); }
}
__device__ __forceinline__ void arows_fetch(const LAS unsigned char* idx, unsigned (&rp)[2]) {
    int tx = (int)threadIdx.x; asm volatile("" : "+v"(tx));
    const LAS unsigned* q = (const LAS unsigned*)idx + tx;
    rp[0] = q[0] | (q[512] << 16); rp[1] = q[1024] | (q[1536] << 16);
}

template <class Epi, class Sched, bool MID, bool F8 = false, bool ALIGN = true>
__device__ __forceinline__ void gemm_phase(LAS unsigned char* lds, const int K, const Sched& S, const Epi& E, const int pitch_ = 0) {
    const int tid = threadIdx.x, wid = __builtin_amdgcn_readfirstlane(tid >> 6), lane = tid & 63, wr = wid >> 2, wc = wid & 3, fr = lane & 15, fq = lane >> 4;
#ifndef UEW_ALL
#define UEW_ALL 0
#endif
    constexpr bool UEW = F8 || UEW_ALL;
    const int nt = F8 ? K / 128 : K / BK;
    unsigned voffB[2], cpk = 0u;
    const int pitch = pitch_ ? pitch_ : (F8 ? K : 2 * K);
#pragma unroll
    for (int i = 0; i < 2; ++i) { int R, C; stage_rc(tid * 16 + i * 8192, R, C); const int Rb = Epi::PERM ? ((R & ~31) + perm32(R & 31)) : R; voffB[i] = (unsigned)(Rb * pitch + C * 2); cpk |= (unsigned)(C * 2) << (8 * i); }
    const size_t kstep = (size_t)(BK * 2);
    const size_t hstep = (size_t)HALF * pitch;
    const unsigned ldsw = (unsigned)wid * 1024u;
    const int aoff = lds_byte(wr * 64 + fr, fq * 8), boff = lds_byte(wc * 32 + fr, fq * 8);
#define PG8_SA(b, h) (((b) * 2 + (h)) * HTB)
#define PG8_SB(b, h) ((4 + (b) * 2 + (h)) * HTB)
#define PG8_STAGE(bufoff, gbase, voff) do { _Pragma("unroll") for (int _i = 0; _i < 2; ++_i) \
        __builtin_amdgcn_global_load_lds((const unsigned*)((const char*)(gbase) + (voff)[_i]), (LAS unsigned*)(lds + (bufoff) + ldsw + _i * 8192), 16, 0, 0); } while (0)
#define PG8_STAGE_A(bufoff, gbase, rpk) do { _Pragma("unroll") for (int _i = 0; _i < 2; ++_i) \
        __builtin_amdgcn_global_load_lds((const unsigned*)((const char*)(gbase) + ((unsigned)__mul24((int)(((rpk) >> (16 * _i)) & 0xffffu), pitch) + ((cpk >> (8 * _i)) & 0xffu))), (LAS unsigned*)(lds + (bufoff) + ldsw + _i * 8192), 16, 0, 0); } while (0)
#define PG8_LDA(dst, b, h) do { _Pragma("unroll") for (int m = 0; m < 4; ++m) _Pragma("unroll") for (int k = 0; k < 2; ++k) dst[m][k] = *(const LAS bf16x8*)(lds + PG8_SA(b, h) + aoff + m * 2048 + k * 1024); } while (0)
#define PG8_LDB(dst, b, h) do { _Pragma("unroll") for (int n = 0; n < 2; ++n) _Pragma("unroll") for (int k = 0; k < 2; ++k) dst[n][k] = *(const LAS bf16x8*)(lds + PG8_SB(b, h) + boff + n * 2048 + k * 1024); } while (0)
#define PG8_CAT(x) __builtin_shufflevector((i32x4)(x)[0], (i32x4)(x)[1], 0, 1, 2, 3, 4, 5, 6, 7)
#define PG8_MMA(ai, bj, At, Bt) do { __builtin_amdgcn_s_setprio(1); \
        if constexpr (F8) { _Pragma("unroll") for (int m = 0; m < 4; ++m) _Pragma("unroll") for (int n = 0; n < 2; ++n) mfma_f8_inplace(acc[ai][bj][m][n], PG8_CAT(Bt[n]), PG8_CAT(At[m]), f8sa, f8sb); } \
        else { _Pragma("unroll") for (int m = 0; m < 4; ++m) _Pragma("unroll") for (int n = 0; n < 2; ++n) _Pragma("unroll") for (int k = 0; k < 2; ++k) acc[ai][bj][m][n] = __builtin_amdgcn_mfma_f32_16x16x32_bf16(Bt[n][k], At[m][k], acc[ai][bj][m][n], 0, 0, 0); } \
        __builtin_amdgcn_s_setprio(0); } while (0)
#define PG8_WAIT_V(n) asm volatile("s_waitcnt vmcnt(" #n ")" ::: "memory")
#define PG8_WAIT_L(n) asm volatile("s_waitcnt lgkmcnt(" #n ")" ::: "memory")
#define PG8_BAR __builtin_amdgcn_s_barrier()
#define PG8_SCHED __builtin_amdgcn_sched_barrier(0)
    Unit cur, nxt; int ui = 0;
    if (!S.next(0, cur)) return;
    const int f8sa = 0x7A7A7A7A, f8sb = 0x7F7F7F7F;
    f32x4 acc[2][2][4][2];
#pragma unroll
    for (int a = 0; a < 2; ++a)
#pragma unroll
        for (int b = 0; b < 2; ++b)
#pragma unroll
            for (int m = 0; m < 4; ++m)
#pragma unroll
                for (int n = 0; n < 2; ++n) acc[a][b][m][n] = (f32x4){0.f, 0.f, 0.f, 0.f};
    bf16x8 At[4][2], B0[2][2], B1[2][2];
    unsigned oA[2];
    arows(cur, oA);
    const char* cA = cur.A; const char* cB = cur.B;
    PG8_STAGE(PG8_SB(0, 0), cB, voffB); PG8_STAGE(PG8_SB(0, 1), cB + hstep, voffB); PG8_STAGE_A(PG8_SA(0, 0), cA, oA[0]); PG8_STAGE_A(PG8_SA(0, 1), cA, oA[1]);
    if (wr == 1) PG8_BAR;
    PG8_WAIT_V(2); PG8_BAR;
    PG8_STAGE(PG8_SB(1, 0), cB + kstep, voffB); PG8_STAGE_A(PG8_SA(1, 0), cA + kstep, oA[0]); PG8_STAGE(PG8_SB(1, 1), cB + hstep + kstep, voffB);
    PG8_WAIT_V(6); PG8_BAR;
    bool has_next = false;
    unsigned nO[2] = {oA[0], oA[1]};
    if constexpr (Sched::GATHER) { has_next = S.next(1, nxt); if (has_next) arows(nxt, nO); }
    for (;;) {
        if constexpr (!Sched::GATHER) has_next = S.next(ui + 1, nxt);
        const char* nA = has_next ? nxt.A : cA; const char* nB = has_next ? nxt.B : cB;
        bool nraw_on = false;
        for (int t = 0; t < nt; t += 2) {
            const bool last = (t == nt - 2);
            if constexpr (Sched::GATHER) { if (t == 0 && has_next) { Unit t2; if (S.next(ui + 2, t2) && t2.gat) { arows_issue(t2, lds + AUX_OFF + 8192); nraw_on = true; } } }
            if (MID && t == nt / 2) E.mid(acc, cur, wr, wc, fr, fq);
            const char* a1 = cA + (size_t)(t + 1) * kstep;
            const char* a2 = last ? nA : cA + (size_t)(t + 2) * kstep; const char* b2 = last ? nB : cB + (size_t)(t + 2) * kstep;
            const char* a3 = a2 + kstep; const char* b3 = b2 + kstep;
            PG8_LDB(B0, 0, 0); PG8_LDB(B1, 0, 1); PG8_SCHED; PG8_LDA(At, 0, 0); PG8_STAGE_A(PG8_SA(1, 1), a1, oA[1]);
            PG8_WAIT_V(8);
            PG8_WAIT_L(0); PG8_BAR; PG8_MMA(0, 0, At, B0); PG8_MMA(0, 1, At, B1); PG8_BAR; PG8_SCHED;
            if constexpr (Sched::GATHER) { if (last) { oA[0] = nO[0]; oA[1] = nO[1]; } }
            PG8_LDA(At, 0, 1); PG8_STAGE(PG8_SB(0, 0), b2, voffB); PG8_STAGE(PG8_SB(0, 1), b2 + hstep, voffB); PG8_STAGE_A(PG8_SA(0, 0), a2, oA[0]);
            PG8_WAIT_V(8);
            PG8_WAIT_L(0); PG8_BAR; PG8_MMA(1, 0, At, B0); PG8_MMA(1, 1, At, B1); PG8_BAR; PG8_SCHED;
            PG8_LDB(B0, 1, 0); PG8_LDB(B1, 1, 1); PG8_SCHED; PG8_LDA(At, 1, 0); PG8_STAGE_A(PG8_SA(0, 1), a2, oA[1]);
            PG8_WAIT_V(8); PG8_WAIT_L(0); PG8_BAR; PG8_MMA(0, 0, At, B0); PG8_MMA(0, 1, At, B1); PG8_BAR; PG8_SCHED;
            PG8_LDA(At, 1, 1); PG8_STAGE(PG8_SB(1, 0), b3, voffB); PG8_STAGE(PG8_SB(1, 1), b3 + hstep, voffB); PG8_STAGE_A(PG8_SA(1, 0), a3, oA[0]);
            PG8_WAIT_V(8); PG8_WAIT_L(0); PG8_BAR; PG8_MMA(1, 0, At, B0); PG8_MMA(1, 1, At, B1); PG8_BAR; PG8_SCHED;
        }
        Unit nn; bool has_nn = false; unsigned nnO[2] = {nO[0], nO[1]};
        if constexpr (Sched::GATHER) { if (has_next) { has_nn = S.next(ui + 2, nn); if (has_nn && !nraw_on) arows(nn, nnO); } }
        f32x4 epf[6];
        E.pre(cur, wr, wc, fr, fq, epf);
        if constexpr (UEW) PG8_WAIT_V(0);
        if constexpr (Sched::GATHER) { if (has_nn && nraw_on) arows_fetch(lds + AUX_OFF + 8192, nnO); asm volatile("" : "+v"(nnO[0]), "+v"(nnO[1])); }
        if constexpr (ALIGN) { if (wr == 0) PG8_BAR; }
        if constexpr (F8) asm volatile("s_nop 15\n\ts_nop 7" ::: "memory");
        E(acc, cur, wr, wc, fr, fq, epf);
        if (!has_next) break;
#pragma unroll
        for (int a = 0; a < 2; ++a)
#pragma unroll
            for (int b = 0; b < 2; ++b)
#pragma unroll
                for (int m = 0; m < 4; ++m)
#pragma unroll
                    for (int n = 0; n < 2; ++n) acc[a][b][m][n] = (f32x4){0.f, 0.f, 0.f, 0.f};
        cur = nxt; cA = nA; cB = nB; ++ui;
        if constexpr (Sched::GATHER) { nxt = nn; has_next = has_nn; nO[0] = nnO[0]; nO[1] = nnO[1]; }
        if constexpr (ALIGN) { if (wr == 1) PG8_BAR; }
    }
    PG8_WAIT_V(0);
    if constexpr (!ALIGN) { if (wr == 0) PG8_BAR; }
    PG8_BAR;
#undef PG8_SA
#undef PG8_SB
#undef PG8_STAGE
#undef PG8_STAGE_A
#undef PG8_LDA
#undef PG8_LDB
#undef PG8_MMA
#undef PG8_CAT
#undef PG8_WAIT_V
#undef PG8_WAIT_L
#undef PG8_BAR
#undef PG8_SCHED
}
__device__ __forceinline__ void static_order(int L, int nM, int nN, int& pm, int& pn) {
    const int nwg = nM * nN; int wgid = L;
    { const int q = nwg / 8, r = nwg % 8, xcd = wgid % 8, off = wgid / 8; wgid = (xcd < r ? xcd * (q + 1) : r * (q + 1) + (xcd - r) * q) + off; }
    const int nig = 8 * nN, gid = wgid / nig, fm = gid * 8, gsz = (nM - fm) < 8 ? (nM - fm) : 8;
    pm = fm + ((wgid % nig) % gsz); pn = (wgid % nig) / gsz;
}
}
using pg8::Unit;

struct SchedInProj {
    static constexpr bool GATHER = false;
    const char *HX, *HC, *WIN; int G, c, nctx, same;
    __device__ __forceinline__ bool next(int i, Unit& u) const {
        const int L = i * G + c; if (L >= 3584 + nctx) return false;
        int pm, pn; bool ctx = false;
        if (L < 3584) { pg8::static_order(L, 128, 28, pm, pn); u.A = HX + (size_t)(same ? 0 : pm) * 256 * PA * 2; }
        else { const int r = L - 3584; pm = r >> 2; pn = 12 + (r & 3); u.A = HC + (size_t)pm * 256 * PA * 2; ctx = true; }
        u.B = WIN + (size_t)(same ? 0 : pn) * 256 * PA * 2; u.gat = nullptr; u.gcnt = 0; u.grow0 = 0; u.row0 = pm * 256; u.e = 0; u.slot0 = 0;
        if (pn < 4) { u.kind = 0; u.ocol = pn * 256; }
        else if (pn < 12) { u.kind = 1; u.ocol = (pn - 4) * 128; }
        else if (pn < 16) { u.kind = ctx ? 5 : 2; u.ocol = (pn - 12) * 256; }
        else if (pn < 20) { u.kind = 3; u.ocol = (pn - 16) * 256; }
        else { u.kind = 4; u.ocol = (pn - 20) * 128; }
        return true;
    }
};
struct SchedCtx {
    static constexpr bool GATHER = false;
    const char *HC, *WIN; int v;
    __device__ __forceinline__ bool next(int i, Unit& u) const {
        if (i > 0) return false;
        const int pm = v >> 2, pn = 12 + (v & 3);
        u.A = HC + (size_t)pm * 256 * D * 2; u.B = WIN + (size_t)pn * 256 * D * 2; u.gat = nullptr; u.gcnt = 0; u.grow0 = 0; u.row0 = pm * 256; u.e = 0; u.slot0 = 0; u.kind = 5; u.ocol = (pn - 12) * 256;
        return true;
    }
};
struct SchedDense {
    static constexpr bool GATHER = false;
    const char *A, *B; int K, G, c;
    __device__ __forceinline__ bool next(int i, Unit& u) const {
        const int L = i * G + c; if (L >= 128 * 4) return false;
        int pm, pn; pg8::static_order(L, 128, 4, pm, pn);
        u.A = A + (size_t)pm * 256 * K * 2; u.B = B + (size_t)pn * 256 * K * 2; u.gat = nullptr; u.gcnt = 0; u.grow0 = 0; u.kind = 0; u.row0 = pm * 256; u.ocol = pn * 256; u.e = 0; u.slot0 = 0;
        return true;
    }
};
constexpr int MOE_NREC = 64;
struct SchedMoe {
    static constexpr bool GATHER = true;
    const char *Abase, *W; const int* tok; const LAS int* tab; int npn, G, c, gather, wrows, esz;
    __device__ __forceinline__ bool next(int i, Unit& u) const {
#define RFL(x) __builtin_amdgcn_readfirstlane(x)
        if (i >= MOE_NREC) return false;
        const i32x4 r = *(const LAS i32x4*)(tab + 128 + 4 * i);
        if (RFL(r[0]) == 0) return false;
        const int pk = RFL(r[1]), cnt = RFL(r[2]), rb = RFL(r[3]), e = pk & 255, pn = (pk >> 8) & 255, mt = pk >> 16;
#undef RFL
        u.e = e; u.slot0 = mt * 256; u.row0 = rb; u.kind = 0; u.gcnt = cnt; u.grow0 = mt * 256;
        u.B = W + ((size_t)e * wrows + (size_t)pn * 256) * DE * esz;
        if (gather) { u.A = Abase; u.gat = tok + (size_t)e * M; u.ocol = pn * 128; }
        else { u.A = Abase + (size_t)rb * DE * esz; u.gat = nullptr; u.ocol = pn * 256; }
        return true;
    }
};
__device__ __forceinline__ void moe_tables(LAS int* tab, const unsigned* gcnt, int npn, int G = 0, int c = 0) {
    if (threadIdx.x == 0) { int pu = 0, pr = 0; for (int e = 0; e < NE; ++e) { const int cn = (int)gcnt[e], t = (cn + 255) >> 8; tab[e] = pu; tab[33 + e] = cn; tab[65 + e] = pr; pu += t * npn; pr += t * 256; } tab[32] = pu; }
    __syncthreads();
    if (G > 0 && (int)threadIdx.x < MOE_NREC) {
        const int i = (int)threadIdx.x, L = i * G + c; i32x4 r = (i32x4){0, 0, 0, 0};
        if (L < tab[32]) { int e = 0;
#pragma unroll
            for (int s = 16; s >= 1; s >>= 1) if (tab[e + s] <= L) e += s;
            const int cnt = tab[33 + e], tiles = (cnt + 255) >> 8, l = L - tab[e], pn = l / tiles, mt = l - pn * tiles;
            r = (i32x4){1, e | (pn << 8) | (mt << 16), cnt, tab[65 + e] + mt * 256}; }
        *(LAS i32x4*)(tab + 128 + 4 * i) = r;
    }
    if (G > 0) __syncthreads();
}

struct EpiInProj {
    static constexpr bool PERM = true;
    unsigned char* ws; const float* bmerge; int skip;
    __device__ __forceinline__ void mid(f32x4 (&)[2][2][4][2], const Unit&, int, int, int, int) const {}
    __device__ __forceinline__ void pre(const Unit& u, int wr, int wc, int fr, int fq, f32x4 (&epf)[6]) const {
        if (u.kind == 4) { const int cl = wc * 32 + 8 * fq;
#pragma unroll
            for (int n = 0; n < 2; ++n) { epf[n] = *(const f32x4*)(bmerge + u.ocol + cl + 4 * n); epf[2 + n] = *(const f32x4*)(bmerge + D + u.ocol + cl + 4 * n); } }
    }
    __device__ __forceinline__ void operator()(const f32x4 (&acc)[2][2][4][2], const Unit& u, int wr, int wc, int fr, int fq, const f32x4 (&epf)[6]) const {
        if (skip == 1) return;
        const bool st_ = !(skip == 2 && u.row0 >= 0);
        int row0 = u.row0 + wr * 64 + fr; asm volatile("" : "+v"(row0)); const int cl = wc * 32 + 8 * fq;
        if (u.kind == 1) {
            bf16* base = (bf16*)(ws + WS_U) + u.ocol + cl;
#pragma unroll
            for (int ai = 0; ai < 2; ++ai)
#pragma unroll
                for (int m = 0; m < 4; ++m) { const f32x4 v0 = acc[ai][0][m][0] * acc[ai][1][m][0], v1 = acc[ai][0][m][1] * acc[ai][1][m][1];
                    u32x4 w; w.x = cvt_pk_bf16(v0[0], v0[1]); w.y = cvt_pk_bf16(v0[2], v0[3]); w.z = cvt_pk_bf16(v1[0], v1[1]); w.w = cvt_pk_bf16(v1[2], v1[3]);
                    if (st_) *(u32x4*)(base + (size_t)(row0 + ai * 128 + m * 16) * D) = w; }
        } else if (u.kind == 4) {
            bf16* rat = (bf16*)(ws + WS_RAT) + u.ocol + cl; bf16* sbg = (bf16*)(ws + WS_SBG) + u.ocol + cl;
            f32x4 ba[2], bb[2];
#pragma unroll
            for (int n = 0; n < 2; ++n) { ba[n] = epf[n] * -1.4426950409f; bb[n] = epf[2 + n] * -1.4426950409f; }
#pragma unroll
            for (int ai = 0; ai < 2; ++ai)
#pragma unroll
                for (int m = 0; m < 4; ++m) { f32x4 r[2], s[2];
#pragma unroll
                    for (int n = 0; n < 2; ++n)
#pragma unroll
                        for (int j = 0; j < 4; ++j) { const float ea = __builtin_amdgcn_exp2f(acc[ai][0][m][n][j] * -1.4426950409f + ba[n][j]), eb = __builtin_amdgcn_exp2f(acc[ai][1][m][n][j] * -1.4426950409f + bb[n][j]);
                            s[n][j] = __builtin_amdgcn_rcpf(1.0f + eb); r[n][j] = (1.0f + eb) * __builtin_amdgcn_rcpf(1.0f + ea); }
                    u32x4 w; w.x = cvt_pk_bf16(r[0][0], r[0][1]); w.y = cvt_pk_bf16(r[0][2], r[0][3]); w.z = cvt_pk_bf16(r[1][0], r[1][1]); w.w = cvt_pk_bf16(r[1][2], r[1][3]);
                    u32x4 x; x.x = cvt_pk_bf16(s[0][0], s[0][1]); x.y = cvt_pk_bf16(s[0][2], s[0][3]); x.z = cvt_pk_bf16(s[1][0], s[1][1]); x.w = cvt_pk_bf16(s[1][2], s[1][3]);
                    const size_t o = (size_t)(row0 + ai * 128 + m * 16) * D; if (st_) { *(u32x4*)(rat + o) = w; *(u32x4*)(sbg + o) = x; } }
        } else {
            bf16* base = (bf16*)(ws + (u.kind == 0 ? WS_GB : u.kind == 2 ? WS_ULRU : u.kind == 3 ? WS_GG : WS_CS3)) + u.ocol + cl;
            const bool gelu = u.kind == 3;
#pragma unroll
            for (int ai = 0; ai < 2; ++ai)
#pragma unroll
                for (int m = 0; m < 4; ++m)
#pragma unroll
                    for (int bj = 0; bj < 2; ++bj) { f32x4 v0 = acc[ai][bj][m][0], v1 = acc[ai][bj][m][1];
                        if (gelu) {
#pragma unroll
                            for (int j = 0; j < 4; ++j) { v0[j] = gelu_fast(v0[j]); v1[j] = gelu_fast(v1[j]); } }
                        u32x4 w; w.x = cvt_pk_bf16(v0[0], v0[1]); w.y = cvt_pk_bf16(v0[2], v0[3]); w.z = cvt_pk_bf16(v1[0], v1[1]); w.w = cvt_pk_bf16(v1[2], v1[3]);
                        if (st_) *(u32x4*)(base + (size_t)(row0 + ai * 128 + m * 16) * D + bj * 128) = w; }
        }
    }
};
struct EpiMerge {
    static constexpr bool PERM = true;
    unsigned char* ws;
    __device__ __forceinline__ void mid(f32x4 (&acc)[2][2][4][2], const Unit& u, int wr, int wc, int fr, int fq) const {
        const bf16* rat = (const bf16*)(ws + WS_RAT) + u.ocol + wc * 32 + 8 * fq; int row0 = u.row0 + wr * 64 + fr; asm volatile("" : "+v"(row0));
#pragma unroll
        for (int ai = 0; ai < 2; ++ai) {
            u32x4 w[4][2];
#pragma unroll
            for (int m = 0; m < 4; ++m)
#pragma unroll
                for (int bj = 0; bj < 2; ++bj) w[m][bj] = __builtin_nontemporal_load((const u32x4*)(rat + (size_t)(row0 + ai * 128 + m * 16) * D + bj * 128));
#pragma unroll
            for (int m = 0; m < 4; ++m)
#pragma unroll
                for (int bj = 0; bj < 2; ++bj) { const u32x4 q = w[m][bj];
                    acc[ai][bj][m][0] *= (f32x4){bflo(q.x), bfhi(q.x), bflo(q.y), bfhi(q.y)}; acc[ai][bj][m][1] *= (f32x4){bflo(q.z), bfhi(q.z), bflo(q.w), bfhi(q.w)}; }
            asm volatile("" ::: "memory"); }
    }
    __device__ __forceinline__ void pre(const Unit&, int, int, int, int, f32x4 (&)[6]) const {}
    __device__ __forceinline__ void operator()(const f32x4 (&acc)[2][2][4][2], const Unit& u, int wr, int wc, int fr, int fq, const f32x4 (&)[6]) const {
        const bf16* sbg = (const bf16*)(ws + WS_SBG) + u.ocol + wc * 32 + 8 * fq; bf16* mg = (bf16*)(ws + WS_MG) + u.ocol + wc * 32 + 8 * fq; int row0 = u.row0 + wr * 64 + fr; asm volatile("" : "+v"(row0));
#pragma unroll
        for (int ai = 0; ai < 2; ++ai) {
            u32x4 w[4][2];
#pragma unroll
            for (int m = 0; m < 4; ++m)
#pragma unroll
                for (int bj = 0; bj < 2; ++bj) w[m][bj] = __builtin_nontemporal_load((const u32x4*)(sbg + (size_t)(row0 + ai * 128 + m * 16) * D + bj * 128));
#pragma unroll
            for (int m = 0; m < 4; ++m)
#pragma unroll
                for (int bj = 0; bj < 2; ++bj) { const size_t o = (size_t)(row0 + ai * 128 + m * 16) * D + bj * 128; const u32x4 q = w[m][bj];
                    const f32x4 v0 = acc[ai][bj][m][0] * (f32x4){bflo(q.x), bfhi(q.x), bflo(q.y), bfhi(q.y)}, v1 = acc[ai][bj][m][1] * (f32x4){bflo(q.z), bfhi(q.z), bflo(q.w), bfhi(q.w)};
                    u32x4 x; x.x = cvt_pk_bf16(v0[0], v0[1]); x.y = cvt_pk_bf16(v0[2], v0[3]); x.z = cvt_pk_bf16(v1[0], v1[1]); x.w = cvt_pk_bf16(v1[2], v1[3]);
                    *(u32x4*)(mg + o) = x; }
            asm volatile("" ::: "memory"); }
    }
};

struct EpiWo {
    static constexpr bool PERM = false;
    const float* x; bf16* out; const float* mx;
    __device__ __forceinline__ void mid(f32x4 (&)[2][2][4][2], const Unit&, int, int, int, int) const {}
    __device__ __forceinline__ void pre(const Unit& u, int wr, int wc, int fr, int fq, f32x4 (&epf)[6]) const {
        const float* gp = mx + (u.row0 / SEQ) * 6144 + 2 * 1024 + u.ocol + wc * 32 + 4 * fq;
#pragma unroll
        for (int bj = 0; bj < 2; ++bj)
#pragma unroll
            for (int n = 0; n < 2; ++n) epf[bj * 2 + n] = *(const f32x4*)(gp + bj * 128 + n * 16);
    }
    __device__ __forceinline__ void operator()(const f32x4 (&acc)[2][2][4][2], const Unit& u, int wr, int wc, int fr, int fq, const f32x4 (&epf)[6]) const {
        int row0 = u.row0 + wr * 64 + fr; asm volatile("" : "+v"(row0)); const int col0 = u.ocol + wc * 32 + 4 * fq;
        f32x4 g[2][2];
#pragma unroll
        for (int bj = 0; bj < 2; ++bj)
#pragma unroll
            for (int n = 0; n < 2; ++n) g[bj][n] = epf[bj * 2 + n];
#pragma unroll
        for (int ai = 0; ai < 2; ++ai)
#pragma unroll
            for (int m2 = 0; m2 < 4; m2 += 2) { f32x4 xv[2][2][2];
#pragma unroll
                for (int mm = 0; mm < 2; ++mm)
#pragma unroll
                    for (int bj = 0; bj < 2; ++bj)
#pragma unroll
                        for (int n = 0; n < 2; ++n) xv[mm][bj][n] = __builtin_nontemporal_load((const f32x4*)(x + (size_t)(row0 + ai * 128 + (m2 + mm) * 16) * D + col0 + bj * 128 + n * 16));
#pragma unroll
                for (int mm = 0; mm < 2; ++mm)
#pragma unroll
                    for (int bj = 0; bj < 2; ++bj)
#pragma unroll
                        for (int n = 0; n < 2; ++n) { const f32x4 o = xv[mm][bj][n] + g[bj][n] * acc[ai][bj][m2 + mm][n]; u32x2 w; w.x = cvt_pk_bf16(o[0], o[1]); w.y = cvt_pk_bf16(o[2], o[3]);
                            *(u32x2*)(out + (size_t)(row0 + ai * 128 + (m2 + mm) * 16) * D + col0 + bj * 128 + n * 16) = w; }
                asm volatile("" ::: "memory"); }
    }
};
struct EpiMoe1 {
    static constexpr bool PERM = true;
    unsigned char* ws; const float* b1;
    __device__ __forceinline__ void mid(f32x4 (&)[2][2][4][2], const Unit&, int, int, int, int) const {}
    __device__ __forceinline__ void pre(const Unit& u, int wr, int wc, int fr, int fq, f32x4 (&epf)[6]) const {
        const float* bp = b1 + (size_t)u.e * 2048 + 2 * (u.ocol + wc * 32 + 8 * fq);
#pragma unroll
        for (int i = 0; i < 4; ++i) epf[i] = *(const f32x4*)(bp + 4 * i);
    }
    __device__ __forceinline__ void operator()(const f32x4 (&acc)[2][2][4][2], const Unit& u, int wr, int wc, int fr, int fq, const f32x4 (&epf)[6]) const {
        int row0 = u.row0 + wr * 64 + fr; asm volatile("" : "+v"(row0)); const int j0 = u.ocol + wc * 32 + 8 * fq;
        f32x4 bv[4];
#pragma unroll
        for (int i = 0; i < 4; ++i) bv[i] = epf[i];
        unsigned char* base = ws + WS_ACT + j0;
#pragma unroll
        for (int ai = 0; ai < 2; ++ai)
#pragma unroll
            for (int m = 0; m < 4; ++m) { f32x4 a[2];
#pragma unroll
                for (int n = 0; n < 2; ++n)
#pragma unroll
                    for (int jj = 0; jj < 4; ++jj) { const float hg = acc[ai][0][m][n][jj] + bv[2 * n + (jj >> 1)][2 * (jj & 1)], hl = acc[ai][1][m][n][jj] + bv[2 * n + (jj >> 1)][2 * (jj & 1) + 1];
                        const float glu = fminf(hg, 7.0f), lin = fminf(fmaxf(hl, -7.0f), 7.0f);
                        a[n][jj] = glu * fsig(1.702f * glu) * (lin + 1.0f); }
                u32x2 w; w.x = pk4_fp8(a[0][0], a[0][1], a[0][2], a[0][3]); w.y = pk4_fp8(a[1][0], a[1][1], a[1][2], a[1][3]);
                *(u32x2*)(base + (size_t)(row0 + ai * 128 + m * 16) * DE) = w; }
    }
};
struct EpiMoe2 {
    static constexpr bool PERM = true;
    unsigned char* ws; const float* b2;
    __device__ __forceinline__ void mid(f32x4 (&)[2][2][4][2], const Unit&, int, int, int, int) const {}
    __device__ __forceinline__ void pre(const Unit& u, int wr, int wc, int fr, int fq, f32x4 (&epf)[6]) const {
        const float* bp = b2 + (size_t)u.e * D + u.ocol + wc * 32 + 8 * fq; const float* gp = (const float*)(ws + WS_GATE) + (size_t)u.e * M + u.slot0 + wr * 64 + fr;
#pragma unroll
        for (int bj = 0; bj < 2; ++bj)
#pragma unroll
            for (int n = 0; n < 2; ++n) epf[bj * 2 + n] = *(const f32x4*)(bp + bj * 128 + 4 * n);
#pragma unroll
        for (int ai = 0; ai < 2; ++ai) epf[4 + ai] = (f32x4){gp[ai * 128], gp[ai * 128 + 16], gp[ai * 128 + 32], gp[ai * 128 + 48]};
    }
    __device__ __forceinline__ void operator()(const f32x4 (&acc)[2][2][4][2], const Unit& u, int wr, int wc, int fr, int fq, const f32x4 (&epf)[6]) const {
        int rl = wr * 64 + fr; asm volatile("" : "+v"(rl)); const int c0 = u.ocol + wc * 32 + 8 * fq;
        f32x4 bv[2][2]; float g[2][4];
#pragma unroll
        for (int bj = 0; bj < 2; ++bj)
#pragma unroll
            for (int n = 0; n < 2; ++n) bv[bj][n] = epf[bj * 2 + n];
#pragma unroll
        for (int ai = 0; ai < 2; ++ai)
#pragma unroll
            for (int m = 0; m < 4; ++m) g[ai][m] = epf[4 + ai][m];
        unsigned char* base = ws + WS_OUTP + c0;
#pragma unroll
        for (int ai = 0; ai < 2; ++ai)
#pragma unroll
            for (int m = 0; m < 4; ++m) {
#pragma unroll
                for (int bj = 0; bj < 2; ++bj) { const f32x4 v0 = (acc[ai][bj][m][0] + bv[bj][0]) * g[ai][m], v1 = (acc[ai][bj][m][1] + bv[bj][1]) * g[ai][m];
                    u32x2 w; w.x = pk4_fp8(v0[0], v0[1], v0[2], v0[3]); w.y = pk4_fp8(v1[0], v1[1], v1[2], v1[3]);
                    *(u32x2*)(base + (size_t)(u.row0 + rl + ai * 128 + m * 16) * D + bj * 128) = w; } }
    }
};

#define XB_TMO      128
#define XB_XCNT(j)  (256  + 64 * (j))
#define XB_XSUB(j)  (1280 + 64 * (j))
#define XB_XGEN(j)  (2304 + 64 * (j))
#define XB_TOP      3328
#define XB_TOPGEN   3392
#define XCD_BAR_WORDS 3456
#define XB_SPIN_CAP (1u << 18)
__device__ __forceinline__ unsigned xb_ld(unsigned* p)              { return __hip_atomic_load(p, __ATOMIC_RELAXED, __HIP_MEMORY_SCOPE_AGENT); }
__device__ __forceinline__ unsigned xb_add(unsigned* p, unsigned v) { return __hip_atomic_fetch_add(p, v, __ATOMIC_RELAXED, __HIP_MEMORY_SCOPE_AGENT); }
__device__ __forceinline__ unsigned xb_xcc_id() { return (unsigned)__builtin_amdgcn_s_getreg((3 << 11) | 20) & 0xFu; }
#define XB_SPIN(cond, bar) do { unsigned _sp = 0; while (cond) { __builtin_amdgcn_s_sleep(1); \
    if ((++_sp & 255u) == 0u) { if (xb_ld(&(bar)[XB_TMO])) break; if (_sp > XB_SPIN_CAP) { atomicAdd(&(bar)[XB_TMO], 1u); break; } } } } while (0)
struct XcdBarrier { unsigned* bar; unsigned x; volatile LAS unsigned* st; };
__device__ __forceinline__ XcdBarrier xcd_barrier_post(unsigned* bar, volatile LAS unsigned* st) {
    XcdBarrier b; b.bar = bar; b.x = xb_xcc_id(); b.st = st;
    if (threadIdx.x == 0) (void)xb_add(&bar[XB_XCNT(b.x)], 1u);
    return b;
}
__device__ __forceinline__ void xcd_barrier_complete(unsigned* bar, unsigned x, unsigned& nloc, unsigned& nx) {
    const unsigned G = gridDim.x * gridDim.y * gridDim.z;
    unsigned sum, cnt, mine, sp = 0u;
    for (;;) {
        sum = 0u; cnt = 0u; mine = 0u;
#pragma unroll
        for (unsigned j = 0; j < 16; ++j) { const unsigned c = xb_ld(&bar[XB_XCNT(j)]); sum += c; cnt += (c > 0u) ? 1u : 0u; mine = (j == x) ? c : mine; }
        if (sum == G) break;
        __builtin_amdgcn_s_sleep(1);
        if ((++sp & 255u) == 0u) { if (xb_ld(&bar[XB_TMO])) break; if (sp > XB_SPIN_CAP) { atomicAdd(&bar[XB_TMO], 1u); break; } }
    }
    nloc = mine > 0u ? mine : 1u; nx = cnt > 0u ? cnt : 1u;
}
__device__ __forceinline__ void xcd_barrier(const XcdBarrier& b) {
    asm volatile("s_waitcnt vmcnt(0)" ::: "memory");
    __syncthreads();
    if (threadIdx.x == 0) {
        unsigned* bar = b.bar;
        __builtin_amdgcn_s_waitcnt(0);
        unsigned nloc = b.st[0], nx = b.st[1];
        if (nloc == 0u) { xcd_barrier_complete(bar, b.x, nloc, nx); b.st[0] = nloc; b.st[1] = nx; }
        const unsigned old = xb_add(&bar[XB_XSUB(b.x)], 1u);
        const unsigned gen = old / nloc;
        if (old + 1u == (gen + 1u) * nloc) {
            __builtin_amdgcn_fence(__ATOMIC_RELEASE, "agent");
            asm volatile("s_waitcnt vmcnt(0)" ::: "memory");
            const unsigned og = xb_add(&bar[XB_TOP], 1u);
            const unsigned tg = og / nx;
            if (og + 1u == (tg + 1u) * nx) xb_add(&bar[XB_TOPGEN], 1u);
            else XB_SPIN(xb_ld(&bar[XB_TOPGEN]) == tg, bar);
            __builtin_amdgcn_fence(__ATOMIC_ACQUIRE, "agent");
            xb_add(&bar[XB_XGEN(b.x)], 1u);
            asm volatile("s_waitcnt vmcnt(0)" ::: "memory");
        } else {
            XB_SPIN(xb_ld(&bar[XB_XGEN(b.x)]) == gen, bar);
            __builtin_amdgcn_fence(__ATOMIC_ACQUIRE, "agent");
            asm volatile("s_waitcnt vmcnt(0)" ::: "memory");
        }
    }
    __syncthreads();
}

struct Frame {
    LAS unsigned char* lds; const P& p;
    int tid, lane, wave, vcu, G, var;
};

template <class RowMap>
__device__ __forceinline__ void p0_transpose_item(const float* W, int N, bf16* WT, int ldt, int coloff, LAS float* scr, int kb, int nb, int lane, RowMap rm) {
    const int k0 = 64 * kb, n0 = 32 * nb;
    float v[32];
#pragma unroll
    for (int i = 0; i < 32; ++i) { const int kk = 2 * i + (lane >> 5); v[i] = W[(size_t)(k0 + kk) * N + n0 + (lane & 31)]; }
#pragma unroll
    for (int i = 0; i < 32; ++i) { const int kk = 2 * i + (lane >> 5); scr[kk * 33 + (lane & 31)] = v[i]; }
    LDS_WAIT(); asm volatile("" ::: "memory");
    const int c = lane & 7;
#pragma unroll
    for (int j = 0; j < 4; ++j) { const int n = (lane >> 3) + 8 * j; const LAS float* s = scr + (8 * c) * 33 + n;
        u32x4 o; o.x = pk2(s[0 * 33], s[1 * 33]); o.y = pk2(s[2 * 33], s[3 * 33]); o.z = pk2(s[4 * 33], s[5 * 33]); o.w = pk2(s[6 * 33], s[7 * 33]);
        *(u32x4*)(WT + (size_t)rm(n0 + n) * ldt + coloff + k0 + 8 * c) = o; }
    LDS_WAIT(); asm volatile("" ::: "memory");
}
template <class RowMap>
__device__ __forceinline__ void p0_transpose_item_f8(const float* W, int N, unsigned char* WT, int ldt, LAS float* scr, int kb, int nb, int lane, RowMap rm) {
    const int k0 = 64 * kb, n0 = 32 * nb;
    float v[32];
#pragma unroll
    for (int i = 0; i < 32; ++i) { const int kk = 2 * i + (lane >> 5); v[i] = W[(size_t)(k0 + kk) * N + n0 + (lane & 31)]; }
#pragma unroll
    for (int i = 0; i < 32; ++i) { const int kk = 2 * i + (lane >> 5); scr[kk * 33 + (lane & 31)] = v[i] * 32.0f; }
    LDS_WAIT(); asm volatile("" ::: "memory");
    const int c = lane & 3;
#pragma unroll
    for (int j = 0; j < 2; ++j) { const int n = (lane >> 2) + 16 * j; const LAS float* s = scr + (16 * c) * 33 + n;
        u32x4 o; o.x = pk4_fp8(s[0 * 33], s[1 * 33], s[2 * 33], s[3 * 33]); o.y = pk4_fp8(s[4 * 33], s[5 * 33], s[6 * 33], s[7 * 33]);
        o.z = pk4_fp8(s[8 * 33], s[9 * 33], s[10 * 33], s[11 * 33]); o.w = pk4_fp8(s[12 * 33], s[13 * 33], s[14 * 33], s[15 * 33]);
        *(u32x4*)(WT + (size_t)rm(n0 + n) * ldt + k0 + 16 * c) = o; }
    LDS_WAIT(); asm volatile("" ::: "memory");
}
struct RmId { __device__ __forceinline__ int operator()(int n) const { return n; } };
struct RmWin { __device__ __forceinline__ int operator()(int n) const { const int g = n >> 10, ch = n & 1023;
    return g == 0 ? ch : g == 1 ? 1024 + 256 * (ch >> 7) + (ch & 127) : g == 2 ? 1024 + 256 * (ch >> 7) + 128 + (ch & 127) : g == 3 ? 3072 + ch : g == 4 ? 4096 + ch : g == 5 ? 5120 + 256 * (ch >> 7) + (ch & 127) : 5120 + 256 * (ch >> 7) + 128 + (ch & 127); } };
struct RmW1 { __device__ __forceinline__ int operator()(int n) const { const int j = n >> 1, h = n & 1; return 256 * (j >> 7) + 128 * h + (j & 127); } };
struct RmGen { int kind, off; __device__ __forceinline__ int operator()(int n) const { return kind == 1 ? RmWin{}(n) : kind == 2 ? RmW1{}(n) : off + n; } };

constexpr int I_ADA = 96 * 8, I_WIN = 16 * 224, I_WA = 16 * 32, I_WO = 16 * 32, I_W1 = NE * 16 * 64, I_W2 = NE * 16 * 32, I_LG = 2 * 16 * 2 * 2;
constexpr int P0_ITEMS = I_ADA + I_WIN + 2 * I_WA + I_WO + I_LG;
constexpr size_t WS_RTAB = WS_MX + 256 * 1024;
constexpr size_t WS_WG = 15 * MiB + 512 * 1024;

struct P0Desc { const float* src; unsigned char* dst; int N, ldtb, n0, rmk, roff, f8; float sc; };
__device__ __forceinline__ P0Desc p0_describe(const P& p, int r) {
    const float* W; int N, ldt, coloff = 0, kb, nb, rmk = 0, roff = 0, f8 = 0; unsigned char* WT; float sc = 1.0f;
    if (r < I_WIN) { W = p.w_in; N = INC; WT = p.ws + WS_WIN; ldt = PA; kb = r / 224; nb = r % 224; rmk = 1; }
    else if ((r -= I_WIN) < I_WA) { W = p.w_out_a; N = D; WT = p.ws + WS_WAB; ldt = 2048; kb = r >> 5; nb = r & 31; }
    else if ((r -= I_WA) < I_WA) { W = p.w_out_b; N = D; WT = p.ws + WS_WAB; ldt = 2048; coloff = 1024; kb = r >> 5; nb = r & 31; }
    else if ((r -= I_WA) < I_WO) { W = p.w_o; N = D; WT = p.ws + WS_WO; ldt = D; kb = r >> 5; nb = r & 31; }
    else { r -= I_WO; const int gate = (r >> 1) & 1, db = r >> 2;
        W = (gate ? p.lru_wx : p.lru_wa) + (size_t)db * 4096; N = 64; WT = p.ws + WS_WG + (size_t)db * 128 * 64 * 2; ldt = 64; kb = 0; nb = r & 1; roff = gate * 64; sc = -1.4426950408889634f; }
    const int esz = f8 ? 1 : 2;
    return P0Desc{W + (size_t)(64 * kb) * N + 32 * nb, WT + (size_t)(coloff + 64 * kb) * esz, N, ldt * esz, 32 * nb, rmk, roff, f8, f8 ? 32.0f : sc};
}
__device__ __forceinline__ void p0_prologue(Frame& F) {
    const P& p = F.p; const int lane = F.lane;
    LAS float* sil = (LAS float*)(F.lds + AUX_OFF);
    for (int i = F.tid; i < 5 * D; i += NTHR) { const int r = i >> 10, k = i & 1023; const float v = r < 4 ? p.c[r * D + k] : p.c_ctx[k]; sil[i] = v * sigmoidf_(v); }
    __syncthreads();
    for (int i = F.vcu * NTHR + F.tid; i < D * NE; i += F.G * NTHR) {
        const int e = i & 31, k = i >> 5; const float w = p.router_w[i]; const bf16 hi = f2bf(w), lo = f2bf(w - bf2f(hi));
        const int off = e * 2048 + ((((k >> 3) ^ (e & 15))) << 4) + (k & 7) * 2; *(bf16*)(p.ws + WS_RTAB + off) = hi; *(bf16*)(p.ws + WS_RTAB + 65536 + off) = lo; }
    LAS float* scr = (LAS float*)(F.lds + F.wave * 16384);
    const int gw = F.vcu * NWAVES + F.wave, NGW = F.G * NWAVES;
    int it = gw;
    for (; it < I_ADA; it += NGW) {
        const int cg = it % 96, ks = it / 96, n = 64 * cg + lane, k0 = 128 * ks; float a[5] = {0.f, 0.f, 0.f, 0.f, 0.f};
        for (int kh = 0; kh < 4; ++kh) {
            float w[32];
#pragma unroll
            for (int j = 0; j < 32; ++j) w[j] = __builtin_nontemporal_load(&p.w_ada[(size_t)(k0 + 32 * kh + j) * 6144 + n]);
#pragma unroll
            for (int j4 = 0; j4 < 8; ++j4)
#pragma unroll
                for (int rr = 0; rr < 5; ++rr) { const f32x4 s = *(const LAS f32x4*)(sil + rr * D + k0 + 32 * kh + 4 * j4); a[rr] += s[0] * w[4 * j4] + s[1] * w[4 * j4 + 1] + s[2] * w[4 * j4 + 2] + s[3] * w[4 * j4 + 3]; }
        }
        float* part = (float*)(p.ws + WS_RAT);
#pragma unroll
        for (int rr = 0; rr < 5; ++rr) __hip_atomic_store(&part[(size_t)(ks * 5 + rr) * 6144 + n], a[rr], __ATOMIC_RELAXED, __HIP_MEMORY_SCOPE_AGENT);
        VM_WAIT();
        unsigned tk = 0; if (lane == 0) tk = __hip_atomic_fetch_add((unsigned*)(p.ws + WS_CTL) + 17408 + cg, 1u, __ATOMIC_RELAXED, __HIP_MEMORY_SCOPE_AGENT);
        tk = __builtin_amdgcn_readfirstlane(tk);
        if (tk == 7u) {
            float* mx = (float*)(p.ws + WS_MX); const float bias = p.b_ada[n];
#pragma unroll
            for (int rr = 0; rr < 5; ++rr) { float sacc = bias;
#pragma unroll
                for (int k2 = 0; k2 < 8; ++k2) sacc += __hip_atomic_load(&part[(size_t)(k2 * 5 + rr) * 6144 + n], __ATOMIC_RELAXED, __HIP_MEMORY_SCOPE_AGENT);
                mx[rr * 6144 + n] = sacc; }
        }
    }
    if (it >= P0_ITEMS) return;
    P0Desc cur = p0_describe(p, it - I_ADA);
    float v[32];
#pragma unroll
    for (int i = 0; i < 32; ++i) v[i] = __builtin_nontemporal_load(&cur.src[(size_t)(2 * i + (lane >> 5)) * cur.N + (lane & 31)]);
    for (;;) {
        const int itn = it + NGW; const bool more = itn < P0_ITEMS;
        P0Desc nxt = cur; float vn[32];
        if (more) { nxt = p0_describe(p, itn - I_ADA);
#pragma unroll
            for (int i = 0; i < 32; ++i) vn[i] = __builtin_nontemporal_load(&nxt.src[(size_t)(2 * i + (lane >> 5)) * nxt.N + (lane & 31)]); }
        const float sc = cur.sc;
#pragma unroll
        for (int i = 0; i < 32; ++i) scr[(2 * i + (lane >> 5)) * 33 + (lane & 31)] = v[i] * sc;
        LDS_WAIT(); asm volatile("" ::: "memory");
        if (cur.f8) {
            const int c = lane & 3;
#pragma unroll
            for (int j = 0; j < 2; ++j) { const int n = (lane >> 2) + 16 * j; const LAS float* s = scr + (16 * c) * 33 + n;
                u32x4 o; o.x = pk4_fp8(s[0 * 33], s[1 * 33], s[2 * 33], s[3 * 33]); o.y = pk4_fp8(s[4 * 33], s[5 * 33], s[6 * 33], s[7 * 33]);
                o.z = pk4_fp8(s[8 * 33], s[9 * 33], s[10 * 33], s[11 * 33]); o.w = pk4_fp8(s[12 * 33], s[13 * 33], s[14 * 33], s[15 * 33]);
                *(u32x4*)(cur.dst + (size_t)RmGen{cur.rmk, cur.roff}(cur.n0 + n) * cur.ldtb + 16 * c) = o; }
        } else {
            const int c = lane & 7;
#pragma unroll
            for (int j = 0; j < 4; ++j) { const int n = (lane >> 3) + 8 * j; const LAS float* s = scr + (8 * c) * 33 + n;
                u32x4 o; o.x = pk2(s[0 * 33], s[1 * 33]); o.y = pk2(s[2 * 33], s[3 * 33]); o.z = pk2(s[4 * 33], s[5 * 33]); o.w = pk2(s[6 * 33], s[7 * 33]);
#ifdef EXP_Q8
                if (cur.rmk == 1 && ((EXP_Q8 >> ((cur.n0 + n) >> 10)) & 1)) {
#define Q8W(x) (__builtin_amdgcn_cvt_f32_fp8(__builtin_amdgcn_cvt_pk_fp8_f32((x) * 32.0f, 0.f, 0, false), 0) * 0.03125f)
                    o.x = pk2(Q8W(s[0 * 33]), Q8W(s[1 * 33])); o.y = pk2(Q8W(s[2 * 33]), Q8W(s[3 * 33])); o.z = pk2(Q8W(s[4 * 33]), Q8W(s[5 * 33])); o.w = pk2(Q8W(s[6 * 33]), Q8W(s[7 * 33])); }
#endif
                *(u32x4*)(cur.dst + (size_t)RmGen{cur.rmk, cur.roff}(cur.n0 + n) * cur.ldtb + 16 * c) = o; }
        }
        LDS_WAIT(); asm volatile("" ::: "memory");
        if (!more) break;
#pragma unroll
        for (int i = 0; i < 32; ++i) v[i] = vn[i];
        cur = nxt; it = itn;
    }
}

__device__ __forceinline__ void p1_row(const float* src, bf16* dst, const f32x4 (&am)[4], const f32x4 (&sh)[4], int lane) {
    f32x4 v[4]; float s = 0.f;
#pragma unroll
    for (int j = 0; j < 4; ++j) { v[j] = *(const f32x4*)(src + 4 * lane + 256 * j); s += (v[j][0] * v[j][0] + v[j][1] * v[j][1]) + (v[j][2] * v[j][2] + v[j][3] * v[j][3]); }
    const float rstd = rsqrtf(wave_sum(s) * (1.0f / D) + EPS);
#pragma unroll
    for (int j = 0; j < 4; ++j) { const f32x4 o = v[j] * rstd * am[j] + sh[j]; u32x2 w; w.x = cvt_pk_bf16(o[0], o[1]); w.y = cvt_pk_bf16(o[2], o[3]); *(u32x2*)(dst + 4 * lane + 256 * j) = w; }
}
__device__ __forceinline__ void p1_mods(const P& p, int b, int lane, f32x4 (&am)[4], f32x4 (&sh)[4]) {
    const float* md = (const float*)(p.ws + WS_MX) + b * 6144;
#pragma unroll
    for (int j = 0; j < 4; ++j) { const int k = 4 * lane + 256 * j; const f32x4 g = *(const f32x4*)(p.norm_mix + k), sc = *(const f32x4*)(md + 1024 + k); am[j] = g * (sc + 1.0f); sh[j] = *(const f32x4*)(md + k); }
}
__device__ __forceinline__ void p1_rows4(const float* src0, bf16* dst0, int r, int rs, int rend, const f32x4 (&am)[4], const f32x4 (&sh)[4], int lane) {
    f32x4 v[4][4]; float s[4];
#pragma unroll
    for (int q = 0; q < 4; ++q) { const int rr = r + q * rs; s[q] = 0.f;
#pragma unroll
        for (int j = 0; j < 4; ++j) v[q][j] = rr < rend ? __builtin_nontemporal_load((const f32x4*)(src0 + (size_t)rr * D + 4 * lane + 256 * j)) : (f32x4){0.f, 0.f, 0.f, 0.f}; }
#pragma unroll
    for (int q = 0; q < 4; ++q) {
#pragma unroll
        for (int j = 0; j < 4; ++j) s[q] += (v[q][j][0] * v[q][j][0] + v[q][j][1] * v[q][j][1]) + (v[q][j][2] * v[q][j][2] + v[q][j][3] * v[q][j][3]); }
#pragma unroll
    for (int o = 1; o < 64; o <<= 1) {
#pragma unroll
        for (int q = 0; q < 4; ++q) s[q] += __shfl_xor(s[q], o); }
#pragma unroll
    for (int q = 0; q < 4; ++q) { const int rr = r + q * rs; if (rr >= rend) continue; const float rstd = rsqrtf(s[q] * (1.0f / D) + EPS); bf16* dst = dst0 + (size_t)rr * PA;
#pragma unroll
        for (int j = 0; j < 4; ++j) { f32x4 o = v[q][j] * rstd * am[j] + sh[j];
#ifdef EXP_Q8
            if (EXP_Q8 & 128) {
#pragma unroll
                for (int e = 0; e < 4; ++e) o[e] = __builtin_amdgcn_cvt_f32_fp8(__builtin_amdgcn_cvt_pk_fp8_f32(o[e], 0.f, 0, false), 0); }
#endif
            u32x2 w; w.x = cvt_pk_bf16(o[0], o[1]); w.y = cvt_pk_bf16(o[2], o[3]); *(u32x2*)(dst + 4 * lane + 256 * j) = w; } }
}
__device__ __forceinline__ void p1_rows(Frame& F) {
    const P& p = F.p; const int lane = F.lane;
    const int gw = F.vcu * NWAVES + F.wave, NGW = F.G * NWAVES;
    f32x4 am[4], sh[4];
    for (int b = 0; b < NB; ++b) {
        p1_mods(p, b, lane, am, sh);
        for (int r = gw; r < SEQ; r += 4 * NGW) p1_rows4(p.x + (size_t)b * SEQ * D, (bf16*)(p.ws + WS_HXP) + (size_t)b * SEQ * PA, r, NGW, SEQ, am, sh, lane);
    }
    p1_mods(p, 4, lane, am, sh);
    for (int r = gw; r < MC; r += 4 * NGW) p1_rows4(p.ctx, (bf16*)(p.ws + WS_HC), r, NGW, MC, am, sh, lane);
}
__device__ __forceinline__ void p1_ctx_rows(Frame& F, int pm) {
    const P& p = F.p; const int lane = F.lane; f32x4 am[4], sh[4];
    p1_mods(p, 4, lane, am, sh);
    for (int r0 = pm * 256 + F.wave * 32; r0 < pm * 256 + F.wave * 32 + 32; r0 += 4) {
        f32x4 v[4][4]; float s[4];
#pragma unroll
        for (int r = 0; r < 4; ++r) { const float* src = p.ctx + (size_t)(r0 + r) * D; s[r] = 0.f;
#pragma unroll
            for (int j = 0; j < 4; ++j) v[r][j] = *(const f32x4*)(src + 4 * lane + 256 * j); }
#pragma unroll
        for (int r = 0; r < 4; ++r) {
#pragma unroll
            for (int j = 0; j < 4; ++j) s[r] += (v[r][j][0] * v[r][j][0] + v[r][j][1] * v[r][j][1]) + (v[r][j][2] * v[r][j][2] + v[r][j][3] * v[r][j][3]); }
#pragma unroll
        for (int o = 1; o < 64; o <<= 1) {
#pragma unroll
            for (int r = 0; r < 4; ++r) s[r] += __shfl_xor(s[r], o); }
#pragma unroll
        for (int r = 0; r < 4; ++r) { const float rstd = rsqrtf(s[r] * (1.0f / D) + EPS); bf16* dst = (bf16*)(p.ws + WS_HC) + (size_t)(r0 + r) * PA;
#pragma unroll
            for (int j = 0; j < 4; ++j) { const f32x4 o = v[r][j] * rstd * am[j] + sh[j]; u32x2 w; w.x = cvt_pk_bf16(o[0], o[1]); w.y = cvt_pk_bf16(o[2], o[3]); *(u32x2*)(dst + 4 * lane + 256 * j) = w; } }
    }
}

__device__ __forceinline__ unsigned dpp_max_u32(unsigned x) {
    x = max(x, (unsigned)__builtin_amdgcn_update_dpp(0, (int)x, 0xB1, 0xF, 0xF, false));
    x = max(x, (unsigned)__builtin_amdgcn_update_dpp(0, (int)x, 0x4E, 0xF, 0xF, false));
    x = max(x, (unsigned)__builtin_amdgcn_update_dpp(0, (int)x, 0x141, 0xF, 0xF, false));
    x = max(x, (unsigned)__builtin_amdgcn_update_dpp(0, (int)x, 0x140, 0xF, 0xF, false));
    return x;
}
__device__ __forceinline__ unsigned rkey(float v, int e) { unsigned u = __float_as_uint(v); u = (u & 0x80000000u) ? ~u : (u | 0x80000000u); return (u & ~31u) | (unsigned)(31 - e); }
__device__ __forceinline__ float rkey_val(unsigned k) { const unsigned u = k & ~31u; return __uint_as_float((u & 0x80000000u) ? (u & 0x7fffffffu) : ~u); }
__device__ __forceinline__ void p6_route(Frame& F) {
    const P& p = F.p; const int tid = F.tid, lane = F.lane, wave = F.wave;
    LAS unsigned char* WH = F.lds; LAS unsigned char* WL = F.lds + 65536;
    for (int i = tid; i < 8192; i += NTHR) *(LAS u32x4*)(F.lds + i * 16) = *(const u32x4*)(p.ws + WS_RTAB + (size_t)i * 16);
    LAS int* cntl = (LAS int*)(F.lds + AUX_OFF);
    LAS int* basel = cntl + 32;
    LAS int* sel_e = cntl + 64; LAS int* sel_r = sel_e + 512; LAS float* sel_g = (LAS float*)(sel_r + 512);
    LAS f32x4* amsh = (LAS f32x4*)(F.lds + AUX_OFF + 8192);
    unsigned* gcnt = (unsigned*)(p.ws + WS_CTL) + CW_CNT;
    const float* mxall = (const float*)(p.ws + WS_MX);
    for (int rg = F.vcu; rg < M / 128; rg += F.G) {
        int tv = F.tid; asm volatile("" : "+v"(tv));
        const int lv = tv & 63;
        __syncthreads();
        if (tv < 32) cntl[tv] = 0;
        const int b = (rg * 128) / SEQ; const float* md = mxall + b * 6144;
        if (wave == 0) {
#pragma unroll
            for (int j = 0; j < 4; ++j) { const int k = 4 * lv + 256 * j; const f32x4 g = *(const f32x4*)(p.norm_ffn + k), sc = *(const f32x4*)(md + 4 * 1024 + k); amsh[j * 64 + lv] = g * (sc + 1.0f); amsh[(4 + j) * 64 + lv] = *(const f32x4*)(md + 3 * 1024 + k); }
        }
        __syncthreads();
        const int row0 = rg * 128 + wave * 16;
        const int er = lv & 15, rq = lv >> 4;
        u32x4 xv[32];
        { const bf16* xr = (const bf16*)(p.ws + WS_X1) + (size_t)(row0 + er) * D + 8 * rq;
#pragma unroll
          for (int s_ = 0; s_ < 32; ++s_) xv[s_] = __builtin_nontemporal_load((const u32x4*)(xr + 32 * s_)); }
        float ss0 = 0.f, ss1 = 0.f;
#pragma unroll
        for (int s_ = 0; s_ < 32; ++s_) { const u32x4 w = xv[s_];
            ss0 += (bflo(w.x) * bflo(w.x) + bfhi(w.x) * bfhi(w.x)) + (bflo(w.y) * bflo(w.y) + bfhi(w.y) * bfhi(w.y));
            ss1 += (bflo(w.z) * bflo(w.z) + bfhi(w.z) * bfhi(w.z)) + (bflo(w.w) * bflo(w.w) + bfhi(w.w) * bfhi(w.w)); }
#pragma unroll
        for (int s_ = 0; s_ < 32; ++s_) asm volatile("" : "+v"(xv[s_]));
        float ssq = ss0 + ss1; ssq += __shfl_xor(ssq, 16); ssq += __shfl_xor(ssq, 32);
        const float rstd = rsqrtf(ssq * (1.0f / D) + EPS);
        { const LAS float* amf = (const LAS float*)amsh; unsigned char* fx8 = p.ws + WS_FX8 + (size_t)(row0 + er) * D + 8 * rq;
#pragma unroll
          for (int s_ = 0; s_ < 32; ++s_) { const int k = 32 * s_ + 8 * rq; const u32x4 w = xv[s_];
            const f32x4 am0 = *(const LAS f32x4*)(amf + k), am1 = *(const LAS f32x4*)(amf + k + 4), sh0 = *(const LAS f32x4*)(amf + 1024 + k), sh1 = *(const LAS f32x4*)(amf + 1024 + k + 4);
            const f32x4 o0 = (f32x4){bflo(w.x), bfhi(w.x), bflo(w.y), bfhi(w.y)} * rstd * am0 + sh0, o1 = (f32x4){bflo(w.z), bfhi(w.z), bflo(w.w), bfhi(w.w)} * rstd * am1 + sh1;
            xv[s_] = (u32x4){cvt_pk_bf16(o0[0], o0[1]), cvt_pk_bf16(o0[2], o0[3]), cvt_pk_bf16(o1[0], o1[1]), cvt_pk_bf16(o1[2], o1[3])};
            u32x2 q8; q8.x = pk4_fp8(o0[0], o0[1], o0[2], o0[3]); q8.y = pk4_fp8(o1[0], o1[1], o1[2], o1[3]);
            *(u32x2*)(fx8 + 32 * s_) = q8; asm volatile("" ::: "memory"); } }
        f32x4 a0 = (f32x4){0.f, 0.f, 0.f, 0.f}, a1 = a0, a2 = a0, a3 = a0;
        const int cb = er * 2048 + ((((er & 12) | (rq ^ (er & 3)))) << 4);
#pragma unroll
        for (int sI = 0; sI < 32; ++sI) { const int co = cb ^ (sI << 6); const bf16x8 af = (bf16x8)xv[sI];
            const bf16x8 h0 = *(const LAS bf16x8*)(WH + co), l0 = *(const LAS bf16x8*)(WL + co);
            const bf16x8 h1 = *(const LAS bf16x8*)(WH + 32768 + co), l1 = *(const LAS bf16x8*)(WL + 32768 + co);
            a0 = __builtin_amdgcn_mfma_f32_16x16x32_bf16(af, h0, a0, 0, 0, 0); a2 = __builtin_amdgcn_mfma_f32_16x16x32_bf16(af, l0, a2, 0, 0, 0);
            a1 = __builtin_amdgcn_mfma_f32_16x16x32_bf16(af, h1, a1, 0, 0, 0); a3 = __builtin_amdgcn_mfma_f32_16x16x32_bf16(af, l1, a3, 0, 0, 0);
            if ((sI & 3) == 3) asm volatile("" ::: "memory"); }
        a0 += a2; a1 += a3;
        const float rb0 = p.router_b[er], rb1 = p.router_b[16 + er];
#pragma unroll
        for (int i = 0; i < 4; ++i) {
            unsigned k0 = rkey(a0[i] + rb0, er), k1 = rkey(a1[i] + rb1, 16 + er), wk[TOPK];
#pragma unroll
            for (int t = 0; t < TOPK; ++t) { const unsigned m = dpp_max_u32(max(k0, k1)); wk[t] = m; k0 = (k0 == m) ? 0u : k0; k1 = (k1 == m) ? 0u : k1; }
            const float v0 = rkey_val(wk[0]); float ex[TOPK], se = 0.f;
#pragma unroll
            for (int t = 0; t < TOPK; ++t) { ex[t] = __expf(rkey_val(wk[t]) - v0); se += ex[t]; }
            const float inv = 1.0f / se;
            if (er < TOPK) { const unsigned w_ = er == 0 ? wk[0] : er == 1 ? wk[1] : er == 2 ? wk[2] : wk[3]; const float g = (er == 0 ? ex[0] : er == 1 ? ex[1] : er == 2 ? ex[2] : ex[3]) * inv;
                const int e = 31 - (int)(w_ & 31u), rl = wave * 16 + 4 * rq + i;
                const int rank = __hip_atomic_fetch_add((int*)&cntl[e], 1, __ATOMIC_RELAXED, __HIP_MEMORY_SCOPE_WORKGROUP); sel_e[rl * 4 + er] = e; sel_r[rl * 4 + er] = rank; sel_g[rl * 4 + er] = g; }
        }
        __syncthreads();
        if (tv < 32) basel[tv] = (int)atomicAdd(&gcnt[tv], (unsigned)cntl[tv]);
        __syncthreads();
        { const int rl = tv >> 2, t = tv & 3, row = rg * 128 + rl, e = sel_e[tv], slot = basel[e] + sel_r[tv];
          ((int*)(p.ws + WS_TOK))[(size_t)e * M + slot] = row; ((float*)(p.ws + WS_GATE))[(size_t)e * M + slot] = sel_g[tv]; ((int*)(p.ws + WS_INV))[(size_t)row * 4 + t] = e * M + slot; }
    }
    __syncthreads();
}

__device__ __forceinline__ void p9_final(Frame& F) {
    const P& p = F.p; const int lane = F.lane;
    LAS int* tab = (LAS int*)(F.lds + AUX_OFF);
    moe_tables(tab, (const unsigned*)(p.ws + WS_CTL) + CW_CNT, 1);
    const int gw = F.vcu * NWAVES + F.wave, NGW = F.G * NWAVES, b = gw & 3;
    const float* gp = (const float*)(p.ws + WS_MX) + b * 6144 + 5 * 1024;
    f32x4 g[4], nf[4];
#pragma unroll
    for (int j = 0; j < 4; ++j) { const int k = 8 * lane + 512 * (j >> 1) + 4 * (j & 1); g[j] = *(const f32x4*)(gp + k); nf[j] = *(const f32x4*)(p.norm_final + k); }
    const int rs = NGW >> 2;
    for (int r = gw >> 2; r < SEQ; r += 2 * rs) {
        int4 iv[2]; bool ok[2];
#pragma unroll
        for (int q = 0; q < 2; ++q) { const int rr = r + q * rs; ok[q] = rr < SEQ; iv[q] = *(const int4*)((const int*)(p.ws + WS_INV) + (size_t)(b * SEQ + (ok[q] ? rr : r)) * 4); }
        u32x2 ow[2][TOPK][2]; u32x4 xw[2][2];
#pragma unroll
        for (int q = 0; q < 2; ++q) { const int row = b * SEQ + (ok[q] ? r + q * rs : r); const int ivs[4] = {iv[q].x, iv[q].y, iv[q].z, iv[q].w};
#pragma unroll
            for (int t = 0; t < TOPK; ++t) { const int e = ivs[t] >> 15, slot = ivs[t] & (M - 1); const unsigned char* op = p.ws + WS_OUTP + (size_t)(tab[65 + e] + slot) * D;
#pragma unroll
                for (int h = 0; h < 2; ++h) ow[q][t][h] = __builtin_nontemporal_load((const u32x2*)(op + 8 * lane + 512 * h)); }
            const bf16* x1 = (const bf16*)(p.ws + WS_X1) + (size_t)row * D;
#pragma unroll
            for (int h = 0; h < 2; ++h) xw[q][h] = __builtin_nontemporal_load((const u32x4*)(x1 + 8 * lane + 512 * h)); }
#pragma unroll
        for (int q = 0; q < 2; ++q) { if (!ok[q]) continue; const int row = b * SEQ + r + q * rs;
            f32x4 y[4];
#pragma unroll
            for (int j = 0; j < 4; ++j) y[j] = (f32x4){0.f, 0.f, 0.f, 0.f};
#pragma unroll
            for (int t = 0; t < TOPK; ++t)
#pragma unroll
                for (int h = 0; h < 2; ++h) { const u32x2 w = ow[q][t][h];
                    y[2 * h] += (f32x4){__builtin_amdgcn_cvt_f32_fp8((int)w.x, 0), __builtin_amdgcn_cvt_f32_fp8((int)w.x, 1), __builtin_amdgcn_cvt_f32_fp8((int)w.x, 2), __builtin_amdgcn_cvt_f32_fp8((int)w.x, 3)};
                    y[2 * h + 1] += (f32x4){__builtin_amdgcn_cvt_f32_fp8((int)w.y, 0), __builtin_amdgcn_cvt_f32_fp8((int)w.y, 1), __builtin_amdgcn_cvt_f32_fp8((int)w.y, 2), __builtin_amdgcn_cvt_f32_fp8((int)w.y, 3)}; }
            float* xo = p.out + (size_t)row * D; f32x4 v[4]; float s = 0.f;
#pragma unroll
            for (int h = 0; h < 2; ++h) { const u32x4 w = xw[q][h];
                v[2 * h] = (f32x4){bflo(w.x), bfhi(w.x), bflo(w.y), bfhi(w.y)} + g[2 * h] * y[2 * h]; v[2 * h + 1] = (f32x4){bflo(w.z), bfhi(w.z), bflo(w.w), bfhi(w.w)} + g[2 * h + 1] * y[2 * h + 1]; }
#pragma unroll
            for (int j = 0; j < 4; ++j) s += (v[j][0] * v[j][0] + v[j][1] * v[j][1]) + (v[j][2] * v[j][2] + v[j][3] * v[j][3]);
            const float rstd = rsqrtf(wave_sum(s) * (1.0f / D) + EPS);
#pragma unroll
            for (int j = 0; j < 4; ++j) { const int k = 8 * lane + 512 * (j >> 1) + 4 * (j & 1); __builtin_nontemporal_store(v[j] * rstd * nf[j], (f32x4*)(xo + k)); }
        }
    }
}
constexpr int TC = 32, NCTXC = CTX / TC, NCH = NCTXC + SEQ / TC;
constexpr int P3_UPITCH = 128, P3_UBUF = 5120, P3_VOFF = 2 * P3_UBUF, P3_VPITCH = 144, P3_WAVE_LDS = P3_VOFF + 4608;
constexpr int P3_WG = 8 * P3_WAVE_LDS, P3_WPITCH = 144, P3_CW = P3_WG + 256 * P3_WPITCH, P3_GB = P3_CW + 2560;
static_assert(P3_VOFF + TC * P3_VPITCH <= P3_WAVE_LDS && P3_GB + 1536 <= RING_BYTES + AUX_BYTES, "P3 LDS map");
constexpr size_t WS_SUMG = WS_HX;
constexpr size_t WS_CARRY = WS_HX + 32 * MiB;
struct Comp { float P, Q; };
__device__ __forceinline__ Comp comp_then(const Comp& e, const Comp& l) { return Comp{e.P * l.P, l.P * e.Q + l.Q}; }

__device__ __forceinline__ void p3_tables(Frame& F, int blk) {
    const P& p = F.p; LAS unsigned char* lds = F.lds; const int tid = F.tid;
    __syncthreads();
    for (int i = tid; i < 2 * 128 * 8; i += NTHR) { const int ck = i & 7, n = (i >> 3) & 127, d = i >> 10;
        *(LAS u32x4*)(lds + P3_WG + (d * 128 + n) * P3_WPITCH + (ck << 4)) = *(const u32x4*)((const bf16*)(p.ws + WS_WG) + ((size_t)(d * 16 + blk) * 128 + n) * 64 + ck * 8); }
    for (int i = tid; i < 2 * 5 * 64; i += NTHR) { const int c = i & 63, t = (i >> 6) % 5, d = i / 320;
        *(LAS float*)(lds + P3_CW + i * 4) = t < 4 ? p.lru_conv_w[(size_t)(d * 4 + (d ? 3 - t : t)) * D + blk * 64 + c] : p.lru_conv_b[d * D + blk * 64 + c]; }
    for (int i = tid; i < 2 * 3 * 64; i += NTHR) { const int c = i & 63, k = (i >> 6) % 3, d = i / 192, g = d * D + blk * 64 + c;
        *(LAS float*)(lds + P3_GB + i * 4) = k == 0 ? -1.4426950408889634f * p.lru_ba[g] : k == 1 ? -1.4426950408889634f * p.lru_bx[g] : 1.4426950408889634f * -8.0f * log1pf(__expf(-p.lru_lambda[g])); }
    LDS_WAIT(); __syncthreads();
}
__device__ __forceinline__ void p3_tile_dma(const P& p, LAS unsigned char* ub, int b, int blk, int nat, int lane) {
    const bool isctx = nat < NCTXC; const int t0 = (isctx ? nat : nat - NCTXC) * TC, L = isctx ? CTX : SEQ;
    const bf16* U = (isctx ? (const bf16*)(p.ws + WS_CS3) + (size_t)b * CTX * D : (const bf16*)(p.ws + WS_ULRU) + (size_t)b * SEQ * D) + blk * 64;
    const bf16* Zp = (const bf16*)(p.ws + WS_ZERO);
#pragma unroll
    for (int i = 0; i < 5; ++i) { const int idx = lane + 64 * i, r = idx >> 3, c = idx & 7, t = t0 - 3 + r; const bf16* src = (t >= 0 && t < L) ? U + (size_t)t * D + c * 8 : Zp;
        __builtin_amdgcn_global_load_lds((const unsigned*)src, (LAS unsigned*)(ub + i * 1024), 16, 0, 0); }
}
template <int PASS, int V = 0>
__device__ __forceinline__ void p3_chunk(Frame& F, int lane, LAS unsigned char* wl, LAS unsigned char* ub, int d, Comp (&tot)[4], const float (&cin)[4], unsigned (&hpk)[2][4][2]) {
    LAS unsigned char* lds = F.lds; const int ch = lane & 15, qd = lane >> 4;
#define TEXP(x) ((V & 1) ? ((x) * 0.5f + 1.0f) : __builtin_amdgcn_exp2f(x))
#define TRCP(x) ((V & 1) ? ((x) * 0.25f) : __builtin_amdgcn_rcpf(x))
#define TSQRT(x) ((V & 1) ? ((x) * 0.5f) : __builtin_amdgcn_sqrtf(x))
    if (!(V & 8)) {
        const int cc = lane & 7, tg = lane >> 3, ro = d ? 3 : 0;
        u32x4 ur[7];
#pragma unroll
        for (int r = 0; r < 7; ++r) ur[r] = *(const LAS u32x4*)(ub + (4 * tg + ro + r) * P3_UPITCH + cc * 16);
        f32x4 cwv[5][2];
#pragma unroll
        for (int t = 0; t < 5; ++t) { cwv[t][0] = *(const LAS f32x4*)(lds + P3_CW + ((d * 5 + t) * 64 + cc * 8) * 4); cwv[t][1] = *(const LAS f32x4*)(lds + P3_CW + ((d * 5 + t) * 64 + cc * 8 + 4) * 4); }
#pragma unroll
        for (int i = 0; i < 4; ++i) {
            f32x4 v0 = cwv[4][0], v1 = cwv[4][1];
#pragma unroll
            for (int t = 0; t < 4; ++t) { const u32x4 w = ur[i + t];
                v0 += cwv[t][0] * (f32x4){bflo(w.x), bfhi(w.x), bflo(w.y), bfhi(w.y)}; v1 += cwv[t][1] * (f32x4){bflo(w.z), bfhi(w.z), bflo(w.w), bfhi(w.w)}; }
            const int tl = 4 * tg + i, s = d ? TC - 1 - tl : tl;
            u32x4 o; o.x = cvt_pk_bf16(v0[0], v0[1]); o.y = cvt_pk_bf16(v0[2], v0[3]); o.z = cvt_pk_bf16(v1[0], v1[1]); o.w = cvt_pk_bf16(v1[2], v1[3]);
            *(LAS u32x4*)(wl + P3_VOFF + s * P3_VPITCH + (cc << 4)) = o;
        }
        LDS_WAIT();
    }
    float hrun[4];
#pragma unroll
    for (int n = 0; n < 4; ++n) { tot[n] = Comp{1.f, 0.f}; hrun[n] = cin[n]; }
#pragma unroll
    for (int m = 0; m < 2; ++m) {
        const int sa = 16 * m + (lane & 15);
        bf16x8 af[2];
#pragma unroll
        for (int kk = 0; kk < 2; ++kk) af[kk] = *(const LAS bf16x8*)(wl + P3_VOFF + sa * P3_VPITCH + ((kk * 4 + qd) << 4));
#pragma unroll
        for (int np = 0; np < 4; np += 2) {
            f32x4 ar[2], ai[2]; int nr[2]; f32x2 ba, bx, c1;
#pragma unroll
            for (int q = 0; q < 2; ++q) { const int n = np + q; nr[q] = n * 16 + ch; ar[q] = (f32x4){0.f, 0.f, 0.f, 0.f}; ai[q] = ar[q];
#pragma unroll
                for (int kk = 0; kk < 2; ++kk) { const int co = ((kk * 4 + qd) << 4);
                    const bf16x8 wa = *(const LAS bf16x8*)(lds + P3_WG + (d * 128 + nr[q]) * P3_WPITCH + co), wx = *(const LAS bf16x8*)(lds + P3_WG + (d * 128 + 64 + nr[q]) * P3_WPITCH + co);
                    ar[q] = __builtin_amdgcn_mfma_f32_16x16x32_bf16(af[kk], wa, ar[q], 0, 0, 0); ai[q] = __builtin_amdgcn_mfma_f32_16x16x32_bf16(af[kk], wx, ai[q], 0, 0, 0); }
                ba[q] = *(const LAS float*)(lds + P3_GB + ((d * 3 + 0) * 64 + nr[q]) * 4); bx[q] = *(const LAS float*)(lds + P3_GB + ((d * 3 + 1) * 64 + nr[q]) * 4); c1[q] = *(const LAS float*)(lds + P3_GB + ((d * 3 + 2) * 64 + nr[q]) * 4); }
            f32x2 Pi[4], Qi[4]; f32x2 Pl = (f32x2){1.f, 1.f}, Ql = (f32x2){0.f, 0.f};
#pragma unroll
            for (int i = 0; i < 4; ++i) {
                const int s = 16 * m + 4 * qd + i;
                const f32x2 v = (f32x2){bf2f(*(const LAS bf16*)(wl + P3_VOFF + s * P3_VPITCH + nr[0] * 2)), bf2f(*(const LAS bf16*)(wl + P3_VOFF + s * P3_VPITCH + nr[1] * 2))};
                const f32x2 tr = (f32x2){ar[0][i], ar[1][i]} + ba, ti = (f32x2){ai[0][i], ai[1][i]} + bx;
                const f32x2 er = (f32x2){TEXP(tr.x), TEXP(tr.y)} + 1.0f, ei = (f32x2){TEXP(ti.x), TEXP(ti.y)} + 1.0f;
#ifdef P3_RSQ
                const f32x2 r = (f32x2){TRCP(er.x), TRCP(er.y)};
                const f32x2 la = c1 * r; const f32x2 a = (f32x2){TEXP(la.x), TEXP(la.y)};
                f32x2 om = 1.0f - a * a; om = (f32x2){fmaxf(om.x, 1e-30f), fmaxf(om.y, 1e-30f)};
                const f32x2 w_ = om * ei * ei;
                const f32x2 bq = (om * v) * (f32x2){__builtin_amdgcn_rsqf(w_.x), __builtin_amdgcn_rsqf(w_.y)};
#else
                const f32x2 r = (f32x2){TRCP(er.x), TRCP(er.y)}, ig = (f32x2){TRCP(ei.x), TRCP(ei.y)};
                const f32x2 la = c1 * r; const f32x2 a = (f32x2){TEXP(la.x), TEXP(la.y)};
                const f32x2 om = 1.0f - a * a; const f32x2 bq = (f32x2){TSQRT(om.x), TSQRT(om.y)} * (ig * v);
#endif
#ifdef EXP_P3TRANS
                { const f32x2 d1 = (f32x2){__builtin_amdgcn_exp2f(la.x - 1.0f), __builtin_amdgcn_exp2f(la.y - 1.0f)}, d2 = (f32x2){__builtin_amdgcn_rcpf(er.x + 1.0f), __builtin_amdgcn_rcpf(er.y + 1.0f)}, d3 = (f32x2){__builtin_amdgcn_sqrtf(om.x + 1.0f), __builtin_amdgcn_sqrtf(om.y + 1.0f)};
                  Ql = Ql + 0.0f * (d1 + d2 + d3); }
#endif
                Ql = a * Ql + bq; Pl = Pl * a; Pi[i] = Pl; Qi[i] = Ql;
            }
            const f32x2 oP = (V & 2) ? Pl : (f32x2){__shfl_xor(Pl.x, 16), __shfl_xor(Pl.y, 16)}, oQ = (V & 2) ? Ql : (f32x2){__shfl_xor(Ql.x, 16), __shfl_xor(Ql.y, 16)};
            const bool odd = (qd & 1) != 0, hi = (qd & 2) != 0;
            const f32x2 eP = odd ? oP : Pl, eQ = odd ? oQ : Ql, lP = odd ? Pl : oP, lQ = odd ? Ql : oQ;
            const f32x2 pP = eP * lP, pQ = lP * eQ + lQ;
            const f32x2 qP = (V & 2) ? pP : (f32x2){__shfl_xor(pP.x, 32), __shfl_xor(pP.y, 32)}, qQ = (V & 2) ? pQ : (f32x2){__shfl_xor(pQ.x, 32), __shfl_xor(pQ.y, 32)};
            const f32x2 e2P = hi ? qP : pP, e2Q = hi ? qQ : pQ, l2P = hi ? pP : qP, l2Q = hi ? pQ : qQ;
            const f32x2 tP = e2P * l2P, tQ = l2P * e2Q + l2Q;
            if (PASS == 1) {
#pragma unroll
                for (int q = 0; q < 2; ++q) { const int n = np + q; tot[n] = Comp{tot[n].P * tP[q], tP[q] * tot[n].Q + tQ[q]}; }
            } else {
                const f32x2 xP = qd == 0 ? (f32x2){1.f, 1.f} : qd == 1 ? oP : qd == 2 ? qP : qP * oP, xQ = qd == 0 ? (f32x2){0.f, 0.f} : qd == 1 ? oQ : qd == 2 ? qQ : oP * qQ + oQ;
                const f32x2 hr = (f32x2){hrun[np], hrun[np + 1]}; const f32x2 hs = xP * hr + xQ;
                f32x2 h[4];
#pragma unroll
                for (int i = 0; i < 4; ++i) h[i] = Pi[i] * hs + Qi[i];
                const f32x2 hn = tP * hr + tQ; hrun[np] = hn.x; hrun[np + 1] = hn.y;
#pragma unroll
                for (int q = 0; q < 2; ++q) { const int n = np + q;
                    if (d == 1) { hpk[m][n][0] = cvt_pk_bf16(h[0][q], h[1][q]); hpk[m][n][1] = cvt_pk_bf16(h[2][q], h[3][q]); }
                    else {
                        const unsigned m0 = __shfl_xor(hpk[1 - m][n][0], 48), m1 = __shfl_xor(hpk[1 - m][n][1], 48);
                        const float hb[4] = {bfhi(m1), bflo(m1), bfhi(m0), bflo(m0)};
#pragma unroll
                        for (int i = 0; i < 4; ++i) { const int s = 16 * m + 4 * qd + i;
                            *(LAS bf16*)(wl + P3_VOFF + s * P3_VPITCH + nr[q] * 2) = (bf16)cvt_pk_bf16(h[i][q] + hb[i], 0.f); }
                    }
                }
            }
        }
    }
}
constexpr int CV_W1 = NE * 32 * 64, CV_ITEMS = CV_W1 + NE * 32 * 32;
struct CvJob { const float* src; unsigned char* dst; int N, n0, w1; };
__device__ __forceinline__ CvJob cv32_job(const P& p, int idx) {
    CvJob j;
    if (idx < CV_W1) { const int e = idx >> 11, l = idx & 2047, kb = l >> 6, nb = l & 63; j.N = 2048; j.src = p.w1 + (size_t)e * D * 2048 + (size_t)(32 * kb) * 2048 + 32 * nb; j.dst = p.ws + WS_W1 + (size_t)e * 2048 * D + 32 * kb; j.n0 = 32 * nb; j.w1 = 1; }
    else { const int r = idx - CV_W1, e = r >> 10, l = r & 1023, kb = l >> 5, nb = l & 31; j.N = D; j.src = p.w2 + (size_t)e * DE * D + (size_t)(32 * kb) * D + 32 * nb; j.dst = p.ws + WS_W2 + (size_t)e * D * DE + 32 * kb; j.n0 = 32 * nb; j.w1 = 0; }
    return j;
}
__device__ __forceinline__ void cv32_issue(const CvJob& j, int lane, float (&v)[16]) {
#pragma unroll
    for (int i = 0; i < 16; ++i) v[i] = __builtin_nontemporal_load(&j.src[(size_t)(2 * i + (lane >> 5)) * j.N + (lane & 31)]);
}
__device__ __forceinline__ void cv32_finish(const CvJob& j, int lane, const float (&v)[16], LAS float* scr) {
#pragma unroll
    for (int i = 0; i < 16; ++i) scr[(2 * i + (lane >> 5)) * 33 + (lane & 31)] = v[i] * 32.0f;
    LDS_WAIT(); asm volatile("" ::: "memory");
    const int c = lane & 1, n = lane >> 1; const LAS float* s = scr + (16 * c) * 33 + n;
    u32x4 o; o.x = pk4_fp8(s[0 * 33], s[1 * 33], s[2 * 33], s[3 * 33]); o.y = pk4_fp8(s[4 * 33], s[5 * 33], s[6 * 33], s[7 * 33]);
    o.z = pk4_fp8(s[8 * 33], s[9 * 33], s[10 * 33], s[11 * 33]); o.w = pk4_fp8(s[12 * 33], s[13 * 33], s[14 * 33], s[15 * 33]);
    const int nn = j.n0 + n, row = j.w1 ? 256 * ((nn >> 1) >> 7) + 128 * (nn & 1) + ((nn >> 1) & 127) : nn;
    *(u32x4*)(j.dst + (size_t)row * D + 16 * c) = o;
    LDS_WAIT(); asm volatile("" ::: "memory");
}
struct GcLoads { u32x4 um, u0, up, gb; };
__device__ __forceinline__ void gc_issue(const P& p, int c, int lane, GcLoads& g) {
    const int m = c >> 1, h = c & 1, c8 = 512 * h + 8 * lane, off = h ? GW : 1, tb = m & (SEQ - 1), row = tb >> 6, col = tb & 63;
    const bool okm = h ? row > 0 : col > 0, okp = h ? row < GROWS - 1 : col < GW - 1;
    const bf16* U = (const bf16*)(p.ws + WS_U) + c8; const u32x4 z4 = (u32x4){0u, 0u, 0u, 0u};
    g.um = z4; g.up = z4;
    if (okm) g.um = *(const u32x4*)(U + (size_t)(m - off) * D);
    g.u0 = *(const u32x4*)(U + (size_t)m * D);
    if (okp) g.up = *(const u32x4*)(U + (size_t)(m + off) * D);
    g.gb = __builtin_nontemporal_load((const u32x4*)((const bf16*)(p.ws + WS_GB) + (size_t)m * D + c8));
}
__device__ __forceinline__ void gc_finish(const P& p, int c, int lane, const GcLoads& g) {
    const int m = c >> 1, c8 = 512 * (c & 1) + 8 * lane;
    f32x4 w[3][2];
#pragma unroll
    for (int k = 0; k < 3; ++k) { w[k][0] = *(const f32x4*)(p.conv_a_w + k * D + c8); w[k][1] = *(const f32x4*)(p.conv_a_w + k * D + c8 + 4); }
    const unsigned um_[4] = {g.um.x, g.um.y, g.um.z, g.um.w}, u0_[4] = {g.u0.x, g.u0.y, g.u0.z, g.u0.w}, up_[4] = {g.up.x, g.up.y, g.up.z, g.up.w}, gb_[4] = {g.gb.x, g.gb.y, g.gb.z, g.gb.w};
    unsigned o[4];
#pragma unroll
    for (int j = 0; j < 4; ++j) { const int q = j >> 1, e0 = 2 * (j & 1);
        const float lo = (w[0][q][e0] * bflo(um_[j]) + w[1][q][e0] * bflo(u0_[j]) + w[2][q][e0] * bflo(up_[j])) * bflo(gb_[j]);
        const float hi = (w[0][q][e0 + 1] * bfhi(um_[j]) + w[1][q][e0 + 1] * bfhi(u0_[j]) + w[2][q][e0 + 1] * bfhi(up_[j])) * bfhi(gb_[j]);
        o[j] = cvt_pk_bf16(lo, hi); }
    *(u32x4*)((bf16*)(p.ws + WS_Z) + (size_t)m * 2048 + c8) = (u32x4){o[0], o[1], o[2], o[3]};
}
constexpr int GC_ITEMS = 2 * M;
template <int PV = 0>
__device__ __forceinline__ void p3a_summaries(Frame& F) {
    const P& p = F.p; const int lane = F.lane, ch = lane & 15, qd = lane >> 4;
    if (F.G < 16) return;
    const int blk = F.vcu & 15, bpb = F.G >> 4, bidx = F.vcu >> 4;
    p3_tables(F, blk);
    LAS unsigned char* wl = F.lds + F.wave * P3_WAVE_LDS;
    const float cin[4] = {0.f, 0.f, 0.f, 0.f}; unsigned hpk[2][4][2];
    const int jstep = bpb * NWAVES, NJ = NB * 2 * NCH;
    int j = bidx * NWAVES + F.wave, ubi = 0;
    const int cvstep = F.G * NWAVES, cvend = CV_ITEMS / 3; int cvi = (int)blockIdx.x * NWAVES + F.wave, gci = cvi;
    constexpr bool nobg = (PV & 16) != 0;
    if (nobg) { cvi = cvend; gci = GC_ITEMS; }
    if (j < NJ) p3_tile_dma(p, wl, (j >> 1) & 3, blk, j >> 3, lane);
    for (; j < NJ; j += jstep, ubi ^= 1) {
        const int d = j & 1, b = (j >> 1) & 3, nat = j >> 3; Comp tot[4];
        int lv = lane; asm volatile("" : "+v"(lv));
        VM_WAIT();
        const int jn = j + jstep;
        if (jn < NJ) p3_tile_dma(p, wl + (ubi ^ 1) * P3_UBUF, (jn >> 1) & 3, blk, jn >> 3, lv);
        CvJob cj[1]; float cvv[1][16]; bool cvon[1]; GcLoads gl[2]; int gcc[2];
#pragma unroll
        for (int q = 0; q < 1; ++q) { cvon[q] = cvi < cvend && !nobg; if (cvon[q]) { cj[q] = cv32_job(p, cvi); cv32_issue(cj[q], lv, cvv[q]); cvi += cvstep; } }
#pragma unroll
        for (int q = 0; q < 2; ++q) { gcc[q] = (gci < GC_ITEMS && !nobg) ? gci : -1; if (gcc[q] >= 0) { gc_issue(p, gcc[q], lv, gl[q]); gci += cvstep; } }
        p3_chunk<1, (PV & 15)>(F, lv, wl, wl + ubi * P3_UBUF, d, tot, cin, hpk);
#pragma unroll
        for (int q = 0; q < 1; ++q) if (cvon[q]) cv32_finish(cj[q], lv, cvv[q], (LAS float*)(wl + P3_VOFF));
#pragma unroll
        for (int q = 0; q < 2; ++q) if (gcc[q] >= 0) gc_finish(p, gcc[q], lv, gl[q]);
        if ((lv >> 4) == 0) { f32x2* sg = (f32x2*)(p.ws + WS_SUMG) + ((size_t)((b * 2 + d) * NCH + nat)) * D + blk * 64 + (lv & 15);
#pragma unroll
            for (int n = 0; n < 4; ++n) sg[n * 16] = (f32x2){tot[n].P, tot[n].Q}; }
    }
    for (; cvi < cvend; cvi += cvstep) { const CvJob jb = cv32_job(p, cvi); float v[16]; cv32_issue(jb, lane, v); cv32_finish(jb, lane, v, (LAS float*)(wl + P3_VOFF)); }
    for (; gci < GC_ITEMS; gci += cvstep) { GcLoads g; gc_issue(p, gci, lane, g); gc_finish(p, gci, lane, g); }
    __syncthreads();
}
__device__ __forceinline__ void p3b_carries(Frame& F) {
    const P& p = F.p; const int tid = F.tid, c = tid & 63, seg = tid >> 6;
    LAS f32x2* sc = (LAS f32x2*)F.lds;
    constexpr int SEGL = NCH / 8;
    static_assert(SEGL * 8 == NCH, "segments");
    for (int w = F.vcu; w < NB * 2 * 16; w += F.G) {
        const int cg = w & 15, d = (w >> 4) & 1, b = w >> 5;
        const f32x2* sg = (const f32x2*)(p.ws + WS_SUMG) + (size_t)((b * 2 + d) * NCH) * D + cg * 64 + c; float* cr = (float*)(p.ws + WS_CARRY) + (size_t)((b * 2 + d) * NCH) * D + cg * 64 + c;
        f32x2 cv[SEGL];
#pragma unroll
        for (int u = 0; u < SEGL; ++u) { const int j = seg * SEGL + u, nat = d == 0 ? j : (j < NCTXC ? NCTXC - 1 - j : NCH + NCTXC - 1 - j); cv[u] = sg[(size_t)nat * D]; }
        float Pt = 1.f, Qt = 0.f;
#pragma unroll
        for (int u = 0; u < SEGL; ++u) { Qt = cv[u].x * Qt + cv[u].y; Pt *= cv[u].x; }
        __syncthreads();
        sc[seg * 64 + c] = (f32x2){Pt, Qt};
        LDS_WAIT(); __syncthreads();
        float h = 0.f;
#pragma unroll
        for (int s2 = 0; s2 < 8; ++s2) { const f32x2 q = sc[s2 * 64 + c]; if (s2 < seg) h = q.x * h + q.y; }
#pragma unroll
        for (int u = 0; u < SEGL; ++u) { const int j = seg * SEGL + u, nat = d == 0 ? j : (j < NCTXC ? NCTXC - 1 - j : NCH + NCTXC - 1 - j); cr[(size_t)nat * D] = h; h = cv[u].x * h + cv[u].y; }
    }
    __syncthreads();
}
__device__ __forceinline__ void p3c_apply(Frame& F) {
    const P& p = F.p; const int lane = F.lane;
    if (F.G < 16) return;
    const int blk = F.vcu & 15, bpb = F.G >> 4, bidx = F.vcu >> 4;
    p3_tables(F, blk);
    LAS unsigned char* wl = F.lds + F.wave * P3_WAVE_LDS;
    const int jstep = bpb * NWAVES, NJ = NB * (SEQ / TC);
    int j = bidx * NWAVES + F.wave, ubi = 0;
    const int cvstep = F.G * NWAVES, cvend = CV_ITEMS; int cvi = CV_ITEMS / 3 + (int)blockIdx.x * NWAVES + F.wave;
#define P3C_PREFETCH(jj, ub_, ln_) do { const int b_ = (jj) & 3, nat_ = NCTXC + ((jj) >> 2); p3_tile_dma(p, ub_, b_, blk, nat_, ln_); } while (0)
    if (j < NJ) P3C_PREFETCH(j, wl, lane);
    for (; j < NJ; j += jstep, ubi ^= 1) {
        const int b = j & 3, nat = NCTXC + (j >> 2), t0 = (nat - NCTXC) * TC;
        unsigned hpk[2][4][2];
        int lv = lane; asm volatile("" : "+v"(lv));
        const int cc = lv & 7;
        VM_WAIT();
        float cb_[4], cf_[4];
        { const float* cr_ = (const float*)(p.ws + WS_CARRY) + ((size_t)(b * 2 * NCH + nat)) * D + blk * 64 + (lv & 15);
#pragma unroll
          for (int n = 0; n < 4; ++n) { cf_[n] = cr_[n * 16]; cb_[n] = cr_[(size_t)NCH * D + n * 16]; } }
        const int jn = j + jstep;
        if (jn < NJ) P3C_PREFETCH(jn, wl + (ubi ^ 1) * P3_UBUF, lv);
        Comp tot[4];
        CvJob cj[4]; float cvv[4][16]; bool cvon[4];
#pragma unroll
        for (int q = 0; q < 4; ++q) { cvon[q] = cvi < cvend; if (cvon[q]) { cj[q] = cv32_job(p, cvi); cv32_issue(cj[q], lv, cvv[q]); cvi += cvstep; } }
        p3_chunk<2>(F, lv, wl, wl + ubi * P3_UBUF, 1, tot, cb_, hpk);
        u32x4 gg[4];
#pragma unroll
        for (int i = 0; i < 4; ++i) { const int tl = (lv >> 3) + 8 * i; gg[i] = __builtin_nontemporal_load((const u32x4*)((const bf16*)(p.ws + WS_GG) + ((size_t)b * SEQ + t0 + tl) * D + blk * 64 + cc * 8)); }
        p3_chunk<2>(F, lv, wl, wl + ubi * P3_UBUF, 0, tot, cf_, hpk);
        LDS_WAIT();
#pragma unroll
        for (int i = 0; i < 4; ++i) { const int tl = (lv >> 3) + 8 * i; const size_t mrow = (size_t)b * SEQ + t0 + tl;
            const u32x4 hv = *(const LAS u32x4*)(wl + P3_VOFF + tl * P3_VPITCH + (cc << 4)); const u32x4 g = gg[i];
            u32x4 o; o.x = cvt_pk_bf16(bflo(hv.x) * bflo(g.x), bfhi(hv.x) * bfhi(g.x)); o.y = cvt_pk_bf16(bflo(hv.y) * bflo(g.y), bfhi(hv.y) * bfhi(g.y));
            o.z = cvt_pk_bf16(bflo(hv.z) * bflo(g.z), bfhi(hv.z) * bfhi(g.z)); o.w = cvt_pk_bf16(bflo(hv.w) * bflo(g.w), bfhi(hv.w) * bfhi(g.w));
            *(u32x4*)((bf16*)(p.ws + WS_Z) + mrow * 2048 + 1024 + blk * 64 + cc * 8) = o; }
        LDS_WAIT();
#pragma unroll
        for (int q = 0; q < 4; ++q) if (cvon[q]) cv32_finish(cj[q], lv, cvv[q], (LAS float*)(wl + P3_VOFF));
    }
    for (; cvi < cvend; cvi += cvstep) { const CvJob jb = cv32_job(p, cvi); float v[16]; cv32_issue(jb, lane, v); cv32_finish(jb, lane, v, (LAS float*)(wl + P3_VOFF)); }
#undef P3C_PREFETCH
    __syncthreads();
}
__device__ __forceinline__ void p3_conv(Frame& F) {
    const P& p = F.p; const int c8 = (F.tid & 127) * 8, tsub = F.tid >> 7;
    float w[3][8];
#pragma unroll
    for (int k = 0; k < 3; ++k)
#pragma unroll
        for (int c = 0; c < 8; ++c) w[k][c] = p.conv_a_w[k * D + c8 + c];
    const bool horiz = c8 < 512; const int off = horiz ? 1 : GW;
    const bf16* U = (const bf16*)(p.ws + WS_U) + c8; const bf16* GBp = (const bf16*)(p.ws + WS_GB) + c8; bf16* Z = (bf16*)(p.ws + WS_Z) + c8;
    for (int m0 = F.vcu * 4 + tsub; m0 < M; m0 += F.G * 16) {
        u32x4 um[4], u0[4], up[4], gb[4];
#pragma unroll
        for (int q = 0; q < 4; ++q) { const int m = m0 + q * F.G * 4; const u32x4 z4 = (u32x4){0u, 0u, 0u, 0u}; um[q] = z4; u0[q] = z4; up[q] = z4; gb[q] = z4;
            if (m < M) { const int tb = m & (SEQ - 1), row = tb >> 6, col = tb & 63; const bool okm = horiz ? col > 0 : row > 0, okp = horiz ? col < GW - 1 : row < GROWS - 1;
                if (okm) um[q] = *(const u32x4*)(U + (size_t)(m - off) * D); u0[q] = *(const u32x4*)(U + (size_t)m * D); if (okp) up[q] = *(const u32x4*)(U + (size_t)(m + off) * D); gb[q] = __builtin_nontemporal_load((const u32x4*)(GBp + (size_t)m * D)); } }
#pragma unroll
        for (int q = 0; q < 4; ++q) { const int m = m0 + q * F.G * 4; if (m >= M) continue;
            const unsigned um_[4] = {um[q].x, um[q].y, um[q].z, um[q].w}, u0_[4] = {u0[q].x, u0[q].y, u0[q].z, u0[q].w}, up_[4] = {up[q].x, up[q].y, up[q].z, up[q].w}, gb_[4] = {gb[q].x, gb[q].y, gb[q].z, gb[q].w};
            unsigned o[4];
#pragma unroll
            for (int j = 0; j < 4; ++j) {
                const float lo = (w[0][2 * j] * bflo(um_[j]) + w[1][2 * j] * bflo(u0_[j]) + w[2][2 * j] * bflo(up_[j])) * bflo(gb_[j]);
                const float hi = (w[0][2 * j + 1] * bfhi(um_[j]) + w[1][2 * j + 1] * bfhi(u0_[j]) + w[2][2 * j + 1] * bfhi(up_[j])) * bfhi(gb_[j]);
                o[j] = cvt_pk_bf16(lo, hi);
            }
            *(u32x4*)(Z + (size_t)m * 2048) = (u32x4){o[0], o[1], o[2], o[3]}; }
    }
}

__device__ __forceinline__ void p2_ctx_tiles(Frame& F) {
    const P& p = F.p; const int lane = F.lane, r16 = lane & 15, kq = lane >> 4;
    const bf16* HC = (const bf16*)(p.ws + WS_HC); const bf16* WL = (const bf16*)(p.ws + WS_WIN) + (size_t)3072 * D; bf16* CS = (bf16*)(p.ws + WS_CS3);
    for (int t = F.vcu; t < 256; t += F.G) {
        const int m0 = (t >> 4) * 64 + (F.wave & 3) * 16, n0 = (t & 15) * 64 + (F.wave >> 2) * 32;
        const bf16* ap = HC + (size_t)(m0 + r16) * D + 8 * kq; const bf16* bp0 = WL + (size_t)(n0 + r16) * D + 8 * kq; const bf16* bp1 = bp0 + (size_t)16 * D;
        f32x4 c0 = (f32x4){0.f, 0.f, 0.f, 0.f}, c1 = c0;
#pragma unroll 8
        for (int s2 = 0; s2 < 32; ++s2) { const bf16x8 a = *(const bf16x8*)(ap + 32 * s2), b0 = *(const bf16x8*)(bp0 + 32 * s2), b1 = *(const bf16x8*)(bp1 + 32 * s2);
            c0 = __builtin_amdgcn_mfma_f32_16x16x32_bf16(a, b0, c0, 0, 0, 0); c1 = __builtin_amdgcn_mfma_f32_16x16x32_bf16(a, b1, c1, 0, 0, 0); }
#pragma unroll
        for (int i = 0; i < 4; ++i) { bf16* o = CS + (size_t)(m0 + 4 * kq + i) * D + n0 + r16; o[0] = f2bf(c0[i]); o[16] = f2bf(c1[i]); }
    }
}

struct Args { P p; int ph_lo, ph_hi, region, pad; };
constexpr int NPHASE = 10;
#ifndef P2_ALIGN
#define P2_ALIGN true
#endif
__global__ void __launch_bounds__(NTHR, 2) mega_fwd(Args args) {
    extern __shared__ __attribute__((aligned(16))) unsigned char lds_raw[];
    Frame F{(LAS unsigned char*)lds_raw, args.p, 0, 0, 0, 0, 0, 0};
    F.var = 0;
    F.tid = threadIdx.x; F.lane = F.tid & 63; F.wave = __builtin_amdgcn_readfirstlane(F.tid >> 6);
    __builtin_assume(F.wave >= 0 && F.wave < NWAVES); __builtin_assume(gridDim.x >= 1 && gridDim.x <= 1024);
    F.G = gridDim.x; { const int bx = blockIdx.x; F.vcu = (F.G % 8 == 0) ? (bx % 8) * (F.G / 8) + bx / 8 : bx; }
    volatile LAS unsigned* MISC = (volatile LAS unsigned*)(F.lds + MISC_OFF);
    for (int u = F.tid; u < 128; u += NTHR) MISC[u] = 0u;
    __syncthreads();
    const int lo = args.ph_lo, hi = args.ph_hi;
    const P& p = F.p; unsigned char* ws = p.ws;
    unsigned* barw = (unsigned*)(ws + WS_CTL) + CW_BAR + (args.region & 7) * XCD_BAR_WORDS;
    XcdBarrier bar; bar.bar = barw; bar.x = 0; bar.st = nullptr;
    if (hi - lo > 1 || (lo == 3 && args.region < 8)) bar = xcd_barrier_post(barw, MISC + 8);
#ifndef CTM
#define CTM 0x3FFu
#endif
#define IN(k) (((CTM >> (k)) & 1u) && lo <= (k) && (k) < hi)
#define SEAM(k) do { if (IN(k) && IN((k) + 1)) xcd_barrier(bar); } while (0)
#define PHASE(k, ...) do { if (IN(k)) { __VA_ARGS__ } SEAM(k); } while (0)
    PHASE(0, { p0_prologue(F); });
    PHASE(1, { p1_rows(F); });
    PHASE(2, {
        SchedInProj S{(const char*)(ws + WS_HXP), (const char*)(ws + WS_HC), (const char*)(ws + WS_WIN), F.G, (int)blockIdx.x, ((args.region >> 8) & 4) ? 0 : 16, 0};
        EpiInProj E{ws, p.b_merge, (int)((args.region >> 8) & 3)};
        pg8::gemm_phase<EpiInProj, SchedInProj, false, false, P2_ALIGN>(F.lds, D, S, E, PA * 2);
    });
    if (IN(3)) {
        const int part = (args.region >> 3) & 31;
#ifdef PROBE_P3VAR
        if (part == 1 && (args.region >> 8)) p3a_summaries<PROBE_P3VAR>(F); else
#endif
        if (part == 0 || part == 1) p3a_summaries<0>(F);
        if (part == 0) xcd_barrier(bar);
        if (part == 0 || part == 2) p3b_carries(F);
        if (part == 0) xcd_barrier(bar);
        if (part == 0 || part == 3) p3c_apply(F);
    } SEAM(3);
    PHASE(4, {
        SchedDense S{(const char*)(ws + WS_Z), (const char*)(ws + WS_WAB), 2048, F.G, (int)blockIdx.x};
        EpiMerge E{ws};
        pg8::gemm_phase<EpiMerge, SchedDense, true>(F.lds, 2048, S, E);
    });
    PHASE(5, {
        SchedDense S{(const char*)(ws + WS_MG), (const char*)(ws + WS_WO), D, F.G, (int)blockIdx.x};
        EpiWo E{p.x, (bf16*)(ws + WS_X1), (const float*)(ws + WS_MX)};
        pg8::gemm_phase<EpiWo, SchedDense, false>(F.lds, D, S, E);
    });
    PHASE(6, { p6_route(F); });
    PHASE(7, {
        LAS int* tab = (LAS int*)(F.lds + AUX_OFF);
        __syncthreads();
        moe_tables(tab, (const unsigned*)(ws + WS_CTL) + CW_CNT, 8, F.G, (int)blockIdx.x);
        SchedMoe S{(const char*)(ws + WS_FX8), (const char*)(ws + WS_W1), (const int*)(ws + WS_TOK), tab, 8, F.G, (int)blockIdx.x, 1, 2048, 1};
        EpiMoe1 E{ws, p.b1};
        pg8::gemm_phase<EpiMoe1, SchedMoe, false, true>(F.lds, D, S, E);
    });
    PHASE(8, {
        LAS int* tab = (LAS int*)(F.lds + AUX_OFF);
        __syncthreads();
        moe_tables(tab, (const unsigned*)(ws + WS_CTL) + CW_CNT, 4, F.G, (int)blockIdx.x);
        SchedMoe S{(const char*)(ws + WS_ACT), (const char*)(ws + WS_W2), (const int*)(ws + WS_TOK), tab, 4, F.G, (int)blockIdx.x, 0, 1024, 1};
        EpiMoe2 E{ws, p.b2};
        pg8::gemm_phase<EpiMoe2, SchedMoe, false, true>(F.lds, DE, S, E);
    });
    if (IN(9)) { __syncthreads(); p9_final(F); }
#undef PHASE
#undef IN
#undef SEAM
}
#ifndef FAST_MASK
#define FAST_MASK 0x3FFu
#endif
#ifndef ONE_LAUNCH
#define ONE_LAUNCH 1
#endif
static void launch_mega(const P& p, int lo, int hi, int grid, hipStream_t stream, int region = 0) {
    Args a{}; a.p = p; a.ph_lo = lo; a.ph_hi = hi; a.region = region; a.pad = 0;
    hipLaunchKernelGGL(mega_fwd, dim3(grid), dim3(NTHR), LDS_BYTES, stream, a);
}
extern "C" void kernel_launch(void* const* d_in, const int* in_sizes, int n_in, void* d_out, int out_size, void* d_ws, size_t ws_size, hipStream_t stream) {
    static int grid = 0;
    if (grid == 0) {
        if (n_in != 28 || out_size != M * D || ws_size < WS_END) { fprintf(stderr, "kernel_launch: unexpected shapes n_in %d out %d ws %zu\n", n_in, out_size, ws_size); grid = -1; return; }
        int dev = 0, cus = 0, per_cu = 0;
        if (hipGetDevice(&dev) != hipSuccess || hipDeviceGetAttribute(&cus, hipDeviceAttributeMultiprocessorCount, dev) != hipSuccess) { grid = -1; return; }
        if (hipFuncSetAttribute((const void*)mega_fwd, hipFuncAttributeMaxDynamicSharedMemorySize, LDS_BYTES) != hipSuccess) { fprintf(stderr, "kernel_launch: hipFuncSetAttribute failed\n"); grid = -1; return; }
        if (hipOccupancyMaxActiveBlocksPerMultiprocessor(&per_cu, (const void*)mega_fwd, NTHR, LDS_BYTES) != hipSuccess || per_cu < 1) { fprintf(stderr, "kernel_launch: occupancy query reports %d blocks per CU\n", per_cu); }
        (void)hipGetLastError();
        grid = cus;
    }
    if (grid < 0) return;
    P p{};
    const float** f = (const float**)&p;
    for (int i = 0; i < 28; ++i) f[i] = (const float*)d_in[i];
    p.out = (float*)d_out; p.ws = (unsigned char*)d_ws;
    (void)hipMemsetAsync((char*)d_ws + WS_CTL, 0, CTL_ZERO_BYTES, stream);
    const unsigned fm = FAST_MASK;
#ifdef PROBE_LO
    launch_mega(p, 0, PROBE_HI, grid, stream, 0);
    if (PROBE_LO <= 6 && 6 < PROBE_HI) (void)hipMemsetAsync((char*)d_ws + WS_CTL + CW_CNT * 4, 0, 128, stream);
#if defined(PROBE_P2VAR)
    launch_mega(p, 2, 3, grid, stream, 256 * PROBE_P2VAR + 2);
#elif defined(PROBE_P3PART)
#ifdef PROBE_P3VAR
    launch_mega(p, 3, 4, grid, stream, 256 + 8 * PROBE_P3PART + 2);
#else
    launch_mega(p, 3, 4, grid, stream, 8 * PROBE_P3PART + 2);
#endif
#else
    for (int k = PROBE_LO; k < PROBE_HI; ++k) launch_mega(p, k, k + 1, grid, stream, 2);
#endif
    if (PROBE_HI < NPHASE) launch_mega(p, PROBE_HI, NPHASE, grid, stream, 1);
    return;
#endif
    if (ONE_LAUNCH && fm == 0x3FFu) { launch_mega(p, 0, NPHASE, grid, stream); return; }
    for (int ph = 0; ph < NPHASE; ++ph) {
        if ((fm >> ph) & 1u) { launch_mega(p, ph, ph + 1, grid, stream); continue; }
        switch (ph) {
        case 0: nv_adaln<<<6144 / 256, 256, 0, stream>>>(p); if (fm & 0x1B4u) launch_mega(p, 0, 1, grid, stream); break;
        case 1: nv_hx<<<(M + MC) / 4, 256, 0, stream>>>(p); break;
        case 2: for (int mode = 0; mode < 6; ++mode) { FInProj fi{p, mode, D}; const dim3 g(D / 128, (mode == 5 ? MC : M) / 128, 1);
                    if (mode == 1 || mode == 4) nv_gemm<true, FInProj><<<g, 256, 0, stream>>>(fi); else nv_gemm<false, FInProj><<<g, 256, 0, stream>>>(fi); } break;
        case 3: nv_lru<<<NB * 2 * 16, 64, 0, stream>>>(p); nv_mix<<<(unsigned)((size_t)M * D / 256), 256, 0, stream>>>(p); break;
        case 4: { FMerge fm_{p, D, 0}; nv_gemm<true, FMerge><<<dim3(D / 128, M / 128, 1), 256, 0, stream>>>(fm_); } break;
        case 5: { FWo fw{p, D, 0}; nv_gemm<false, FWo><<<dim3(D / 128, M / 128, 1), 256, 0, stream>>>(fw); } break;
        case 6: nv_route<<<M / 4, 256, 0, stream>>>(p); break;
        case 7: { FMoe1 f1{p, D, 0}; nv_gemm<true, FMoe1><<<dim3(DE / 128, M / 128, NE), 256, 0, stream>>>(f1); } break;
        case 8: { FMoe2 f2{p, DE, 0}; nv_gemm<false, FMoe2><<<dim3(D / 128, M / 128, NE), 256, 0, stream>>>(f2); } break;
        case 9: nv_final<<<M / 4, 256, 0, stream>>>(p); break;
        }
    }
}
```

```cpp
#define UEW_ALL 1
#define PADX 64
#include <hip/hip_runtime.h>
#include <stdint.h>
#include <cstdio>

typedef unsigned short bf16;
__device__ __forceinline__ float bf2f(bf16 v) { return __uint_as_float(((unsigned)v) << 16); }
__device__ __forceinline__ bf16 f2bf(float f) { unsigned u = __float_as_uint(f); u += 0x7fffu + ((u >> 16) & 1u); return (bf16)(u >> 16); }

constexpr int NB = 4, SEQ = 8192, D = 1024, M = NB * SEQ, CTX = 256, MC = NB * CTX, INC = 7168;
constexpr int NE = 32, TOPK = 4, DE = 1024, GW = 64, GROWS = SEQ / GW;
constexpr float EPS = 1e-6f;
constexpr size_t MiB = 1u << 20;
constexpr size_t WS_CTL = 0, CTL_BYTES = 1 * MiB;
constexpr int CW_CNT = 16384;
constexpr size_t WS_MX = 1 * MiB;
constexpr size_t WS_TOK = 2 * MiB, WS_GATE = 6 * MiB, WS_INV = 10 * MiB;
#ifndef PADX
#define PADX 0
#endif
constexpr int PA = D + PADX;
constexpr size_t WS_CS3 = 11 * MiB, WS_HC = 13 * MiB;
constexpr size_t WS_WIN = (PADX ? 936 : 16) * MiB, WS_WAB = 30 * MiB, WS_WO = 34 * MiB, WS_W1 = 36 * MiB, WS_W2 = 164 * MiB;
constexpr size_t WS_HX = 228 * MiB, WS_GB = 292 * MiB, WS_U = 356 * MiB, WS_ULRU = 420 * MiB, WS_GG = 484 * MiB;
constexpr size_t WS_ACT = 228 * MiB;
constexpr size_t WS_RAT = 548 * MiB, WS_SBG = 612 * MiB, WS_Z = 676 * MiB, WS_MG = 804 * MiB;
constexpr size_t WS_FX = 548 * MiB, WS_OUTP = 548 * MiB;
constexpr size_t WS_HF = WS_HX, WS_HB = WS_MG;
constexpr size_t WS_END = (PADX ? 952 : 868) * MiB;
constexpr size_t WS_HXP = PADX ? 868 * MiB : WS_HX;

struct P {
    const float *x, *c, *ctx, *c_ctx, *w_ada, *b_ada, *norm_mix, *w_in, *conv_a_w, *w_out_a, *lru_conv_w, *lru_conv_b, *lru_wa, *lru_ba, *lru_wx, *lru_bx,
        *lru_lambda, *w_out_b, *b_merge, *w_o, *norm_ffn, *router_w, *router_b, *w1, *b1, *w2, *b2, *norm_final;
    float* out; unsigned char* ws;
};

__device__ __forceinline__ float wave_sum(float v) {
#pragma unroll
    for (int o = 1; o < 64; o <<= 1) v += __shfl_xor(v, o);
    return v;
}
__device__ __forceinline__ float sigmoidf_(float v) { return 1.0f / (1.0f + __expf(-v)); }
__device__ __forceinline__ float gelu_tanh(float v) { const float u = 0.7978845608028654f * (v + 0.044715f * v * v * v); return v * sigmoidf_(2.0f * u); }
__device__ __forceinline__ int pad256(int v) { return (v + 255) & ~255; }

__global__ __launch_bounds__(256) void nv_adaln(P p) {
    __shared__ float sc[5][D];
    for (int i = threadIdx.x; i < 5 * D; i += 256) { const int r = i / D, k = i % D; const float v = r < 4 ? p.c[r * D + k] : p.c_ctx[k]; sc[r][k] = v * sigmoidf_(v); }
    __syncthreads();
    const int n = blockIdx.x * 256 + threadIdx.x;
    float a[5] = {0, 0, 0, 0, 0};
    for (int k = 0; k < D; ++k) { const float w = p.w_ada[(size_t)k * 6144 + n];
#pragma unroll
        for (int r = 0; r < 5; ++r) a[r] += sc[r][k] * w; }
    float* mx = (float*)(p.ws + WS_MX);
#pragma unroll
    for (int r = 0; r < 5; ++r) mx[r * 6144 + n] = a[r] + p.b_ada[n];
}
__global__ __launch_bounds__(256) void nv_hx(P p) {
    const int row = blockIdx.x * 4 + (threadIdx.x >> 6), lane = threadIdx.x & 63;
    const float* mx = (const float*)(p.ws + WS_MX);
    const float* src; bf16* dst; const float* md;
    if (row < M) { src = p.x + (size_t)row * D; dst = (bf16*)(p.ws + WS_HX) + (size_t)row * D; md = mx + (row / SEQ) * 6144; }
    else { const int r = row - M; src = p.ctx + (size_t)r * D; dst = (bf16*)(p.ws + WS_HC) + (size_t)r * D; md = mx + 4 * 6144; }
    float v[16]; float s = 0.f;
#pragma unroll
    for (int j = 0; j < 16; ++j) { v[j] = src[lane + 64 * j]; s += v[j] * v[j]; }
    const float rstd = rsqrtf(wave_sum(s) * (1.0f / D) + EPS);
#pragma unroll
    for (int j = 0; j < 16; ++j) { const int k = lane + 64 * j; dst[k] = f2bf(v[j] * rstd * p.norm_mix[k] * (1.0f + md[1024 + k]) + md[k]); }
}

template <bool DUAL, class F>
__global__ __launch_bounds__(256) void nv_gemm(F f) {
    const int K = f.K;
    __shared__ float As[2][16][128 + 4], Bs[2][16][128 + 4];
    const int z = blockIdx.z, m0 = blockIdx.y * 128, n0 = blockIdx.x * 128, tid = threadIdx.x, tx = tid & 15, ty = tid >> 4;
    if (m0 >= f.rows(z)) return;
    float acc[8][8], acc2[8][8];
#pragma unroll
    for (int i = 0; i < 8; ++i)
#pragma unroll
        for (int j = 0; j < 8; ++j) { acc[i][j] = 0.f; acc2[i][j] = 0.f; }
    for (int k0 = 0; k0 < K; k0 += 16) {
#pragma unroll
        for (int i = 0; i < 8; ++i) { const int idx = tid + 256 * i; const int mm = idx >> 4, kk = idx & 15; As[0][kk][mm] = f.a(z, m0 + mm, k0 + kk); if (DUAL) As[1][kk][mm] = f.a2(z, m0 + mm, k0 + kk); }
#pragma unroll
        for (int i = 0; i < 8; ++i) { const int idx = tid + 256 * i; const int kk = idx >> 7, nn = idx & 127; Bs[0][kk][nn] = f.b(z, k0 + kk, n0 + nn); if (DUAL) Bs[1][kk][nn] = f.b2(z, k0 + kk, n0 + nn); }
        __syncthreads();
#pragma unroll
        for (int kk = 0; kk < 16; ++kk) {
            float av[8], bv[8];
#pragma unroll
            for (int i = 0; i < 8; ++i) { av[i] = As[0][kk][ty + 16 * i]; bv[i] = Bs[0][kk][tx + 16 * i]; }
#pragma unroll
            for (int i = 0; i < 8; ++i)
#pragma unroll
                for (int j = 0; j < 8; ++j) acc[i][j] += av[i] * bv[j];
            if (DUAL) {
#pragma unroll
                for (int i = 0; i < 8; ++i) { av[i] = As[1][kk][ty + 16 * i]; bv[i] = Bs[1][kk][tx + 16 * i]; }
#pragma unroll
                for (int i = 0; i < 8; ++i)
#pragma unroll
                    for (int j = 0; j < 8; ++j) acc2[i][j] += av[i] * bv[j];
            }
        }
        __syncthreads();
    }
#pragma unroll
    for (int i = 0; i < 8; ++i)
#pragma unroll
        for (int j = 0; j < 8; ++j) f.ep(z, m0 + ty + 16 * i, n0 + tx + 16 * j, acc[i][j], acc2[i][j]);
}
struct FInProj {
    P p; int mode, K;
    __device__ int rows(int) const { return mode == 5 ? MC : M; }
    __device__ float a(int, int m, int k) const { const bf16* A = (const bf16*)(p.ws + (mode == 5 ? WS_HC : WS_HX)); return bf2f(A[(size_t)m * D + k]); }
    __device__ float a2(int z, int m, int k) const { return a(z, m, k); }
    __device__ int col1() const { return mode == 0 ? 0 : mode == 1 ? 1024 : mode == 2 ? 3072 : mode == 3 ? 4096 : mode == 4 ? 5120 : 3072; }
    __device__ float b(int, int k, int n) const { return p.w_in[(size_t)k * INC + col1() + n]; }
    __device__ float b2(int, int k, int n) const { return p.w_in[(size_t)k * INC + col1() + 1024 + n]; }
    __device__ void ep(int, int m, int n, float v, float v2) const {
        const size_t o = (size_t)m * D + n;
        if (mode == 0) ((bf16*)(p.ws + WS_GB))[o] = f2bf(v);
        else if (mode == 1) ((bf16*)(p.ws + WS_U))[o] = f2bf(v * v2);
        else if (mode == 2) ((bf16*)(p.ws + WS_ULRU))[o] = f2bf(v);
        else if (mode == 3) ((bf16*)(p.ws + WS_GG))[o] = f2bf(gelu_tanh(v));
        else if (mode == 4) { const float sa = sigmoidf_(v + p.b_merge[n]), sb = sigmoidf_(v2 + p.b_merge[D + n]); ((bf16*)(p.ws + WS_RAT))[o] = f2bf(sa / sb); ((bf16*)(p.ws + WS_SBG))[o] = f2bf(sb); }
        else ((bf16*)(p.ws + WS_CS3))[o] = f2bf(v);
    }
};
struct FMerge {
    P p; int K, pad;
    __device__ int rows(int) const { return M; }
    __device__ float a(int, int m, int k) const { return bf2f(((const bf16*)(p.ws + WS_Z))[(size_t)m * 2048 + k]); }
    __device__ float a2(int, int m, int k) const { return bf2f(((const bf16*)(p.ws + WS_Z))[(size_t)m * 2048 + 1024 + k]); }
    __device__ float b(int, int k, int n) const { return p.w_out_a[(size_t)k * D + n]; }
    __device__ float b2(int, int k, int n) const { return p.w_out_b[(size_t)k * D + n]; }
    __device__ void ep(int, int m, int n, float v, float v2) const {
        const size_t o = (size_t)m * D + n; const float rat = bf2f(((const bf16*)(p.ws + WS_RAT))[o]), sb = bf2f(((const bf16*)(p.ws + WS_SBG))[o]);
        ((bf16*)(p.ws + WS_MG))[o] = f2bf((v * rat + v2) * sb);
    }
};
struct FWo {
    P p; int K, pad;
    __device__ int rows(int) const { return M; }
    __device__ float a(int, int m, int k) const { return bf2f(((const bf16*)(p.ws + WS_MG))[(size_t)m * D + k]); }
    __device__ float a2(int, int, int) const { return 0.f; }
    __device__ float b(int, int k, int n) const { return p.w_o[(size_t)k * D + n]; }
    __device__ float b2(int, int, int) const { return 0.f; }
    __device__ void ep(int, int m, int n, float v, float) const { const float* mx = (const float*)(p.ws + WS_MX); const size_t o = (size_t)m * D + n; p.out[o] = p.x[o] + mx[(m / SEQ) * 6144 + 2 * 1024 + n] * v; }
};
__device__ __forceinline__ int expert_base(const unsigned* cnt, int e) { int b = 0; for (int i = 0; i < e; ++i) b += pad256((int)cnt[i]); return b; }
struct FMoe1 {
    P p; int K, pad;
    __device__ const unsigned* cnt() const { return (const unsigned*)(p.ws + WS_CTL) + CW_CNT; }
    __device__ int rows(int z) const { return (int)cnt()[z]; }
    __device__ float a(int z, int m, int k) const { if (m >= rows(z)) return 0.f; const int tok = ((const int*)(p.ws + WS_TOK))[(size_t)z * M + m]; return bf2f(((const bf16*)(p.ws + WS_FX))[(size_t)tok * D + k]); }
    __device__ float a2(int z, int m, int k) const { return a(z, m, k); }
    __device__ float b(int z, int k, int n) const { return p.w1[((size_t)z * D + k) * 2048 + 2 * n]; }
    __device__ float b2(int z, int k, int n) const { return p.w1[((size_t)z * D + k) * 2048 + 2 * n + 1]; }
    __device__ void ep(int z, int m, int n, float v, float v2) const {
        if (m >= rows(z)) return;
        const float hg = v + p.b1[(size_t)z * 2048 + 2 * n], hl = v2 + p.b1[(size_t)z * 2048 + 2 * n + 1];
        const float glu = fminf(hg, 7.0f), lin = fminf(fmaxf(hl, -7.0f), 7.0f);
        const float act = glu * sigmoidf_(1.702f * glu) * (lin + 1.0f);
        ((bf16*)(p.ws + WS_ACT))[(size_t)(expert_base(cnt(), z) + m) * DE + n] = f2bf(act);
    }
};
struct FMoe2 {
    P p; int K, pad;
    __device__ const unsigned* cnt() const { return (const unsigned*)(p.ws + WS_CTL) + CW_CNT; }
    __device__ int rows(int z) const { return (int)cnt()[z]; }
    __device__ float a(int z, int m, int k) const { if (m >= rows(z)) return 0.f; return bf2f(((const bf16*)(p.ws + WS_ACT))[(size_t)(expert_base(cnt(), z) + m) * DE + k]); }
    __device__ float a2(int, int, int) const { return 0.f; }
    __device__ float b(int z, int k, int n) const { return p.w2[((size_t)z * DE + k) * D + n]; }
    __device__ float b2(int, int, int) const { return 0.f; }
    __device__ void ep(int z, int m, int n, float v, float) const {
        if (m >= rows(z)) return;
        const float g = ((const float*)(p.ws + WS_GATE))[(size_t)z * M + m];
        ((bf16*)(p.ws + WS_OUTP))[(size_t)(expert_base(cnt(), z) + m) * D + n] = f2bf((v + p.b2[(size_t)z * D + n]) * g);
    }
};

__global__ __launch_bounds__(64) void nv_lru(P p) {
    __shared__ float vs[64];
    const int j = threadIdx.x, blk = blockIdx.x & 15, dir = (blockIdx.x >> 4) & 1, b = blockIdx.x >> 5, ch = blk * 64 + j;
    float wa[64], wx[64];
    const float* WA = p.lru_wa + ((size_t)(dir * 16 + blk) * 64) * 64; const float* WX = p.lru_wx + ((size_t)(dir * 16 + blk) * 64) * 64;
#pragma unroll
    for (int k = 0; k < 64; ++k) { wa[k] = WA[k * 64 + j]; wx[k] = WX[k * 64 + j]; }
    const float ba = p.lru_ba[dir * D + ch], bx = p.lru_bx[dir * D + ch], cb = p.lru_conv_b[dir * D + ch];
    float cw[4];
#pragma unroll
    for (int q = 0; q < 4; ++q) cw[q] = p.lru_conv_w[(size_t)(dir * 4 + q) * D + ch];
    const float lam = p.lru_lambda[dir * D + ch];
    const float c1 = -8.0f * log1pf(__expf(-lam));
    float h = 0.f;
    bf16* hout = (bf16*)(p.ws + (dir == 0 ? WS_HF : WS_HB));
    for (int seq = 0; seq < 2; ++seq) {
        const int L = seq == 0 ? CTX : SEQ;
        const bf16* u = seq == 0 ? (const bf16*)(p.ws + WS_CS3) + (size_t)b * CTX * D : (const bf16*)(p.ws + WS_ULRU) + (size_t)b * SEQ * D;
        for (int step = 0; step < L; ++step) {
            const int t = dir == 0 ? step : L - 1 - step;
            float v = cb;
#pragma unroll
            for (int q = 0; q < 4; ++q) { const int tt = dir == 0 ? t + q - 3 : t + 3 - q; if (tt >= 0 && tt < L) v += cw[q] * bf2f(u[(size_t)tt * D + ch]); }
            vs[j] = v;
            __syncthreads();
            float r = ba, i = bx;
#pragma unroll
            for (int k = 0; k < 64; ++k) { const float vk = vs[k]; r += vk * wa[k]; i += vk * wx[k]; }
            __syncthreads();
            r = sigmoidf_(r); i = sigmoidf_(i);
            const float la = c1 * r, a = __expf(la), bb = sqrtf(fmaxf(1.0f - __expf(2.0f * la), 0.f)) * (i * v);
            h = a * h + bb;
            if (seq == 1) hout[((size_t)b * SEQ + t) * D + ch] = f2bf(h);
        }
    }
}
__global__ __launch_bounds__(256) void nv_mix(P p) {
    const size_t idx = (size_t)blockIdx.x * 256 + threadIdx.x; const int m = (int)(idx / D), ch = (int)(idx % D);
    const int tb = m % SEQ, row = tb / GW, col = tb % GW;
    const bf16* U = (const bf16*)(p.ws + WS_U);
    float s = 0.f;
#pragma unroll
    for (int k = 0; k < 3; ++k) {
        const float w = p.conv_a_w[k * D + ch]; int mm; bool ok;
        if (ch < 512) { const int c2 = col + k - 1; ok = c2 >= 0 && c2 < GW; mm = m + k - 1; }
        else { const int r2 = row + k - 1; ok = r2 >= 0 && r2 < GROWS; mm = m + (k - 1) * GW; }
        if (ok) s += w * bf2f(U[(size_t)mm * D + ch]);
    }
    bf16* Z = (bf16*)(p.ws + WS_Z);
    Z[(size_t)m * 2048 + ch] = f2bf(bf2f(((const bf16*)(p.ws + WS_GB))[idx]) * s);
    const float hh = bf2f(((const bf16*)(p.ws + WS_HF))[idx]) + bf2f(((const bf16*)(p.ws + WS_HB))[idx]);
    Z[(size_t)m * 2048 + 1024 + ch] = f2bf(bf2f(((const bf16*)(p.ws + WS_GG))[idx]) * hh);
}
__global__ __launch_bounds__(256) void nv_route(P p) {
    const int row = blockIdx.x * 4 + (threadIdx.x >> 6), lane = threadIdx.x & 63;
    const float* mx = (const float*)(p.ws + WS_MX) + (row / SEQ) * 6144;
    const float* src = p.out + (size_t)row * D;
    float v[16]; float s = 0.f;
#pragma unroll
    for (int j = 0; j < 16; ++j) { v[j] = src[lane + 64 * j]; s += v[j] * v[j]; }
    const float rstd = rsqrtf(wave_sum(s) * (1.0f / D) + EPS);
    bf16* fx = (bf16*)(p.ws + WS_FX) + (size_t)row * D;
#pragma unroll
    for (int j = 0; j < 16; ++j) { const int k = lane + 64 * j; v[j] = v[j] * rstd * p.norm_ffn[k] * (1.0f + mx[4 * 1024 + k]) + mx[3 * 1024 + k]; fx[k] = f2bf(v[j]); }
    float lg[NE];
#pragma unroll
    for (int e = 0; e < NE; ++e) { float a = 0.f;
#pragma unroll
        for (int j = 0; j < 16; ++j) a += v[j] * p.router_w[(size_t)(lane + 64 * j) * NE + e];
        lg[e] = wave_sum(a) + p.router_b[e]; }
    if (lane == 0) {
        int idx[TOPK]; float val[TOPK]; unsigned used = 0u;
#pragma unroll
        for (int t = 0; t < TOPK; ++t) { int bi = -1; float bv = -3.0e38f;
#pragma unroll
            for (int e = 0; e < NE; ++e) { const bool free_ = !((used >> e) & 1u); if (free_ && lg[e] > bv) { bv = lg[e]; bi = e; } }
            idx[t] = bi; val[t] = bv; used |= 1u << bi; }
        float ex[TOPK], se = 0.f;
#pragma unroll
        for (int t = 0; t < TOPK; ++t) { ex[t] = __expf(val[t] - val[0]); se += ex[t]; }
        unsigned* cnt = (unsigned*)(p.ws + WS_CTL) + CW_CNT;
#pragma unroll
        for (int t = 0; t < TOPK; ++t) {
            const int e = idx[t]; const unsigned slot = atomicAdd(&cnt[e], 1u);
            ((int*)(p.ws + WS_TOK))[(size_t)e * M + slot] = row;
            ((float*)(p.ws + WS_GATE))[(size_t)e * M + slot] = ex[t] / se;
            ((int*)(p.ws + WS_INV))[(size_t)row * 4 + t] = e * M + (int)slot;
        }
    }
}
__global__ __launch_bounds__(256) void nv_final(P p) {
    const int row = blockIdx.x * 4 + (threadIdx.x >> 6), lane = threadIdx.x & 63;
    const float* mx = (const float*)(p.ws + WS_MX) + (row / SEQ) * 6144 + 5 * 1024;
    const unsigned* cnt = (const unsigned*)(p.ws + WS_CTL) + CW_CNT;
    const int* inv = (const int*)(p.ws + WS_INV) + (size_t)row * 4;
    const bf16* op[TOPK];
#pragma unroll
    for (int t = 0; t < TOPK; ++t) { const int e = inv[t] / M, slot = inv[t] % M; op[t] = (const bf16*)(p.ws + WS_OUTP) + (size_t)(expert_base(cnt, e) + slot) * D; }
    float* xo = p.out + (size_t)row * D;
    float v[16]; float s = 0.f;
#pragma unroll
    for (int j = 0; j < 16; ++j) { const int k = lane + 64 * j; float y = 0.f;
#pragma unroll
        for (int t = 0; t < TOPK; ++t) y += bf2f(op[t][k]);
        v[j] = xo[k] + mx[k] * y; s += v[j] * v[j]; }
    const float rstd = rsqrtf(wave_sum(s) * (1.0f / D) + EPS);
#pragma unroll
    for (int j = 0; j < 16; ++j) { const int k = lane + 64 * j; xo[k] = v[j] * rstd * p.norm_final[k]; }
}

#define LAS __attribute__((address_space(3)))
#define GAS __attribute__((address_space(1)))
typedef short bf16x8 __attribute__((ext_vector_type(8)));
typedef float f32x4 __attribute__((ext_vector_type(4)));
typedef float f32x2 __attribute__((ext_vector_type(2)));
typedef unsigned u32x4 __attribute__((ext_vector_type(4)));
typedef unsigned u32x2 __attribute__((ext_vector_type(2)));
typedef int i32x4 __attribute__((ext_vector_type(4)));
typedef int i32x8 __attribute__((ext_vector_type(8)));
constexpr size_t WS_X1 = WS_GG;
constexpr size_t WS_FX8 = 612 * MiB;
__device__ __forceinline__ unsigned pk4_fp8(float a, float b, float c, float d) { int w = 0; w = __builtin_amdgcn_cvt_pk_fp8_f32(a, b, w, false); w = __builtin_amdgcn_cvt_pk_fp8_f32(c, d, w, true); return (unsigned)w; }
constexpr int NWAVES = 8, NTHR = 512;
constexpr int RING_BYTES = 131072, AUX_OFF = RING_BYTES, AUX_BYTES = 28672, MISC_OFF = AUX_OFF + AUX_BYTES, LDS_BYTES = MISC_OFF + 512;
constexpr size_t WS_ZERO = WS_CTL + 66048;
constexpr int CW_BAR = 4096;
constexpr size_t CTL_ZERO_BYTES = 131072;

__device__ __forceinline__ unsigned cvt_pk_bf16(float lo, float hi) { unsigned r; asm volatile("v_cvt_pk_bf16_f32 %0, %1, %2" : "=v"(r) : "v"(lo), "v"(hi)); return r; }
__device__ __forceinline__ unsigned pk2(float lo, float hi) { return (unsigned)f2bf(lo) | ((unsigned)f2bf(hi) << 16); }
__device__ __forceinline__ float bflo(unsigned w) { return __uint_as_float(w << 16); }
__device__ __forceinline__ float bfhi(unsigned w) { return __uint_as_float(w & 0xffff0000u); }
__device__ __forceinline__ float gelu_fast(float v) { const float t = v * (-2.3022082f - 0.10294324f * v * v); return v * __builtin_amdgcn_rcpf(1.0f + __builtin_amdgcn_exp2f(t)); }
__device__ __forceinline__ float fsig(float v) { return __builtin_amdgcn_rcpf(1.0f + __expf(-v)); }
__device__ __forceinline__ void mfma_f8_inplace(f32x4& acc, const i32x8& a, const i32x8& b, int sa, int sb) {
    asm volatile("v_mfma_scale_f32_16x16x128_f8f6f4 %0, %1, %2, %0, %3, %4 op_sel_hi:[0,0,0]" : "+v"(acc) : "v"(a), "v"(b), "v"(sa), "v"(sb));
}
__device__ __forceinline__ void mfma_bf16_inplace(f32x4& acc, const bf16x8& a, const bf16x8& b) {
    asm volatile("v_mfma_f32_16x16x32_bf16 %0, %1, %2, %0" : "+v"(acc) : "v"(a), "v"(b));
}
#define LDS_WAIT() asm volatile("s_waitcnt lgkmcnt(0)" ::: "memory")
#define VM_WAIT() asm volatile("s_waitcnt vmcnt(0)" ::: "memory")

namespace pg8 {
constexpr int BM = 256, BK = 64, HALF = 128, HTB = HALF * BK * 2, STAGE_BYTES = 8 * HTB;
__host__ __device__ __forceinline__ int lds_byte(int r, int c) { const int st = (r >> 4) * 2 + (c >> 5), rr = r & 15, cc = c & 31, ob = rr * 64 + cc * 2; return st * 1024 + (ob ^ (((ob >> 9) & 1) << 5)); }
__host__ __device__ __forceinline__ void stage_rc(int b, int& R, int& C) { const int st = b / 1024, sb = b % 1024, swz = sb ^ (((sb >> 9) & 1) << 5); R = (st >> 1) * 16 + swz / 64; C = (st & 1) * 32 + (swz % 64) / 2; }
__host__ __device__ __forceinline__ int perm32(int rho) { const int n = rho >> 4, i = rho & 15; return 8 * (i >> 2) + 4 * n + (i & 3); }

struct Unit { const char* A; const char* B; const int* gat; int gcnt, grow0; int kind, row0, ocol, e, slot0; };

__device__ __forceinline__ void arows(const Unit& u, unsigned (&rp)[2]) {
    int R[2], C[2]; int tx = (int)threadIdx.x; asm volatile("" : "+v"(tx));
#pragma unroll
    for (int i = 0; i < 2; ++i) stage_rc(tx * 16 + i * 8192, R[i], C[i]);
#pragma unroll
    for (int h = 0; h < 2; ++h) {
        int r[2];
#pragma unroll
        for (int i = 0; i < 2; ++i) { r[i] = h * HALF + R[i]; if (u.gat) { const int gr = u.grow0 + r[i]; r[i] = gr < u.gcnt ? u.gat[gr] : 0; } }
        rp[h] = (unsigned)r[0] | ((unsigned)r[1] << 16);
    }
}
__device__ __forceinline__ void arows_issue(const Unit& u, LAS unsigned char* idx) {
    int R[2], C[2]; int tx = (int)threadIdx.x; asm volatile("" : "+v"(tx));
    const unsigned wofs = (unsigned)__builtin_amdgcn_readfirstlane(tx >> 6) * 256u;
#pragma unroll
    for (int i = 0; i < 2; ++i) stage_rc(tx * 16 + i * 8192, R[i], C[i]);
#pragma unroll
    for (int h = 0; h < 2; ++h)
#pragma unroll
        for (int i = 0; i < 2; ++i) { int gr = u.grow0 + h * HALF + R[i]; gr = gr < u.gcnt ? gr : u.gcnt - 1;
            __builtin_amdgcn_global_load_lds((const unsigned*)(u.gat + gr), (LAS unsigned*)(idx + (h * 2 + i) * 2048 + wofs), 4, 0, 0); }
}
__device__ __forceinline__ void arows_fetch(const LAS unsigned char* idx, unsigned (&rp)[2]) {
    int tx = (int)threadIdx.x; asm volatile("" : "+v"(tx));
    const LAS unsigned* q = (const LAS unsigned*)idx + tx;
    rp[0] = q[0] | (q[512] << 16); rp[1] = q[1024] | (q[1536] << 16);
}

template <class Epi, class Sched, bool MID, bool F8 = false, bool ALIGN = true>
__device__ __forceinline__ void gemm_phase(LAS unsigned char* lds, const int K, const Sched& S, const Epi& E, const int pitch_ = 0) {
    const int tid = threadIdx.x, wid = __builtin_amdgcn_readfirstlane(tid >> 6), lane = tid & 63, wr = wid >> 2, wc = wid & 3, fr = lane & 15, fq = lane >> 4;
#ifndef UEW_ALL
#define UEW_ALL 0
#endif
    constexpr bool UEW = F8 || UEW_ALL;
    const int nt = F8 ? K / 128 : K / BK;
    unsigned voffB[2], cpk = 0u;
    const int pitch = pitch_ ? pitch_ : (F8 ? K : 2 * K);
#pragma unroll
    for (int i = 0; i < 2; ++i) { int R, C; stage_rc(tid * 16 + i * 8192, R, C); const int Rb = Epi::PERM ? ((R & ~31) + perm32(R & 31)) : R; voffB[i] = (unsigned)(Rb * pitch + C * 2); cpk |= (unsigned)(C * 2) << (8 * i); }
    const size_t kstep = (size_t)(BK * 2);
    const size_t hstep = (size_t)HALF * pitch;
    const unsigned ldsw = (unsigned)wid * 1024u;
    const int aoff = lds_byte(wr * 64 + fr, fq * 8), boff = lds_byte(wc * 32 + fr, fq * 8);
#define PG8_SA(b, h) (((b) * 2 + (h)) * HTB)
#define PG8_SB(b, h) ((4 + (b) * 2 + (h)) * HTB)
#define PG8_STAGE(bufoff, gbase, voff) do { _Pragma("unroll") for (int _i = 0; _i < 2; ++_i) \
        __builtin_amdgcn_global_load_lds((const unsigned*)((const char*)(gbase) + (voff)[_i]), (LAS unsigned*)(lds + (bufoff) + ldsw + _i * 8192), 16, 0, 0); } while (0)
#define PG8_STAGE_A(bufoff, gbase, rpk) do { _Pragma("unroll") for (int _i = 0; _i < 2; ++_i) \
        __builtin_amdgcn_global_load_lds((const unsigned*)((const char*)(gbase) + ((unsigned)__mul24((int)(((rpk) >> (16 * _i)) & 0xffffu), pitch) + ((cpk >> (8 * _i)) & 0xffu))), (LAS unsigned*)(lds + (bufoff) + ldsw + _i * 8192), 16, 0, 0); } while (0)
#define PG8_LDA(dst, b, h) do { _Pragma("unroll") for (int m = 0; m < 4; ++m) _Pragma("unroll") for (int k = 0; k < 2; ++k) dst[m][k] = *(const LAS bf16x8*)(lds + PG8_SA(b, h) + aoff + m * 2048 + k * 1024); } while (0)
#define PG8_LDB(dst, b, h) do { _Pragma("unroll") for (int n = 0; n < 2; ++n) _Pragma("unroll") for (int k = 0; k < 2; ++k) dst[n][k] = *(const LAS bf16x8*)(lds + PG8_SB(b, h) + boff + n * 2048 + k * 1024); } while (0)
#define PG8_CAT(x) __builtin_shufflevector((i32x4)(x)[0], (i32x4)(x)[1], 0, 1, 2, 3, 4, 5, 6, 7)
#define PG8_MMA(ai, bj, At, Bt) do { __builtin_amdgcn_s_setprio(1); \
        if constexpr (F8) { _Pragma("unroll") for (int m = 0; m < 4; ++m) _Pragma("unroll") for (int n = 0; n < 2; ++n) mfma_f8_inplace(acc[ai][bj][m][n], PG8_CAT(Bt[n]), PG8_CAT(At[m]), f8sa, f8sb); } \
        else { _Pragma("unroll") for (int m = 0; m < 4; ++m) _Pragma("unroll") for (int n = 0; n < 2; ++n) _Pragma("unroll") for (int k = 0; k < 2; ++k) acc[ai][bj][m][n] = __builtin_amdgcn_mfma_f32_16x16x32_bf16(Bt[n][k], At[m][k], acc[ai][bj][m][n], 0, 0, 0); } \
        __builtin_amdgcn_s_setprio(0); } while (0)
#define PG8_WAIT_V(n) asm volatile("s_waitcnt vmcnt(" #n ")" ::: "memory")
#define PG8_WAIT_L(n) asm volatile("s_waitcnt lgkmcnt(" #n ")" ::: "memory")
#define PG8_BAR __builtin_amdgcn_s_barrier()
#define PG8_SCHED __builtin_amdgcn_sched_barrier(0)
    Unit cur, nxt; int ui = 0;
    if (!S.next(0, cur)) return;
    const int f8sa = 0x7A7A7A7A, f8sb = 0x7F7F7F7F;
    f32x4 acc[2][2][4][2];
#pragma unroll
    for (int a = 0; a < 2; ++a)
#pragma unroll
        for (int b = 0; b < 2; ++b)
#pragma unroll
            for (int m = 0; m < 4; ++m)
#pragma unroll
                for (int n = 0; n < 2; ++n) acc[a][b][m][n] = (f32x4){0.f, 0.f, 0.f, 0.f};
    bf16x8 At[4][2], B0[2][2], B1[2][2];
    unsigned oA[2];
    arows(cur, oA);
    const char* cA = cur.A; const char* cB = cur.B;
    PG8_STAGE(PG8_SB(0, 0), cB, voffB); PG8_STAGE(PG8_SB(0, 1), cB + hstep, voffB); PG8_STAGE_A(PG8_SA(0, 0), cA, oA[0]); PG8_STAGE_A(PG8_SA(0, 1), cA, oA[1]);
    if (wr == 1) PG8_BAR;
    PG8_WAIT_V(2); PG8_BAR;
    PG8_STAGE(PG8_SB(1, 0), cB + kstep, voffB); PG8_STAGE_A(PG8_SA(1, 0), cA + kstep, oA[0]); PG8_STAGE(PG8_SB(1, 1), cB + hstep + kstep, voffB);
    PG8_WAIT_V(6); PG8_BAR;
    bool has_next = false;
    unsigned nO[2] = {oA[0], oA[1]};
    if constexpr (Sched::GATHER) { has_next = S.next(1, nxt); if (has_next) arows(nxt, nO); }
    for (;;) {
        if constexpr (!Sched::GATHER) has_next = S.next(ui + 1, nxt);
        const char* nA = has_next ? nxt.A : cA; const char* nB = has_next ? nxt.B : cB;
        bool nraw_on = false;
        for (int t = 0; t < nt; t += 2) {
            const bool last = (t == nt - 2);
            if constexpr (Sched::GATHER) { if (t == 0 && has_next) { Unit t2; if (S.next(ui + 2, t2) && t2.gat) { arows_issue(t2, lds + AUX_OFF + 8192); nraw_on = true; } } }
            if (MID && t == nt / 2) E.mid(acc, cur, wr, wc, fr, fq);
            const char* a1 = cA + (size_t)(t + 1) * kstep;
            const char* a2 = last ? nA : cA + (size_t)(t + 2) * kstep; const char* b2 = last ? nB : cB + (size_t)(t + 2) * kstep;
            const char* a3 = a2 + kstep; const char* b3 = b2 + kstep;
            PG8_LDB(B0, 0, 0); PG8_LDB(B1, 0, 1); PG8_SCHED; PG8_LDA(At, 0, 0); PG8_STAGE_A(PG8_SA(1, 1), a1, oA[1]);
            PG8_WAIT_V(8);
            PG8_WAIT_L(0); PG8_BAR; PG8_MMA(0, 0, At, B0); PG8_MMA(0, 1, At, B1); PG8_BAR; PG8_SCHED;
            if constexpr (Sched::GATHER) { if (last) { oA[0] = nO[0]; oA[1] = nO[1]; } }
            PG8_LDA(At, 0, 1); PG8_STAGE(PG8_SB(0, 0), b2, voffB); PG8_STAGE(PG8_SB(0, 1), b2 + hstep, voffB); PG8_STAGE_A(PG8_SA(0, 0), a2, oA[0]);
            PG8_WAIT_V(8);
            PG8_WAIT_L(0); PG8_BAR; PG8_MMA(1, 0, At, B0); PG8_MMA(1, 1, At, B1); PG8_BAR; PG8_SCHED;
            PG8_LDB(B0, 1, 0); PG8_LDB(B1, 1, 1); PG8_SCHED; PG8_LDA(At, 1, 0); PG8_STAGE_A(PG8_SA(0, 1), a2, oA[1]);
            PG8_WAIT_V(8); PG8_WAIT_L(0); PG8_BAR; PG8_MMA(0, 0, At, B0); PG8_MMA(0, 1, At, B1); PG8_BAR; PG8_SCHED;
            PG8_LDA(At, 1, 1); PG8_STAGE(PG8_SB(1, 0), b3, voffB); PG8_STAGE(PG8_SB(1, 1), b3 + hstep, voffB); PG8_STAGE_A(PG8_SA(1, 0), a3, oA[0]);
            PG8_WAIT_V(8); PG8_WAIT_L(0); PG8_BAR; PG8_MMA(1, 0, At, B0); PG8_MMA(1, 1, At, B1); PG8_BAR; PG8_SCHED;
        }
        Unit nn; bool has_nn = false; unsigned nnO[2] = {nO[0], nO[1]};
        if constexpr (Sched::GATHER) { if (has_next) { has_nn = S.next(ui + 2, nn); if (has_nn && !nraw_on) arows(nn, nnO); } }
        f32x4 epf[6];
        E.pre(cur, wr, wc, fr, fq, epf);
        if constexpr (UEW) PG8_WAIT_V(0);
        if constexpr (Sched::GATHER) { if (has_nn && nraw_on) arows_fetch(lds + AUX_OFF + 8192, nnO); asm volatile("" : "+v"(nnO[0]), "+v"(nnO[1])); }
        if constexpr (ALIGN) { if (wr == 0) PG8_BAR; }
        if constexpr (F8) asm volatile("s_nop 15\n\ts_nop 7" ::: "memory");
        E(acc, cur, wr, wc, fr, fq, epf);
        if (!has_next) break;
#pragma unroll
        for (int a = 0; a < 2; ++a)
#pragma unroll
            for (int b = 0; b < 2; ++b)
#pragma unroll
                for (int m = 0; m < 4; ++m)
#pragma unroll
                    for (int n = 0; n < 2; ++n) acc[a][b][m][n] = (f32x4){0.f, 0.f, 0.f, 0.f};
        cur = nxt; cA = nA; cB = nB; ++ui;
        if constexpr (Sched::GATHER) { nxt = nn; has_next = has_nn; nO[0] = nnO[0]; nO[1] = nnO[1]; }
        if constexpr (ALIGN) { if (wr == 1) PG8_BAR; }
    }
    PG8_WAIT_V(0);
    if constexpr (!ALIGN) { if (wr == 0) PG8_BAR; }
    PG8_BAR;
#undef PG8_SA
#undef PG8_SB
#undef PG8_STAGE
#undef PG8_STAGE_A
#undef PG8_LDA
#undef PG8_LDB
#undef PG8_MMA
#undef PG8_CAT
#undef PG8_WAIT_V
#undef PG8_WAIT_L
#undef PG8_BAR
#undef PG8_SCHED
}
__device__ __forceinline__ void static_order(int L, int nM, int nN, int& pm, int& pn) {
    const int nwg = nM * nN; int wgid = L;
    { const int q = nwg / 8, r = nwg % 8, xcd = wgid % 8, off = wgid / 8; wgid = (xcd < r ? xcd * (q + 1) : r * (q + 1) + (xcd - r) * q) + off; }
    const int nig = 8 * nN, gid = wgid / nig, fm = gid * 8, gsz = (nM - fm) < 8 ? (nM - fm) : 8;
    pm = fm + ((wgid % nig) % gsz); pn = (wgid % nig) / gsz;
}
}
using pg8::Unit;

struct SchedInProj {
    static constexpr bool GATHER = false;
    const char *HX, *HC, *WIN; int G, c, nctx, same;
    __device__ __forceinline__ bool next(int i, Unit& u) const {
        const int L = i * G + c; if (L >= 3584 + nctx) return false;
        int pm, pn; bool ctx = false;
        if (L < 3584) { pg8::static_order(L, 128, 28, pm, pn); u.A = HX + (size_t)(same ? 0 : pm) * 256 * PA * 2; }
        else { const int r = L - 3584; pm = r >> 2; pn = 12 + (r & 3); u.A = HC + (size_t)pm * 256 * PA * 2; ctx = true; }
        u.B = WIN + (size_t)(same ? 0 : pn) * 256 * PA * 2; u.gat = nullptr; u.gcnt = 0; u.grow0 = 0; u.row0 = pm * 256; u.e = 0; u.slot0 = 0;
        if (pn < 4) { u.kind = 0; u.ocol = pn * 256; }
        else if (pn < 12) { u.kind = 1; u.ocol = (pn - 4) * 128; }
        else if (pn < 16) { u.kind = ctx ? 5 : 2; u.ocol = (pn - 12) * 256; }
        else if (pn < 20) { u.kind = 3; u.ocol = (pn - 16) * 256; }
        else { u.kind = 4; u.ocol = (pn - 20) * 128; }
        return true;
    }
};
struct SchedCtx {
    static constexpr bool GATHER = false;
    const char *HC, *WIN; int v;
    __device__ __forceinline__ bool next(int i, Unit& u) const {
        if (i > 0) return false;
        const int pm = v >> 2, pn = 12 + (v & 3);
        u.A = HC + (size_t)pm * 256 * D * 2; u.B = WIN + (size_t)pn * 256 * D * 2; u.gat = nullptr; u.gcnt = 0; u.grow0 = 0; u.row0 = pm * 256; u.e = 0; u.slot0 = 0; u.kind = 5; u.ocol = (pn - 12) * 256;
        return true;
    }
};
struct SchedDense {
    static constexpr bool GATHER = false;
    const char *A, *B; int K, G, c;
    __device__ __forceinline__ bool next(int i, Unit& u) const {
        const int L = i * G + c; if (L >= 128 * 4) return false;
        int pm, pn; pg8::static_order(L, 128, 4, pm, pn);
        u.A = A + (size_t)pm * 256 * K * 2; u.B = B + (size_t)pn * 256 * K * 2; u.gat = nullptr; u.gcnt = 0; u.grow0 = 0; u.kind = 0; u.row0 = pm * 256; u.ocol = pn * 256; u.e = 0; u.slot0 = 0;
        return true;
    }
};
constexpr int MOE_NREC = 64;
struct SchedMoe {
    static constexpr bool GATHER = true;
    const char *Abase, *W; const int* tok; const LAS int* tab; int npn, G, c, gather, wrows, esz;
    __device__ __forceinline__ bool next(int i, Unit& u) const {
#define RFL(x) __builtin_amdgcn_readfirstlane(x)
        if (i >= MOE_NREC) return false;
        const i32x4 r = *(const LAS i32x4*)(tab + 128 + 4 * i);
        if (RFL(r[0]) == 0) return false;
        const int pk = RFL(r[1]), cnt = RFL(r[2]), rb = RFL(r[3]), e = pk & 255, pn = (pk >> 8) & 255, mt = pk >> 16;
#undef RFL
        u.e = e; u.slot0 = mt * 256; u.row0 = rb; u.kind = 0; u.gcnt = cnt; u.grow0 = mt * 256;
        u.B = W + ((size_t)e * wrows + (size_t)pn * 256) * DE * esz;
        if (gather) { u.A = Abase; u.gat = tok + (size_t)e * M; u.ocol = pn * 128; }
        else { u.A = Abase + (size_t)rb * DE * esz; u.gat = nullptr; u.ocol = pn * 256; }
        return true;
    }
};
__device__ __forceinline__ void moe_tables(LAS int* tab, const unsigned* gcnt, int npn, int G = 0, int c = 0) {
    if (threadIdx.x == 0) { int pu = 0, pr = 0; for (int e = 0; e < NE; ++e) { const int cn = (int)gcnt[e], t = (cn + 255) >> 8; tab[e] = pu; tab[33 + e] = cn; tab[65 + e] = pr; pu += t * npn; pr += t * 256; } tab[32] = pu; }
    __syncthreads();
    if (G > 0 && (int)threadIdx.x < MOE_NREC) {
        int cp = c;
        if (G == 256) { const int x = c & 7, j = c >> 3; cp = npn == 8 ? (x >> 2) * 128 + (j >> 2) * 16 + (x & 3) * 4 + (j & 3) : npn == 4 ? (x >> 1) * 64 + (j >> 3) * 16 + (x & 1) * 8 + (j & 7) : c; }
        const int i = (int)threadIdx.x, L = i * G + cp; i32x4 r = (i32x4){0, 0, 0, 0};
        if (L < tab[32]) { int e = 0;
#pragma unroll
            for (int s = 16; s >= 1; s >>= 1) if (tab[e + s] <= L) e += s;
            const int cnt = tab[33 + e], tiles = (cnt + 255) >> 8, l = L - tab[e], pn = l / tiles, mt = l - pn * tiles;
            r = (i32x4){1, e | (pn << 8) | (mt << 16), cnt, tab[65 + e] + mt * 256}; }
        *(LAS i32x4*)(tab + 128 + 4 * i) = r;
    }
    if (G > 0) __syncthreads();
}

struct EpiInProj {
    static constexpr bool PERM = true;
    unsigned char* ws; const float* bmerge; int skip;
    __device__ __forceinline__ void mid(f32x4 (&)[2][2][4][2], const Unit&, int, int, int, int) const {}
    __device__ __forceinline__ void pre(const Unit& u, int wr, int wc, int fr, int fq, f32x4 (&epf)[6]) const {
        if (u.kind == 4) { const int cl = wc * 32 + 8 * fq;
#pragma unroll
            for (int n = 0; n < 2; ++n) { epf[n] = *(const f32x4*)(bmerge + u.ocol + cl + 4 * n); epf[2 + n] = *(const f32x4*)(bmerge + D + u.ocol + cl + 4 * n); } }
    }
    __device__ __forceinline__ void operator()(const f32x4 (&acc)[2][2][4][2], const Unit& u, int wr, int wc, int fr, int fq, const f32x4 (&epf)[6]) const {
        if (skip == 1) return;
        const bool st_ = !(skip == 2 && u.row0 >= 0);
        int row0 = u.row0 + wr * 64 + fr; asm volatile("" : "+v"(row0)); const int cl = wc * 32 + 8 * fq;
        if (u.kind == 1) {
            bf16* base = (bf16*)(ws + WS_U) + u.ocol + cl;
#pragma unroll
            for (int ai = 0; ai < 2; ++ai)
#pragma unroll
                for (int m = 0; m < 4; ++m) { const f32x4 v0 = acc[ai][0][m][0] * acc[ai][1][m][0], v1 = acc[ai][0][m][1] * acc[ai][1][m][1];
                    u32x4 w; w.x = cvt_pk_bf16(v0[0], v0[1]); w.y = cvt_pk_bf16(v0[2], v0[3]); w.z = cvt_pk_bf16(v1[0], v1[1]); w.w = cvt_pk_bf16(v1[2], v1[3]);
                    if (st_) *(u32x4*)(base + (size_t)(row0 + ai * 128 + m * 16) * D) = w; }
        } else if (u.kind == 4) {
            bf16* rat = (bf16*)(ws + WS_RAT) + u.ocol + cl; bf16* sbg = (bf16*)(ws + WS_SBG) + u.ocol + cl;
            f32x4 ba[2], bb[2];
#pragma unroll
            for (int n = 0; n < 2; ++n) { ba[n] = epf[n] * -1.4426950409f; bb[n] = epf[2 + n] * -1.4426950409f; }
#pragma unroll
            for (int ai = 0; ai < 2; ++ai)
#pragma unroll
                for (int m = 0; m < 4; ++m) { f32x4 r[2], s[2];
#pragma unroll
                    for (int n = 0; n < 2; ++n)
#pragma unroll
                        for (int j = 0; j < 4; ++j) { const float ea = __builtin_amdgcn_exp2f(acc[ai][0][m][n][j] * -1.4426950409f + ba[n][j]), eb = __builtin_amdgcn_exp2f(acc[ai][1][m][n][j] * -1.4426950409f + bb[n][j]);
                            s[n][j] = __builtin_amdgcn_rcpf(1.0f + eb); r[n][j] = (1.0f + eb) * __builtin_amdgcn_rcpf(1.0f + ea); }
                    u32x4 w; w.x = cvt_pk_bf16(r[0][0], r[0][1]); w.y = cvt_pk_bf16(r[0][2], r[0][3]); w.z = cvt_pk_bf16(r[1][0], r[1][1]); w.w = cvt_pk_bf16(r[1][2], r[1][3]);
                    u32x4 x; x.x = cvt_pk_bf16(s[0][0], s[0][1]); x.y = cvt_pk_bf16(s[0][2], s[0][3]); x.z = cvt_pk_bf16(s[1][0], s[1][1]); x.w = cvt_pk_bf16(s[1][2], s[1][3]);
                    const size_t o = (size_t)(row0 + ai * 128 + m * 16) * D; if (st_) { *(u32x4*)(rat + o) = w; *(u32x4*)(sbg + o) = x; } }
        } else {
            bf16* base = (bf16*)(ws + (u.kind == 0 ? WS_GB : u.kind == 2 ? WS_ULRU : u.kind == 3 ? WS_GG : WS_CS3)) + u.ocol + cl;
            const bool gelu = u.kind == 3;
#pragma unroll
            for (int ai = 0; ai < 2; ++ai)
#pragma unroll
                for (int m = 0; m < 4; ++m)
#pragma unroll
                    for (int bj = 0; bj < 2; ++bj) { f32x4 v0 = acc[ai][bj][m][0], v1 = acc[ai][bj][m][1];
                        if (gelu) {
#pragma unroll
                            for (int j = 0; j < 4; ++j) { v0[j] = gelu_fast(v0[j]); v1[j] = gelu_fast(v1[j]); } }
                        u32x4 w; w.x = cvt_pk_bf16(v0[0], v0[1]); w.y = cvt_pk_bf16(v0[2], v0[3]); w.z = cvt_pk_bf16(v1[0], v1[1]); w.w = cvt_pk_bf16(v1[2], v1[3]);
                        if (st_) *(u32x4*)(base + (size_t)(row0 + ai * 128 + m * 16) * D + bj * 128) = w; }
        }
    }
};
struct EpiMerge {
    static constexpr bool PERM = true;
    unsigned char* ws;
    __device__ __forceinline__ void mid(f32x4 (&acc)[2][2][4][2], const Unit& u, int wr, int wc, int fr, int fq) const {
        const bf16* rat = (const bf16*)(ws + WS_RAT) + u.ocol + wc * 32 + 8 * fq; int row0 = u.row0 + wr * 64 + fr; asm volatile("" : "+v"(row0));
#pragma unroll
        for (int ai = 0; ai < 2; ++ai) {
            u32x4 w[4][2];
#pragma unroll
            for (int m = 0; m < 4; ++m)
#pragma unroll
                for (int bj = 0; bj < 2; ++bj) w[m][bj] = __builtin_nontemporal_load((const u32x4*)(rat + (size_t)(row0 + ai * 128 + m * 16) * D + bj * 128));
#pragma unroll
            for (int m = 0; m < 4; ++m)
#pragma unroll
                for (int bj = 0; bj < 2; ++bj) { const u32x4 q = w[m][bj];
                    acc[ai][bj][m][0] *= (f32x4){bflo(q.x), bfhi(q.x), bflo(q.y), bfhi(q.y)}; acc[ai][bj][m][1] *= (f32x4){bflo(q.z), bfhi(q.z), bflo(q.w), bfhi(q.w)}; }
            asm volatile("" ::: "memory"); }
    }
    __device__ __forceinline__ void pre(const Unit&, int, int, int, int, f32x4 (&)[6]) const {}
    __device__ __forceinline__ void operator()(const f32x4 (&acc)[2][2][4][2], const Unit& u, int wr, int wc, int fr, int fq, const f32x4 (&)[6]) const {
        const bf16* sbg = (const bf16*)(ws + WS_SBG) + u.ocol + wc * 32 + 8 * fq; bf16* mg = (bf16*)(ws + WS_MG) + u.ocol + wc * 32 + 8 * fq; int row0 = u.row0 + wr * 64 + fr; asm volatile("" : "+v"(row0));
#pragma unroll
        for (int ai = 0; ai < 2; ++ai) {
            u32x4 w[4][2];
#pragma unroll
            for (int m = 0; m < 4; ++m)
#pragma unroll
                for (int bj = 0; bj < 2; ++bj) w[m][bj] = __builtin_nontemporal_load((const u32x4*)(sbg + (size_t)(row0 + ai * 128 + m * 16) * D + bj * 128));
#pragma unroll
            for (int m = 0; m < 4; ++m)
#pragma unroll
                for (int bj = 0; bj < 2; ++bj) { const size_t o = (size_t)(row0 + ai * 128 + m * 16) * D + bj * 128; const u32x4 q = w[m][bj];
                    const f32x4 v0 = acc[ai][bj][m][0] * (f32x4){bflo(q.x), bfhi(q.x), bflo(q.y), bfhi(q.y)}, v1 = acc[ai][bj][m][1] * (f32x4){bflo(q.z), bfhi(q.z), bflo(q.w), bfhi(q.w)};
                    u32x4 x; x.x = cvt_pk_bf16(v0[0], v0[1]); x.y = cvt_pk_bf16(v0[2], v0[3]); x.z = cvt_pk_bf16(v1[0], v1[1]); x.w = cvt_pk_bf16(v1[2], v1[3]);
                    *(u32x4*)(mg + o) = x; }
            asm volatile("" ::: "memory"); }
    }
};

struct EpiWo {
    static constexpr bool PERM = false;
    const float* x; bf16* out; const float* mx;
    __device__ __forceinline__ void mid(f32x4 (&)[2][2][4][2], const Unit&, int, int, int, int) const {}
    __device__ __forceinline__ void pre(const Unit& u, int wr, int wc, int fr, int fq, f32x4 (&epf)[6]) const {
        const float* gp = mx + (u.row0 / SEQ) * 6144 + 2 * 1024 + u.ocol + wc * 32 + 4 * fq;
#pragma unroll
        for (int bj = 0; bj < 2; ++bj)
#pragma unroll
            for (int n = 0; n < 2; ++n) epf[bj * 2 + n] = *(const f32x4*)(gp + bj * 128 + n * 16);
    }
    __device__ __forceinline__ void operator()(const f32x4 (&acc)[2][2][4][2], const Unit& u, int wr, int wc, int fr, int fq, const f32x4 (&epf)[6]) const {
        int row0 = u.row0 + wr * 64 + fr; asm volatile("" : "+v"(row0)); const int col0 = u.ocol + wc * 32 + 4 * fq;
        f32x4 g[2][2];
#pragma unroll
        for (int bj = 0; bj < 2; ++bj)
#pragma unroll
            for (int n = 0; n < 2; ++n) g[bj][n] = epf[bj * 2 + n];
#pragma unroll
        for (int ai = 0; ai < 2; ++ai)
#pragma unroll
            for (int m2 = 0; m2 < 4; m2 += 2) { f32x4 xv[2][2][2];
#pragma unroll
                for (int mm = 0; mm < 2; ++mm)
#pragma unroll
                    for (int bj = 0; bj < 2; ++bj)
#pragma unroll
                        for (int n = 0; n < 2; ++n) xv[mm][bj][n] = __builtin_nontemporal_load((const f32x4*)(x + (size_t)(row0 + ai * 128 + (m2 + mm) * 16) * D + col0 + bj * 128 + n * 16));
#pragma unroll
                for (int mm = 0; mm < 2; ++mm)
#pragma unroll
                    for (int bj = 0; bj < 2; ++bj)
#pragma unroll
                        for (int n = 0; n < 2; ++n) { const f32x4 o = xv[mm][bj][n] + g[bj][n] * acc[ai][bj][m2 + mm][n]; u32x2 w; w.x = cvt_pk_bf16(o[0], o[1]); w.y = cvt_pk_bf16(o[2], o[3]);
                            *(u32x2*)(out + (size_t)(row0 + ai * 128 + (m2 + mm) * 16) * D + col0 + bj * 128 + n * 16) = w; }
                asm volatile("" ::: "memory"); }
    }
};
struct EpiMoe1 {
    static constexpr bool PERM = true;
    unsigned char* ws; const float* b1;
    __device__ __forceinline__ void mid(f32x4 (&)[2][2][4][2], const Unit&, int, int, int, int) const {}
    __device__ __forceinline__ void pre(const Unit& u, int wr, int wc, int fr, int fq, f32x4 (&epf)[6]) const {
        const float* bp = b1 + (size_t)u.e * 2048 + 2 * (u.ocol + wc * 32 + 8 * fq);
#pragma unroll
        for (int i = 0; i < 4; ++i) epf[i] = *(const f32x4*)(bp + 4 * i);
    }
    __device__ __forceinline__ void operator()(const f32x4 (&acc)[2][2][4][2], const Unit& u, int wr, int wc, int fr, int fq, const f32x4 (&epf)[6]) const {
        int row0 = u.row0 + wr * 64 + fr; asm volatile("" : "+v"(row0)); const int j0 = u.ocol + wc * 32 + 8 * fq;
        f32x4 bv[4];
#pragma unroll
        for (int i = 0; i < 4; ++i) bv[i] = epf[i];
        unsigned char* base = ws + WS_ACT + j0;
#pragma unroll
        for (int ai = 0; ai < 2; ++ai)
#pragma unroll
            for (int m = 0; m < 4; ++m) { f32x4 a[2];
#pragma unroll
                for (int n = 0; n < 2; ++n)
#pragma unroll
                    for (int jj = 0; jj < 4; ++jj) { const float hg = acc[ai][0][m][n][jj] + bv[2 * n + (jj >> 1)][2 * (jj & 1)], hl = acc[ai][1][m][n][jj] + bv[2 * n + (jj >> 1)][2 * (jj & 1) + 1];
                        const float glu = fminf(hg, 7.0f), lin = fminf(fmaxf(hl, -7.0f), 7.0f);
                        a[n][jj] = glu * fsig(1.702f * glu) * (lin + 1.0f); }
                u32x2 w; w.x = pk4_fp8(a[0][0], a[0][1], a[0][2], a[0][3]); w.y = pk4_fp8(a[1][0], a[1][1], a[1][2], a[1][3]);
                *(u32x2*)(base + (size_t)(row0 + ai * 128 + m * 16) * DE) = w; }
    }
};
struct EpiMoe2 {
    static constexpr bool PERM = true;
    unsigned char* ws; const float* b2;
    __device__ __forceinline__ void mid(f32x4 (&)[2][2][4][2], const Unit&, int, int, int, int) const {}
    __device__ __forceinline__ void pre(const Unit& u, int wr, int wc, int fr, int fq, f32x4 (&epf)[6]) const {
        const float* bp = b2 + (size_t)u.e * D + u.ocol + wc * 32 + 8 * fq; const float* gp = (const float*)(ws + WS_GATE) + (size_t)u.e * M + u.slot0 + wr * 64 + fr;
#pragma unroll
        for (int bj = 0; bj < 2; ++bj)
#pragma unroll
            for (int n = 0; n < 2; ++n) epf[bj * 2 + n] = *(const f32x4*)(bp + bj * 128 + 4 * n);
#pragma unroll
        for (int ai = 0; ai < 2; ++ai) epf[4 + ai] = (f32x4){gp[ai * 128], gp[ai * 128 + 16], gp[ai * 128 + 32], gp[ai * 128 + 48]};
    }
    __device__ __forceinline__ void operator()(const f32x4 (&acc)[2][2][4][2], const Unit& u, int wr, int wc, int fr, int fq, const f32x4 (&epf)[6]) const {
        int rl = wr * 64 + fr; asm volatile("" : "+v"(rl)); const int c0 = u.ocol + wc * 32 + 8 * fq;
        f32x4 bv[2][2]; float g[2][4];
#pragma unroll
        for (int bj = 0; bj < 2; ++bj)
#pragma unroll
            for (int n = 0; n < 2; ++n) bv[bj][n] = epf[bj * 2 + n];
#pragma unroll
        for (int ai = 0; ai < 2; ++ai)
#pragma unroll
            for (int m = 0; m < 4; ++m) g[ai][m] = epf[4 + ai][m];
        unsigned char* base = ws + WS_OUTP + c0;
#pragma unroll
        for (int ai = 0; ai < 2; ++ai)
#pragma unroll
            for (int m = 0; m < 4; ++m) {
#pragma unroll
                for (int bj = 0; bj < 2; ++bj) { const f32x4 v0 = (acc[ai][bj][m][0] + bv[bj][0]) * g[ai][m], v1 = (acc[ai][bj][m][1] + bv[bj][1]) * g[ai][m];
                    u32x2 w; w.x = pk4_fp8(v0[0], v0[1], v0[2], v0[3]); w.y = pk4_fp8(v1[0], v1[1], v1[2], v1[3]);
                    *(u32x2*)(base + (size_t)(u.row0 + rl + ai * 128 + m * 16) * D + bj * 128) = w; } }
    }
};

#define XB_TMO      128
#define XB_XCNT(j)  (256  + 64 * (j))
#define XB_XSUB(j)  (1280 + 64 * (j))
#define XB_XGEN(j)  (2304 + 64 * (j))
#define XB_TOP      3328
#define XB_TOPGEN   3392
#define XCD_BAR_WORDS 3456
#define XB_SPIN_CAP (1u << 18)
__device__ __forceinline__ unsigned xb_ld(unsigned* p)              { return __hip_atomic_load(p, __ATOMIC_RELAXED, __HIP_MEMORY_SCOPE_AGENT); }
__device__ __forceinline__ unsigned xb_add(unsigned* p, unsigned v) { return __hip_atomic_fetch_add(p, v, __ATOMIC_RELAXED, __HIP_MEMORY_SCOPE_AGENT); }
__device__ __forceinline__ unsigned xb_xcc_id() { return (unsigned)__builtin_amdgcn_s_getreg((3 << 11) | 20) & 0xFu; }
#define XB_SPIN(cond, bar) do { unsigned _sp = 0; while (cond) { __builtin_amdgcn_s_sleep(1); \
    if ((++_sp & 255u) == 0u) { if (xb_ld(&(bar)[XB_TMO])) break; if (_sp > XB_SPIN_CAP) { atomicAdd(&(bar)[XB_TMO], 1u); break; } } } } while (0)
struct XcdBarrier { unsigned* bar; unsigned x; volatile LAS unsigned* st; };
__device__ __forceinline__ XcdBarrier xcd_barrier_post(unsigned* bar, volatile LAS unsigned* st) {
    XcdBarrier b; b.bar = bar; b.x = xb_xcc_id(); b.st = st;
    if (threadIdx.x == 0) (void)xb_add(&bar[XB_XCNT(b.x)], 1u);
    return b;
}
__device__ __forceinline__ void xcd_barrier_complete(unsigned* bar, unsigned x, unsigned& nloc, unsigned& nx) {
    const unsigned G = gridDim.x * gridDim.y * gridDim.z;
    unsigned sum, cnt, mine, sp = 0u;
    for (;;) {
        sum = 0u; cnt = 0u; mine = 0u;
#pragma unroll
        for (unsigned j = 0; j < 16; ++j) { const unsigned c = xb_ld(&bar[XB_XCNT(j)]); sum += c; cnt += (c > 0u) ? 1u : 0u; mine = (j == x) ? c : mine; }
        if (sum == G) break;
        __builtin_amdgcn_s_sleep(1);
        if ((++sp & 255u) == 0u) { if (xb_ld(&bar[XB_TMO])) break; if (sp > XB_SPIN_CAP) { atomicAdd(&bar[XB_TMO], 1u); break; } }
    }
    nloc = mine > 0u ? mine : 1u; nx = cnt > 0u ? cnt : 1u;
}
__device__ __forceinline__ void xcd_barrier(const XcdBarrier& b) {
    asm volatile("s_waitcnt vmcnt(0)" ::: "memory");
    __syncthreads();
    if (threadIdx.x == 0) {
        unsigned* bar = b.bar;
        __builtin_amdgcn_s_waitcnt(0);
        unsigned nloc = b.st[0], nx = b.st[1];
        if (nloc == 0u) { xcd_barrier_complete(bar, b.x, nloc, nx); b.st[0] = nloc; b.st[1] = nx; }
        const unsigned old = xb_add(&bar[XB_XSUB(b.x)], 1u);
        const unsigned gen = old / nloc;
        if (old + 1u == (gen + 1u) * nloc) {
            __builtin_amdgcn_fence(__ATOMIC_RELEASE, "agent");
            asm volatile("s_waitcnt vmcnt(0)" ::: "memory");
            const unsigned og = xb_add(&bar[XB_TOP], 1u);
            const unsigned tg = og / nx;
            if (og + 1u == (tg + 1u) * nx) xb_add(&bar[XB_TOPGEN], 1u);
            else XB_SPIN(xb_ld(&bar[XB_TOPGEN]) == tg, bar);
            __builtin_amdgcn_fence(__ATOMIC_ACQUIRE, "agent");
            xb_add(&bar[XB_XGEN(b.x)], 1u);
            asm volatile("s_waitcnt vmcnt(0)" ::: "memory");
        } else {
            XB_SPIN(xb_ld(&bar[XB_XGEN(b.x)]) == gen, bar);
            __builtin_amdgcn_fence(__ATOMIC_ACQUIRE, "agent");
            asm volatile("s_waitcnt vmcnt(0)" ::: "memory");
        }
    }
    __syncthreads();
}

struct Frame {
    LAS unsigned char* lds; const P& p;
    int tid, lane, wave, vcu, G, var;
};

template <class RowMap>
__device__ __forceinline__ void p0_transpose_item(const float* W, int N, bf16* WT, int ldt, int coloff, LAS float* scr, int kb, int nb, int lane, RowMap rm) {
    const int k0 = 64 * kb, n0 = 32 * nb;
    float v[32];
#pragma unroll
    for (int i = 0; i < 32; ++i) { const int kk = 2 * i + (lane >> 5); v[i] = W[(size_t)(k0 + kk) * N + n0 + (lane & 31)]; }
#pragma unroll
    for (int i = 0; i < 32; ++i) { const int kk = 2 * i + (lane >> 5); scr[kk * 33 + (lane & 31)] = v[i]; }
    LDS_WAIT(); asm volatile("" ::: "memory");
    const int c = lane & 7;
#pragma unroll
    for (int j = 0; j < 4; ++j) { const int n = (lane >> 3) + 8 * j; const LAS float* s = scr + (8 * c) * 33 + n;
        u32x4 o; o.x = pk2(s[0 * 33], s[1 * 33]); o.y = pk2(s[2 * 33], s[3 * 33]); o.z = pk2(s[4 * 33], s[5 * 33]); o.w = pk2(s[6 * 33], s[7 * 33]);
        *(u32x4*)(WT + (size_t)rm(n0 + n) * ldt + coloff + k0 + 8 * c) = o; }
    LDS_WAIT(); asm volatile("" ::: "memory");
}
template <class RowMap>
__device__ __forceinline__ void p0_transpose_item_f8(const float* W, int N, unsigned char* WT, int ldt, LAS float* scr, int kb, int nb, int lane, RowMap rm) {
    const int k0 = 64 * kb, n0 = 32 * nb;
    float v[32];
#pragma unroll
    for (int i = 0; i < 32; ++i) { const int kk = 2 * i + (lane >> 5); v[i] = W[(size_t)(k0 + kk) * N + n0 + (lane & 31)]; }
#pragma unroll
    for (int i = 0; i < 32; ++i) { const int kk = 2 * i + (lane >> 5); scr[kk * 33 + (lane & 31)] = v[i] * 32.0f; }
    LDS_WAIT(); asm volatile("" ::: "memory");
    const int c = lane & 3;
#pragma unroll
    for (int j = 0; j < 2; ++j) { const int n = (lane >> 2) + 16 * j; const LAS float* s = scr + (16 * c) * 33 + n;
        u32x4 o; o.x = pk4_fp8(s[0 * 33], s[1 * 33], s[2 * 33], s[3 * 33]); o.y = pk4_fp8(s[4 * 33], s[5 * 33], s[6 * 33], s[7 * 33]);
        o.z = pk4_fp8(s[8 * 33], s[9 * 33], s[10 * 33], s[11 * 33]); o.w = pk4_fp8(s[12 * 33], s[13 * 33], s[14 * 33], s[15 * 33]);
        *(u32x4*)(WT + (size_t)rm(n0 + n) * ldt + k0 + 16 * c) = o; }
    LDS_WAIT(); asm volatile("" ::: "memory");
}
struct RmId { __device__ __forceinline__ int operator()(int n) const { return n; } };
struct RmWin { __device__ __forceinline__ int operator()(int n) const { const int g = n >> 10, ch = n & 1023;
    return g == 0 ? ch : g == 1 ? 1024 + 256 * (ch >> 7) + (ch & 127) : g == 2 ? 1024 + 256 * (ch >> 7) + 128 + (ch & 127) : g == 3 ? 3072 + ch : g == 4 ? 4096 + ch : g == 5 ? 5120 + 256 * (ch >> 7) + (ch & 127) : 5120 + 256 * (ch >> 7) + 128 + (ch & 127); } };
struct RmW1 { __device__ __forceinline__ int operator()(int n) const { const int j = n >> 1, h = n & 1; return 256 * (j >> 7) + 128 * h + (j & 127); } };
struct RmGen { int kind, off; __device__ __forceinline__ int operator()(int n) const { return kind == 1 ? RmWin{}(n) : kind == 2 ? RmW1{}(n) : off + n; } };

constexpr int I_ADA = 96 * 8, I_WIN = 16 * 224, I_WA = 16 * 32, I_WO = 16 * 32, I_W1 = NE * 16 * 64, I_W2 = NE * 16 * 32, I_LG = 2 * 16 * 2 * 2;
constexpr int P0_ITEMS = I_ADA + I_WIN + 2 * I_WA + I_WO + I_LG;
constexpr size_t WS_RTAB = WS_MX + 256 * 1024;
constexpr size_t WS_WG = 15 * MiB + 512 * 1024;

struct P0Desc { const float* src; unsigned char* dst; int N, ldtb, n0, rmk, roff, f8; float sc; };
__device__ __forceinline__ P0Desc p0_describe(const P& p, int r) {
    const float* W; int N, ldt, coloff = 0, kb, nb, rmk = 0, roff = 0, f8 = 0; unsigned char* WT; float sc = 1.0f;
    if (r < I_WIN) { W = p.w_in; N = INC; WT = p.ws + WS_WIN; ldt = PA; kb = r / 224; nb = r % 224; rmk = 1; }
    else if ((r -= I_WIN) < I_WA) { W = p.w_out_a; N = D; WT = p.ws + WS_WAB; ldt = 2048; kb = r >> 5; nb = r & 31; }
    else if ((r -= I_WA) < I_WA) { W = p.w_out_b; N = D; WT = p.ws + WS_WAB; ldt = 2048; coloff = 1024; kb = r >> 5; nb = r & 31; }
    else if ((r -= I_WA) < I_WO) { W = p.w_o; N = D; WT = p.ws + WS_WO; ldt = D; kb = r >> 5; nb = r & 31; }
    else { r -= I_WO; const int gate = (r >> 1) & 1, db = r >> 2;
        W = (gate ? p.lru_wx : p.lru_wa) + (size_t)db * 4096; N = 64; WT = p.ws + WS_WG + (size_t)db * 128 * 64 * 2; ldt = 64; kb = 0; nb = r & 1; roff = gate * 64; sc = -1.4426950408889634f; }
    const int esz = f8 ? 1 : 2;
    return P0Desc{W + (size_t)(64 * kb) * N + 32 * nb, WT + (size_t)(coloff + 64 * kb) * esz, N, ldt * esz, 32 * nb, rmk, roff, f8, f8 ? 32.0f : sc};
}
__device__ __forceinline__ void p0_prologue(Frame& F) {
    const P& p = F.p; const int lane = F.lane;
    LAS float* sil = (LAS float*)(F.lds + AUX_OFF);
    for (int i = F.tid; i < 5 * D; i += NTHR) { const int r = i >> 10, k = i & 1023; const float v = r < 4 ? p.c[r * D + k] : p.c_ctx[k]; sil[i] = v * sigmoidf_(v); }
    __syncthreads();
    for (int i = F.vcu * NTHR + F.tid; i < D * NE; i += F.G * NTHR) {
        const int e = i & 31, k = i >> 5; const float w = p.router_w[i]; const bf16 hi = f2bf(w), lo = f2bf(w - bf2f(hi));
        const int off = e * 2048 + ((((k >> 3) ^ (e & 15))) << 4) + (k & 7) * 2; *(bf16*)(p.ws + WS_RTAB + off) = hi; *(bf16*)(p.ws + WS_RTAB + 65536 + off) = lo; }
    LAS float* scr = (LAS float*)(F.lds + F.wave * 16384);
    const int gw = F.vcu * NWAVES + F.wave, NGW = F.G * NWAVES;
    int it = gw;
    for (; it < I_ADA; it += NGW) {
        const int cg = it % 96, ks = it / 96, n = 64 * cg + lane, k0 = 128 * ks; float a[5] = {0.f, 0.f, 0.f, 0.f, 0.f};
        for (int kh = 0; kh < 4; ++kh) {
            float w[32];
#pragma unroll
            for (int j = 0; j < 32; ++j) w[j] = __builtin_nontemporal_load(&p.w_ada[(size_t)(k0 + 32 * kh + j) * 6144 + n]);
#pragma unroll
            for (int j4 = 0; j4 < 8; ++j4)
#pragma unroll
                for (int rr = 0; rr < 5; ++rr) { const f32x4 s = *(const LAS f32x4*)(sil + rr * D + k0 + 32 * kh + 4 * j4); a[rr] += s[0] * w[4 * j4] + s[1] * w[4 * j4 + 1] + s[2] * w[4 * j4 + 2] + s[3] * w[4 * j4 + 3]; }
        }
        float* part = (float*)(p.ws + WS_RAT);
#pragma unroll
        for (int rr = 0; rr < 5; ++rr) __hip_atomic_store(&part[(size_t)(ks * 5 + rr) * 6144 + n], a[rr], __ATOMIC_RELAXED, __HIP_MEMORY_SCOPE_AGENT);
        VM_WAIT();
        unsigned tk = 0; if (lane == 0) tk = __hip_atomic_fetch_add((unsigned*)(p.ws + WS_CTL) + 17408 + cg, 1u, __ATOMIC_RELAXED, __HIP_MEMORY_SCOPE_AGENT);
        tk = __builtin_amdgcn_readfirstlane(tk);
        if (tk == 7u) {
            float* mx = (float*)(p.ws + WS_MX); const float bias = p.b_ada[n];
#pragma unroll
            for (int rr = 0; rr < 5; ++rr) { float sacc = bias;
#pragma unroll
                for (int k2 = 0; k2 < 8; ++k2) sacc += __hip_atomic_load(&part[(size_t)(k2 * 5 + rr) * 6144 + n], __ATOMIC_RELAXED, __HIP_MEMORY_SCOPE_AGENT);
                mx[rr * 6144 + n] = sacc; }
        }
    }
    if (it >= P0_ITEMS) return;
    P0Desc cur = p0_describe(p, it - I_ADA);
    float v[32];
#pragma unroll
    for (int i = 0; i < 32; ++i) v[i] = __builtin_nontemporal_load(&cur.src[(size_t)(2 * i + (lane >> 5)) * cur.N + (lane & 31)]);
    for (;;) {
        const int itn = it + NGW; const bool more = itn < P0_ITEMS;
        P0Desc nxt = cur; float vn[32];
        if (more) { nxt = p0_describe(p, itn - I_ADA);
#pragma unroll
            for (int i = 0; i < 32; ++i) vn[i] = __builtin_nontemporal_load(&nxt.src[(size_t)(2 * i + (lane >> 5)) * nxt.N + (lane & 31)]); }
        const float sc = cur.sc;
#pragma unroll
        for (int i = 0; i < 32; ++i) scr[(2 * i + (lane >> 5)) * 33 + (lane & 31)] = v[i] * sc;
        LDS_WAIT(); asm volatile("" ::: "memory");
        if (cur.f8) {
            const int c = lane & 3;
#pragma unroll
            for (int j = 0; j < 2; ++j) { const int n = (lane >> 2) + 16 * j; const LAS float* s = scr + (16 * c) * 33 + n;
                u32x4 o; o.x = pk4_fp8(s[0 * 33], s[1 * 33], s[2 * 33], s[3 * 33]); o.y = pk4_fp8(s[4 * 33], s[5 * 33], s[6 * 33], s[7 * 33]);
                o.z = pk4_fp8(s[8 * 33], s[9 * 33], s[10 * 33], s[11 * 33]); o.w = pk4_fp8(s[12 * 33], s[13 * 33], s[14 * 33], s[15 * 33]);
                *(u32x4*)(cur.dst + (size_t)RmGen{cur.rmk, cur.roff}(cur.n0 + n) * cur.ldtb + 16 * c) = o; }
        } else {
            const int c = lane & 7;
#pragma unroll
            for (int j = 0; j < 4; ++j) { const int n = (lane >> 3) + 8 * j; const LAS float* s = scr + (8 * c) * 33 + n;
                u32x4 o; o.x = pk2(s[0 * 33], s[1 * 33]); o.y = pk2(s[2 * 33], s[3 * 33]); o.z = pk2(s[4 * 33], s[5 * 33]); o.w = pk2(s[6 * 33], s[7 * 33]);
#ifdef EXP_Q8
                if (cur.rmk == 1 && ((EXP_Q8 >> ((cur.n0 + n) >> 10)) & 1)) {
#define Q8W(x) (__builtin_amdgcn_cvt_f32_fp8(__builtin_amdgcn_cvt_pk_fp8_f32((x) * 32.0f, 0.f, 0, false), 0) * 0.03125f)
                    o.x = pk2(Q8W(s[0 * 33]), Q8W(s[1 * 33])); o.y = pk2(Q8W(s[2 * 33]), Q8W(s[3 * 33])); o.z = pk2(Q8W(s[4 * 33]), Q8W(s[5 * 33])); o.w = pk2(Q8W(s[6 * 33]), Q8W(s[7 * 33])); }
#endif
                *(u32x4*)(cur.dst + (size_t)RmGen{cur.rmk, cur.roff}(cur.n0 + n) * cur.ldtb + 16 * c) = o; }
        }
        LDS_WAIT(); asm volatile("" ::: "memory");
        if (!more) break;
#pragma unroll
        for (int i = 0; i < 32; ++i) v[i] = vn[i];
        cur = nxt; it = itn;
    }
}

__device__ __forceinline__ void p1_row(const float* src, bf16* dst, const f32x4 (&am)[4], const f32x4 (&sh)[4], int lane) {
    f32x4 v[4]; float s = 0.f;
#pragma unroll
    for (int j = 0; j < 4; ++j) { v[j] = *(const f32x4*)(src + 4 * lane + 256 * j); s += (v[j][0] * v[j][0] + v[j][1] * v[j][1]) + (v[j][2] * v[j][2] + v[j][3] * v[j][3]); }
    const float rstd = rsqrtf(wave_sum(s) * (1.0f / D) + EPS);
#pragma unroll
    for (int j = 0; j < 4; ++j) { const f32x4 o = v[j] * rstd * am[j] + sh[j]; u32x2 w; w.x = cvt_pk_bf16(o[0], o[1]); w.y = cvt_pk_bf16(o[2], o[3]); *(u32x2*)(dst + 4 * lane + 256 * j) = w; }
}
__device__ __forceinline__ void p1_mods(const P& p, int b, int lane, f32x4 (&am)[4], f32x4 (&sh)[4]) {
    const float* md = (const float*)(p.ws + WS_MX) + b * 6144;
#pragma unroll
    for (int j = 0; j < 4; ++j) { const int k = 4 * lane + 256 * j; const f32x4 g = *(const f32x4*)(p.norm_mix + k), sc = *(const f32x4*)(md + 1024 + k); am[j] = g * (sc + 1.0f); sh[j] = *(const f32x4*)(md + k); }
}
__device__ __forceinline__ void p1_rows4(const float* src0, bf16* dst0, int r, int rs, int rend, const f32x4 (&am)[4], const f32x4 (&sh)[4], int lane) {
    f32x4 v[4][4]; float s[4];
#pragma unroll
    for (int q = 0; q < 4; ++q) { const int rr = r + q * rs; s[q] = 0.f;
#pragma unroll
        for (int j = 0; j < 4; ++j) v[q][j] = rr < rend ? __builtin_nontemporal_load((const f32x4*)(src0 + (size_t)rr * D + 4 * lane + 256 * j)) : (f32x4){0.f, 0.f, 0.f, 0.f}; }
#pragma unroll
    for (int q = 0; q < 4; ++q) {
#pragma unroll
        for (int j = 0; j < 4; ++j) s[q] += (v[q][j][0] * v[q][j][0] + v[q][j][1] * v[q][j][1]) + (v[q][j][2] * v[q][j][2] + v[q][j][3] * v[q][j][3]); }
#pragma unroll
    for (int o = 1; o < 64; o <<= 1) {
#pragma unroll
        for (int q = 0; q < 4; ++q) s[q] += __shfl_xor(s[q], o); }
#pragma unroll
    for (int q = 0; q < 4; ++q) { const int rr = r + q * rs; if (rr >= rend) continue; const float rstd = rsqrtf(s[q] * (1.0f / D) + EPS); bf16* dst = dst0 + (size_t)rr * PA;
#pragma unroll
        for (int j = 0; j < 4; ++j) { f32x4 o = v[q][j] * rstd * am[j] + sh[j];
#ifdef EXP_Q8
            if (EXP_Q8 & 128) {
#pragma unroll
                for (int e = 0; e < 4; ++e) o[e] = __builtin_amdgcn_cvt_f32_fp8(__builtin_amdgcn_cvt_pk_fp8_f32(o[e], 0.f, 0, false), 0); }
#endif
            u32x2 w; w.x = cvt_pk_bf16(o[0], o[1]); w.y = cvt_pk_bf16(o[2], o[3]); *(u32x2*)(dst + 4 * lane + 256 * j) = w; } }
}
__device__ __forceinline__ void p1_rows(Frame& F) {
    const P& p = F.p; const int lane = F.lane;
    const int gw = F.vcu * NWAVES + F.wave, NGW = F.G * NWAVES;
    f32x4 am[4], sh[4];
    for (int b = 0; b < NB; ++b) {
        p1_mods(p, b, lane, am, sh);
        for (int r = gw; r < SEQ; r += 4 * NGW) p1_rows4(p.x + (size_t)b * SEQ * D, (bf16*)(p.ws + WS_HXP) + (size_t)b * SEQ * PA, r, NGW, SEQ, am, sh, lane);
    }
    p1_mods(p, 4, lane, am, sh);
    for (int r = gw; r < MC; r += 4 * NGW) p1_rows4(p.ctx, (bf16*)(p.ws + WS_HC), r, NGW, MC, am, sh, lane);
}
__device__ __forceinline__ void p1_ctx_rows(Frame& F, int pm) {
    const P& p = F.p; const int lane = F.lane; f32x4 am[4], sh[4];
    p1_mods(p, 4, lane, am, sh);
    for (int r0 = pm * 256 + F.wave * 32; r0 < pm * 256 + F.wave * 32 + 32; r0 += 4) {
        f32x4 v[4][4]; float s[4];
#pragma unroll
        for (int r = 0; r < 4; ++r) { const float* src = p.ctx + (size_t)(r0 + r) * D; s[r] = 0.f;
#pragma unroll
            for (int j = 0; j < 4; ++j) v[r][j] = *(const f32x4*)(src + 4 * lane + 256 * j); }
#pragma unroll
        for (int r = 0; r < 4; ++r) {
#pragma unroll
            for (int j = 0; j < 4; ++j) s[r] += (v[r][j][0] * v[r][j][0] + v[r][j][1] * v[r][j][1]) + (v[r][j][2] * v[r][j][2] + v[r][j][3] * v[r][j][3]); }
#pragma unroll
        for (int o = 1; o < 64; o <<= 1) {
#pragma unroll
            for (int r = 0; r < 4; ++r) s[r] += __shfl_xor(s[r], o); }
#pragma unroll
        for (int r = 0; r < 4; ++r) { const float rstd = rsqrtf(s[r] * (1.0f / D) + EPS); bf16* dst = (bf16*)(p.ws + WS_HC) + (size_t)(r0 + r) * PA;
#pragma unroll
            for (int j = 0; j < 4; ++j) { const f32x4 o = v[r][j] * rstd * am[j] + sh[j]; u32x2 w; w.x = cvt_pk_bf16(o[0], o[1]); w.y = cvt_pk_bf16(o[2], o[3]); *(u32x2*)(dst + 4 * lane + 256 * j) = w; } }
    }
}

__device__ __forceinline__ unsigned dpp_max_u32(unsigned x) {
    x = max(x, (unsigned)__builtin_amdgcn_update_dpp(0, (int)x, 0xB1, 0xF, 0xF, false));
    x = max(x, (unsigned)__builtin_amdgcn_update_dpp(0, (int)x, 0x4E, 0xF, 0xF, false));
    x = max(x, (unsigned)__builtin_amdgcn_update_dpp(0, (int)x, 0x141, 0xF, 0xF, false));
    x = max(x, (unsigned)__builtin_amdgcn_update_dpp(0, (int)x, 0x140, 0xF, 0xF, false));
    return x;
}
__device__ __forceinline__ unsigned rkey(float v, int e) { unsigned u = __float_as_uint(v); u = (u & 0x80000000u) ? ~u : (u | 0x80000000u); return (u & ~31u) | (unsigned)(31 - e); }
__device__ __forceinline__ float rkey_val(unsigned k) { const unsigned u = k & ~31u; return __uint_as_float((u & 0x80000000u) ? (u & 0x7fffffffu) : ~u); }
__device__ __forceinline__ void p6_route(Frame& F) {
    const P& p = F.p; const int tid = F.tid, lane = F.lane, wave = F.wave;
    LAS unsigned char* WH = F.lds; LAS unsigned char* WL = F.lds + 65536;
    for (int i = tid; i < 8192; i += NTHR) *(LAS u32x4*)(F.lds + i * 16) = *(const u32x4*)(p.ws + WS_RTAB + (size_t)i * 16);
    LAS int* cntl = (LAS int*)(F.lds + AUX_OFF);
    LAS int* basel = cntl + 32;
    LAS int* sel_e = cntl + 64; LAS int* sel_r = sel_e + 512; LAS float* sel_g = (LAS float*)(sel_r + 512);
    LAS f32x4* amsh = (LAS f32x4*)(F.lds + AUX_OFF + 8192);
    unsigned* gcnt = (unsigned*)(p.ws + WS_CTL) + CW_CNT;
    const float* mxall = (const float*)(p.ws + WS_MX);
    for (int rg = F.vcu; rg < M / 128; rg += F.G) {
        int tv = F.tid; asm volatile("" : "+v"(tv));
        const int lv = tv & 63;
        __syncthreads();
        if (tv < 32) cntl[tv] = 0;
        const int b = (rg * 128) / SEQ; const float* md = mxall + b * 6144;
        if (wave == 0) {
#pragma unroll
            for (int j = 0; j < 4; ++j) { const int k = 4 * lv + 256 * j; const f32x4 g = *(const f32x4*)(p.norm_ffn + k), sc = *(const f32x4*)(md + 4 * 1024 + k); amsh[j * 64 + lv] = g * (sc + 1.0f); amsh[(4 + j) * 64 + lv] = *(const f32x4*)(md + 3 * 1024 + k); }
        }
        __syncthreads();
        const int row0 = rg * 128 + wave * 16;
        const int er = lv & 15, rq = lv >> 4;
        u32x4 xv[32];
        { const bf16* xr = (const bf16*)(p.ws + WS_X1) + (size_t)(row0 + er) * D + 8 * rq;
#pragma unroll
          for (int s_ = 0; s_ < 32; ++s_) xv[s_] = __builtin_nontemporal_load((const u32x4*)(xr + 32 * s_)); }
        float ss0 = 0.f, ss1 = 0.f;
#pragma unroll
        for (int s_ = 0; s_ < 32; ++s_) { const u32x4 w = xv[s_];
            ss0 += (bflo(w.x) * bflo(w.x) + bfhi(w.x) * bfhi(w.x)) + (bflo(w.y) * bflo(w.y) + bfhi(w.y) * bfhi(w.y));
            ss1 += (bflo(w.z) * bflo(w.z) + bfhi(w.z) * bfhi(w.z)) + (bflo(w.w) * bflo(w.w) + bfhi(w.w) * bfhi(w.w)); }
#pragma unroll
        for (int s_ = 0; s_ < 32; ++s_) asm volatile("" : "+v"(xv[s_]));
        float ssq = ss0 + ss1; ssq += __shfl_xor(ssq, 16); ssq += __shfl_xor(ssq, 32);
        const float rstd = rsqrtf(ssq * (1.0f / D) + EPS);
        { const LAS float* amf = (const LAS float*)amsh; unsigned char* fx8 = p.ws + WS_FX8 + (size_t)(row0 + er) * D + 8 * rq;
#pragma unroll
          for (int s_ = 0; s_ < 32; ++s_) { const int k = 32 * s_ + 8 * rq; const u32x4 w = xv[s_];
            const f32x4 am0 = *(const LAS f32x4*)(amf + k), am1 = *(const LAS f32x4*)(amf + k + 4), sh0 = *(const LAS f32x4*)(amf + 1024 + k), sh1 = *(const LAS f32x4*)(amf + 1024 + k + 4);
            const f32x4 o0 = (f32x4){bflo(w.x), bfhi(w.x), bflo(w.y), bfhi(w.y)} * rstd * am0 + sh0, o1 = (f32x4){bflo(w.z), bfhi(w.z), bflo(w.w), bfhi(w.w)} * rstd * am1 + sh1;
            xv[s_] = (u32x4){cvt_pk_bf16(o0[0], o0[1]), cvt_pk_bf16(o0[2], o0[3]), cvt_pk_bf16(o1[0], o1[1]), cvt_pk_bf16(o1[2], o1[3])};
            u32x2 q8; q8.x = pk4_fp8(o0[0], o0[1], o0[2], o0[3]); q8.y = pk4_fp8(o1[0], o1[1], o1[2], o1[3]);
            *(u32x2*)(fx8 + 32 * s_) = q8; asm volatile("" ::: "memory"); } }
        f32x4 a0 = (f32x4){0.f, 0.f, 0.f, 0.f}, a1 = a0, a2 = a0, a3 = a0;
        const int cb = er * 2048 + ((((er & 12) | (rq ^ (er & 3)))) << 4);
#pragma unroll
        for (int sI = 0; sI < 32; ++sI) { const int co = cb ^ (sI << 6); const bf16x8 af = (bf16x8)xv[sI];
            const bf16x8 h0 = *(const LAS bf16x8*)(WH + co), l0 = *(const LAS bf16x8*)(WL + co);
            const bf16x8 h1 = *(const LAS bf16x8*)(WH + 32768 + co), l1 = *(const LAS bf16x8*)(WL + 32768 + co);
            a0 = __builtin_amdgcn_mfma_f32_16x16x32_bf16(af, h0, a0, 0, 0, 0); a2 = __builtin_amdgcn_mfma_f32_16x16x32_bf16(af, l0, a2, 0, 0, 0);
            a1 = __builtin_amdgcn_mfma_f32_16x16x32_bf16(af, h1, a1, 0, 0, 0); a3 = __builtin_amdgcn_mfma_f32_16x16x32_bf16(af, l1, a3, 0, 0, 0);
            if ((sI & 3) == 3) asm volatile("" ::: "memory"); }
        a0 += a2; a1 += a3;
        const float rb0 = p.router_b[er], rb1 = p.router_b[16 + er];
#pragma unroll
        for (int i = 0; i < 4; ++i) {
            unsigned k0 = rkey(a0[i] + rb0, er), k1 = rkey(a1[i] + rb1, 16 + er), wk[TOPK];
#pragma unroll
            for (int t = 0; t < TOPK; ++t) { const unsigned m = dpp_max_u32(max(k0, k1)); wk[t] = m; k0 = (k0 == m) ? 0u : k0; k1 = (k1 == m) ? 0u : k1; }
            const float v0 = rkey_val(wk[0]); float ex[TOPK], se = 0.f;
#pragma unroll
            for (int t = 0; t < TOPK; ++t) { ex[t] = __expf(rkey_val(wk[t]) - v0); se += ex[t]; }
            const float inv = 1.0f / se;
            if (er < TOPK) { const unsigned w_ = er == 0 ? wk[0] : er == 1 ? wk[1] : er == 2 ? wk[2] : wk[3]; const float g = (er == 0 ? ex[0] : er == 1 ? ex[1] : er == 2 ? ex[2] : ex[3]) * inv;
                const int e = 31 - (int)(w_ & 31u), rl = wave * 16 + 4 * rq + i;
                const int rank = __hip_atomic_fetch_add((int*)&cntl[e], 1, __ATOMIC_RELAXED, __HIP_MEMORY_SCOPE_WORKGROUP); sel_e[rl * 4 + er] = e; sel_r[rl * 4 + er] = rank; sel_g[rl * 4 + er] = g; }
        }
        __syncthreads();
        if (tv < 32) basel[tv] = (int)atomicAdd(&gcnt[tv], (unsigned)cntl[tv]);
        __syncthreads();
        { const int rl = tv >> 2, t = tv & 3, row = rg * 128 + rl, e = sel_e[tv], slot = basel[e] + sel_r[tv];
          ((int*)(p.ws + WS_TOK))[(size_t)e * M + slot] = row; ((float*)(p.ws + WS_GATE))[(size_t)e * M + slot] = sel_g[tv]; ((int*)(p.ws + WS_INV))[(size_t)row * 4 + t] = e * M + slot; }
    }
    __syncthreads();
}

__device__ __forceinline__ void p9_final(Frame& F) {
    const P& p = F.p; const int lane = F.lane;
    LAS int* tab = (LAS int*)(F.lds + AUX_OFF);
    moe_tables(tab, (const unsigned*)(p.ws + WS_CTL) + CW_CNT, 1);
    const int gw = F.vcu * NWAVES + F.wave, NGW = F.G * NWAVES, b = gw & 3;
    const float* gp = (const float*)(p.ws + WS_MX) + b * 6144 + 5 * 1024;
    f32x4 g[4], nf[4];
#pragma unroll
    for (int j = 0; j < 4; ++j) { const int k = 8 * lane + 512 * (j >> 1) + 4 * (j & 1); g[j] = *(const f32x4*)(gp + k); nf[j] = *(const f32x4*)(p.norm_final + k); }
    const int rs = NGW >> 2;
    for (int r = gw >> 2; r < SEQ; r += 2 * rs) {
        int4 iv[2]; bool ok[2];
#pragma unroll
        for (int q = 0; q < 2; ++q) { const int rr = r + q * rs; ok[q] = rr < SEQ; iv[q] = *(const int4*)((const int*)(p.ws + WS_INV) + (size_t)(b * SEQ + (ok[q] ? rr : r)) * 4); }
        u32x2 ow[2][TOPK][2]; u32x4 xw[2][2];
#pragma unroll
        for (int q = 0; q < 2; ++q) { const int row = b * SEQ + (ok[q] ? r + q * rs : r); const int ivs[4] = {iv[q].x, iv[q].y, iv[q].z, iv[q].w};
#pragma unroll
            for (int t = 0; t < TOPK; ++t) { const int e = ivs[t] >> 15, slot = ivs[t] & (M - 1); const unsigned char* op = p.ws + WS_OUTP + (size_t)(tab[65 + e] + slot) * D;
#pragma unroll
                for (int h = 0; h < 2; ++h) ow[q][t][h] = __builtin_nontemporal_load((const u32x2*)(op + 8 * lane + 512 * h)); }
            const bf16* x1 = (const bf16*)(p.ws + WS_X1) + (size_t)row * D;
#pragma unroll
            for (int h = 0; h < 2; ++h) xw[q][h] = __builtin_nontemporal_load((const u32x4*)(x1 + 8 * lane + 512 * h)); }
#pragma unroll
        for (int q = 0; q < 2; ++q) { if (!ok[q]) continue; const int row = b * SEQ + r + q * rs;
            f32x4 y[4];
#pragma unroll
            for (int j = 0; j < 4; ++j) y[j] = (f32x4){0.f, 0.f, 0.f, 0.f};
#pragma unroll
            for (int t = 0; t < TOPK; ++t)
#pragma unroll
                for (int h = 0; h < 2; ++h) { const u32x2 w = ow[q][t][h];
                    y[2 * h] += (f32x4){__builtin_amdgcn_cvt_f32_fp8((int)w.x, 0), __builtin_amdgcn_cvt_f32_fp8((int)w.x, 1), __builtin_amdgcn_cvt_f32_fp8((int)w.x, 2), __builtin_amdgcn_cvt_f32_fp8((int)w.x, 3)};
                    y[2 * h + 1] += (f32x4){__builtin_amdgcn_cvt_f32_fp8((int)w.y, 0), __builtin_amdgcn_cvt_f32_fp8((int)w.y, 1), __builtin_amdgcn_cvt_f32_fp8((int)w.y, 2), __builtin_amdgcn_cvt_f32_fp8((int)w.y, 3)}; }
            float* xo = p.out + (size_t)row * D; f32x4 v[4]; float s = 0.f;
#pragma unroll
            for (int h = 0; h < 2; ++h) { const u32x4 w = xw[q][h];
                v[2 * h] = (f32x4){bflo(w.x), bfhi(w.x), bflo(w.y), bfhi(w.y)} + g[2 * h] * y[2 * h]; v[2 * h + 1] = (f32x4){bflo(w.z), bfhi(w.z), bflo(w.w), bfhi(w.w)} + g[2 * h + 1] * y[2 * h + 1]; }
#pragma unroll
            for (int j = 0; j < 4; ++j) s += (v[j][0] * v[j][0] + v[j][1] * v[j][1]) + (v[j][2] * v[j][2] + v[j][3] * v[j][3]);
            const float rstd = rsqrtf(wave_sum(s) * (1.0f / D) + EPS);
#pragma unroll
            for (int j = 0; j < 4; ++j) { const int k = 8 * lane + 512 * (j >> 1) + 4 * (j & 1); __builtin_nontemporal_store(v[j] * rstd * nf[j], (f32x4*)(xo + k)); }
        }
    }
}
constexpr int TC = 32, NCTXC = CTX / TC, NCH = NCTXC + SEQ / TC;
constexpr int P3_UPITCH = 128, P3_UBUF = 5120, P3_VOFF = 2 * P3_UBUF, P3_VPITCH = 144, P3_WAVE_LDS = P3_VOFF + 4608;
constexpr int P3_WG = 8 * P3_WAVE_LDS, P3_WPITCH = 144, P3_CW = P3_WG + 256 * P3_WPITCH, P3_GB = P3_CW + 2560;
static_assert(P3_VOFF + TC * P3_VPITCH <= P3_WAVE_LDS && P3_GB + 1536 <= RING_BYTES + AUX_BYTES, "P3 LDS map");
constexpr size_t WS_SUMG = WS_HX;
constexpr size_t WS_CARRY = WS_HX + 32 * MiB;
struct Comp { float P, Q; };
__device__ __forceinline__ Comp comp_then(const Comp& e, const Comp& l) { return Comp{e.P * l.P, l.P * e.Q + l.Q}; }

__device__ __forceinline__ void p3_tables(Frame& F, int blk) {
    const P& p = F.p; LAS unsigned char* lds = F.lds; const int tid = F.tid;
    __syncthreads();
    for (int i = tid; i < 2 * 128 * 8; i += NTHR) { const int ck = i & 7, n = (i >> 3) & 127, d = i >> 10;
        *(LAS u32x4*)(lds + P3_WG + (d * 128 + n) * P3_WPITCH + (ck << 4)) = *(const u32x4*)((const bf16*)(p.ws + WS_WG) + ((size_t)(d * 16 + blk) * 128 + n) * 64 + ck * 8); }
    for (int i = tid; i < 2 * 5 * 64; i += NTHR) { const int c = i & 63, t = (i >> 6) % 5, d = i / 320;
        *(LAS float*)(lds + P3_CW + i * 4) = t < 4 ? p.lru_conv_w[(size_t)(d * 4 + (d ? 3 - t : t)) * D + blk * 64 + c] : p.lru_conv_b[d * D + blk * 64 + c]; }
    for (int i = tid; i < 2 * 3 * 64; i += NTHR) { const int c = i & 63, k = (i >> 6) % 3, d = i / 192, g = d * D + blk * 64 + c;
        *(LAS float*)(lds + P3_GB + i * 4) = k == 0 ? -1.4426950408889634f * p.lru_ba[g] : k == 1 ? -1.4426950408889634f * p.lru_bx[g] : 1.4426950408889634f * -8.0f * log1pf(__expf(-p.lru_lambda[g])); }
    LDS_WAIT(); __syncthreads();
}
__device__ __forceinline__ void p3_tile_dma(const P& p, LAS unsigned char* ub, int b, int blk, int nat, int lane) {
    const bool isctx = nat < NCTXC; const int t0 = (isctx ? nat : nat - NCTXC) * TC, L = isctx ? CTX : SEQ;
    const bf16* U = (isctx ? (const bf16*)(p.ws + WS_CS3) + (size_t)b * CTX * D : (const bf16*)(p.ws + WS_ULRU) + (size_t)b * SEQ * D) + blk * 64;
    const bf16* Zp = (const bf16*)(p.ws + WS_ZERO);
#pragma unroll
    for (int i = 0; i < 5; ++i) { const int idx = lane + 64 * i, r = idx >> 3, c = idx & 7, t = t0 - 3 + r; const bf16* src = (t >= 0 && t < L) ? U + (size_t)t * D + c * 8 : Zp;
        __builtin_amdgcn_global_load_lds((const unsigned*)src, (LAS unsigned*)(ub + i * 1024), 16, 0, 0); }
}
template <int PASS, int V = 0>
__device__ __forceinline__ void p3_chunk(Frame& F, int lane, LAS unsigned char* wl, LAS unsigned char* ub, int d, Comp (&tot)[4], const float (&cin)[4], unsigned (&hpk)[2][4][2]) {
    LAS unsigned char* lds = F.lds; const int ch = lane & 15, qd = lane >> 4;
#define TEXP(x) ((V & 1) ? ((x) * 0.5f + 1.0f) : __builtin_amdgcn_exp2f(x))
#define TRCP(x) ((V & 1) ? ((x) * 0.25f) : __builtin_amdgcn_rcpf(x))
#define TSQRT(x) ((V & 1) ? ((x) * 0.5f) : __builtin_amdgcn_sqrtf(x))
    if (!(V & 8)) {
        const int cc = lane & 7, tg = lane >> 3, ro = d ? 3 : 0;
        u32x4 ur[7];
#pragma unroll
        for (int r = 0; r < 7; ++r) ur[r] = *(const LAS u32x4*)(ub + (4 * tg + ro + r) * P3_UPITCH + cc * 16);
        f32x4 cwv[5][2];
#pragma unroll
        for (int t = 0; t < 5; ++t) { cwv[t][0] = *(const LAS f32x4*)(lds + P3_CW + ((d * 5 + t) * 64 + cc * 8) * 4); cwv[t][1] = *(const LAS f32x4*)(lds + P3_CW + ((d * 5 + t) * 64 + cc * 8 + 4) * 4); }
#pragma unroll
        for (int i = 0; i < 4; ++i) {
            f32x4 v0 = cwv[4][0], v1 = cwv[4][1];
#pragma unroll
            for (int t = 0; t < 4; ++t) { const u32x4 w = ur[i + t];
                v0 += cwv[t][0] * (f32x4){bflo(w.x), bfhi(w.x), bflo(w.y), bfhi(w.y)}; v1 += cwv[t][1] * (f32x4){bflo(w.z), bfhi(w.z), bflo(w.w), bfhi(w.w)}; }
            const int tl = 4 * tg + i, s = d ? TC - 1 - tl : tl;
            u32x4 o; o.x = cvt_pk_bf16(v0[0], v0[1]); o.y = cvt_pk_bf16(v0[2], v0[3]); o.z = cvt_pk_bf16(v1[0], v1[1]); o.w = cvt_pk_bf16(v1[2], v1[3]);
            *(LAS u32x4*)(wl + P3_VOFF + s * P3_VPITCH + (cc << 4)) = o;
        }
        LDS_WAIT();
    }
    float hrun[4];
#pragma unroll
    for (int n = 0; n < 4; ++n) { tot[n] = Comp{1.f, 0.f}; hrun[n] = cin[n]; }
#pragma unroll
    for (int m = 0; m < 2; ++m) {
        const int sa = 16 * m + (lane & 15);
        bf16x8 af[2];
#pragma unroll
        for (int kk = 0; kk < 2; ++kk) af[kk] = *(const LAS bf16x8*)(wl + P3_VOFF + sa * P3_VPITCH + ((kk * 4 + qd) << 4));
#pragma unroll
        for (int np = 0; np < 4; np += 2) {
            f32x4 ar[2], ai[2]; int nr[2]; f32x2 ba, bx, c1;
#pragma unroll
            for (int q = 0; q < 2; ++q) { const int n = np + q; nr[q] = n * 16 + ch; ar[q] = (f32x4){0.f, 0.f, 0.f, 0.f}; ai[q] = ar[q];
#pragma unroll
                for (int kk = 0; kk < 2; ++kk) { const int co = ((kk * 4 + qd) << 4);
                    const bf16x8 wa = *(const LAS bf16x8*)(lds + P3_WG + (d * 128 + nr[q]) * P3_WPITCH + co), wx = *(const LAS bf16x8*)(lds + P3_WG + (d * 128 + 64 + nr[q]) * P3_WPITCH + co);
                    ar[q] = __builtin_amdgcn_mfma_f32_16x16x32_bf16(af[kk], wa, ar[q], 0, 0, 0); ai[q] = __builtin_amdgcn_mfma_f32_16x16x32_bf16(af[kk], wx, ai[q], 0, 0, 0); }
                ba[q] = *(const LAS float*)(lds + P3_GB + ((d * 3 + 0) * 64 + nr[q]) * 4); bx[q] = *(const LAS float*)(lds + P3_GB + ((d * 3 + 1) * 64 + nr[q]) * 4); c1[q] = *(const LAS float*)(lds + P3_GB + ((d * 3 + 2) * 64 + nr[q]) * 4); }
            f32x2 Pi[4], Qi[4]; f32x2 Pl = (f32x2){1.f, 1.f}, Ql = (f32x2){0.f, 0.f};
#pragma unroll
            for (int i = 0; i < 4; ++i) {
                const int s = 16 * m + 4 * qd + i;
                const f32x2 v = (f32x2){bf2f(*(const LAS bf16*)(wl + P3_VOFF + s * P3_VPITCH + nr[0] * 2)), bf2f(*(const LAS bf16*)(wl + P3_VOFF + s * P3_VPITCH + nr[1] * 2))};
                const f32x2 tr = (f32x2){ar[0][i], ar[1][i]} + ba, ti = (f32x2){ai[0][i], ai[1][i]} + bx;
                const f32x2 er = (f32x2){TEXP(tr.x), TEXP(tr.y)} + 1.0f, ei = (f32x2){TEXP(ti.x), TEXP(ti.y)} + 1.0f;
                const f32x2 r = (f32x2){TRCP(er.x), TRCP(er.y)}, ig = (f32x2){TRCP(ei.x), TRCP(ei.y)};
                const f32x2 la = c1 * r; const f32x2 a = (f32x2){TEXP(la.x), TEXP(la.y)};
                const f32x2 om = 1.0f - a * a; const f32x2 bq = (f32x2){TSQRT(om.x), TSQRT(om.y)} * (ig * v);
#ifdef EXP_P3TRANS
                { const f32x2 d1 = (f32x2){__builtin_amdgcn_exp2f(la.x - 1.0f), __builtin_amdgcn_exp2f(la.y - 1.0f)}, d2 = (f32x2){__builtin_amdgcn_rcpf(er.x + 1.0f), __builtin_amdgcn_rcpf(er.y + 1.0f)}, d3 = (f32x2){__builtin_amdgcn_sqrtf(om.x + 1.0f), __builtin_amdgcn_sqrtf(om.y + 1.0f)};
                  Ql = Ql + 0.0f * (d1 + d2 + d3); }
#endif
                Ql = a * Ql + bq; Pl = Pl * a; Pi[i] = Pl; Qi[i] = Ql;
            }
            const f32x2 oP = (V & 2) ? Pl : (f32x2){__shfl_xor(Pl.x, 16), __shfl_xor(Pl.y, 16)}, oQ = (V & 2) ? Ql : (f32x2){__shfl_xor(Ql.x, 16), __shfl_xor(Ql.y, 16)};
            const bool odd = (qd & 1) != 0, hi = (qd & 2) != 0;
            const f32x2 eP = odd ? oP : Pl, eQ = odd ? oQ : Ql, lP = odd ? Pl : oP, lQ = odd ? Ql : oQ;
            const f32x2 pP = eP * lP, pQ = lP * eQ + lQ;
            const f32x2 qP = (V & 2) ? pP : (f32x2){__shfl_xor(pP.x, 32), __shfl_xor(pP.y, 32)}, qQ = (V & 2) ? pQ : (f32x2){__shfl_xor(pQ.x, 32), __shfl_xor(pQ.y, 32)};
            const f32x2 e2P = hi ? qP : pP, e2Q = hi ? qQ : pQ, l2P = hi ? pP : qP, l2Q = hi ? pQ : qQ;
            const f32x2 tP = e2P * l2P, tQ = l2P * e2Q + l2Q;
            if (PASS == 1) {
#pragma unroll
                for (int q = 0; q < 2; ++q) { const int n = np + q; tot[n] = Comp{tot[n].P * tP[q], tP[q] * tot[n].Q + tQ[q]}; }
            } else {
                const f32x2 xP = qd == 0 ? (f32x2){1.f, 1.f} : qd == 1 ? oP : qd == 2 ? qP : qP * oP, xQ = qd == 0 ? (f32x2){0.f, 0.f} : qd == 1 ? oQ : qd == 2 ? qQ : oP * qQ + oQ;
                const f32x2 hr = (f32x2){hrun[np], hrun[np + 1]}; const f32x2 hs = xP * hr + xQ;
                f32x2 h[4];
#pragma unroll
                for (int i = 0; i < 4; ++i) h[i] = Pi[i] * hs + Qi[i];
                const f32x2 hn = tP * hr + tQ; hrun[np] = hn.x; hrun[np + 1] = hn.y;
#pragma unroll
                for (int q = 0; q < 2; ++q) { const int n = np + q;
                    if (d == 1) { hpk[m][n][0] = cvt_pk_bf16(h[0][q], h[1][q]); hpk[m][n][1] = cvt_pk_bf16(h[2][q], h[3][q]); }
                    else {
                        const unsigned m0 = __shfl_xor(hpk[1 - m][n][0], 48), m1 = __shfl_xor(hpk[1 - m][n][1], 48);
                        const float hb[4] = {bfhi(m1), bflo(m1), bfhi(m0), bflo(m0)};
#pragma unroll
                        for (int i = 0; i < 4; ++i) { const int s = 16 * m + 4 * qd + i;
                            *(LAS bf16*)(wl + P3_VOFF + s * P3_VPITCH + nr[q] * 2) = (bf16)cvt_pk_bf16(h[i][q] + hb[i], 0.f); }
                    }
                }
            }
        }
    }
}
constexpr int CV_W1 = NE * 32 * 64, CV_ITEMS = CV_W1 + NE * 32 * 32;
struct CvJob { const float* src; unsigned char* dst; int N, n0, w1; };
__device__ __forceinline__ CvJob cv32_job(const P& p, int idx) {
    CvJob j;
    if (idx < CV_W1) { const int e = idx >> 11, l = idx & 2047, kb = l >> 6, nb = l & 63; j.N = 2048; j.src = p.w1 + (size_t)e * D * 2048 + (size_t)(32 * kb) * 2048 + 32 * nb; j.dst = p.ws + WS_W1 + (size_t)e * 2048 * D + 32 * kb; j.n0 = 32 * nb; j.w1 = 1; }
    else { const int r = idx - CV_W1, e = r >> 10, l = r & 1023, kb = l >> 5, nb = l & 31; j.N = D; j.src = p.w2 + (size_t)e * DE * D + (size_t)(32 * kb) * D + 32 * nb; j.dst = p.ws + WS_W2 + (size_t)e * D * DE + 32 * kb; j.n0 = 32 * nb; j.w1 = 0; }
    return j;
}
__device__ __forceinline__ void cv32_issue(const CvJob& j, int lane, float (&v)[16]) {
#pragma unroll
    for (int i = 0; i < 16; ++i) v[i] = __builtin_nontemporal_load(&j.src[(size_t)(2 * i + (lane >> 5)) * j.N + (lane & 31)]);
}
__device__ __forceinline__ void cv32_finish(const CvJob& j, int lane, const float (&v)[16], LAS float* scr) {
#pragma unroll
    for (int i = 0; i < 16; ++i) scr[(2 * i + (lane >> 5)) * 33 + (lane & 31)] = v[i] * 32.0f;
    LDS_WAIT(); asm volatile("" ::: "memory");
    const int c = lane & 1, n = lane >> 1; const LAS float* s = scr + (16 * c) * 33 + n;
    u32x4 o; o.x = pk4_fp8(s[0 * 33], s[1 * 33], s[2 * 33], s[3 * 33]); o.y = pk4_fp8(s[4 * 33], s[5 * 33], s[6 * 33], s[7 * 33]);
    o.z = pk4_fp8(s[8 * 33], s[9 * 33], s[10 * 33], s[11 * 33]); o.w = pk4_fp8(s[12 * 33], s[13 * 33], s[14 * 33], s[15 * 33]);
    const int nn = j.n0 + n, row = j.w1 ? 256 * ((nn >> 1) >> 7) + 128 * (nn & 1) + ((nn >> 1) & 127) : nn;
    *(u32x4*)(j.dst + (size_t)row * D + 16 * c) = o;
    LDS_WAIT(); asm volatile("" ::: "memory");
}
struct GcLoads { u32x4 um, u0, up, gb; };
__device__ __forceinline__ void gc_issue(const P& p, int c, int lane, GcLoads& g) {
    const int m = c >> 1, h = c & 1, c8 = 512 * h + 8 * lane, off = h ? GW : 1, tb = m & (SEQ - 1), row = tb >> 6, col = tb & 63;
    const bool okm = h ? row > 0 : col > 0, okp = h ? row < GROWS - 1 : col < GW - 1;
    const bf16* U = (const bf16*)(p.ws + WS_U) + c8; const u32x4 z4 = (u32x4){0u, 0u, 0u, 0u};
    g.um = z4; g.up = z4;
    if (okm) g.um = *(const u32x4*)(U + (size_t)(m - off) * D);
    g.u0 = *(const u32x4*)(U + (size_t)m * D);
    if (okp) g.up = *(const u32x4*)(U + (size_t)(m + off) * D);
    g.gb = __builtin_nontemporal_load((const u32x4*)((const bf16*)(p.ws + WS_GB) + (size_t)m * D + c8));
}
__device__ __forceinline__ void gc_finish(const P& p, int c, int lane, const GcLoads& g) {
    const int m = c >> 1, c8 = 512 * (c & 1) + 8 * lane;
    f32x4 w[3][2];
#pragma unroll
    for (int k = 0; k < 3; ++k) { w[k][0] = *(const f32x4*)(p.conv_a_w + k * D + c8); w[k][1] = *(const f32x4*)(p.conv_a_w + k * D + c8 + 4); }
    const unsigned um_[4] = {g.um.x, g.um.y, g.um.z, g.um.w}, u0_[4] = {g.u0.x, g.u0.y, g.u0.z, g.u0.w}, up_[4] = {g.up.x, g.up.y, g.up.z, g.up.w}, gb_[4] = {g.gb.x, g.gb.y, g.gb.z, g.gb.w};
    unsigned o[4];
#pragma unroll
    for (int j = 0; j < 4; ++j) { const int q = j >> 1, e0 = 2 * (j & 1);
        const float lo = (w[0][q][e0] * bflo(um_[j]) + w[1][q][e0] * bflo(u0_[j]) + w[2][q][e0] * bflo(up_[j])) * bflo(gb_[j]);
        const float hi = (w[0][q][e0 + 1] * bfhi(um_[j]) + w[1][q][e0 + 1] * bfhi(u0_[j]) + w[2][q][e0 + 1] * bfhi(up_[j])) * bfhi(gb_[j]);
        o[j] = cvt_pk_bf16(lo, hi); }
    *(u32x4*)((bf16*)(p.ws + WS_Z) + (size_t)m * 2048 + c8) = (u32x4){o[0], o[1], o[2], o[3]};
}
constexpr int GC_ITEMS = 2 * M;
template <int PV = 0>
__device__ __forceinline__ void p3a_summaries(Frame& F) {
    const P& p = F.p; const int lane = F.lane, ch = lane & 15, qd = lane >> 4;
    if (F.G < 16) return;
    const int blk = F.vcu & 15, bpb = F.G >> 4, bidx = F.vcu >> 4;
    p3_tables(F, blk);
    LAS unsigned char* wl = F.lds + F.wave * P3_WAVE_LDS;
    const float cin[4] = {0.f, 0.f, 0.f, 0.f}; unsigned hpk[2][4][2];
    const int jstep = bpb * NWAVES, NJ = NB * 2 * NCH;
    int j = bidx * NWAVES + F.wave, ubi = 0;
    const int cvstep = F.G * NWAVES, cvend = CV_ITEMS / 3; int cvi = (int)blockIdx.x * NWAVES + F.wave, gci = cvi;
    constexpr bool nobg = (PV & 16) != 0;
    if (nobg) { cvi = cvend; gci = GC_ITEMS; }
    if (j < NJ) p3_tile_dma(p, wl, (j >> 1) & 3, blk, j >> 3, lane);
    for (; j < NJ; j += jstep, ubi ^= 1) {
        const int d = j & 1, b = (j >> 1) & 3, nat = j >> 3; Comp tot[4];
        int lv = lane; asm volatile("" : "+v"(lv));
        VM_WAIT();
        const int jn = j + jstep;
        if (jn < NJ) p3_tile_dma(p, wl + (ubi ^ 1) * P3_UBUF, (jn >> 1) & 3, blk, jn >> 3, lv);
        CvJob cj[1]; float cvv[1][16]; bool cvon[1]; GcLoads gl[2]; int gcc[2];
#pragma unroll
        for (int q = 0; q < 1; ++q) { cvon[q] = cvi < cvend && !nobg; if (cvon[q]) { cj[q] = cv32_job(p, cvi); cv32_issue(cj[q], lv, cvv[q]); cvi += cvstep; } }
#pragma unroll
        for (int q = 0; q < 2; ++q) { gcc[q] = (gci < GC_ITEMS && !nobg) ? gci : -1; if (gcc[q] >= 0) { gc_issue(p, gcc[q], lv, gl[q]); gci += cvstep; } }
        p3_chunk<1, (PV & 15)>(F, lv, wl, wl + ubi * P3_UBUF, d, tot, cin, hpk);
#pragma unroll
        for (int q = 0; q < 1; ++q) if (cvon[q]) cv32_finish(cj[q], lv, cvv[q], (LAS float*)(wl + P3_VOFF));
#pragma unroll
        for (int q = 0; q < 2; ++q) if (gcc[q] >= 0) gc_finish(p, gcc[q], lv, gl[q]);
        if ((lv >> 4) == 0) { f32x2* sg = (f32x2*)(p.ws + WS_SUMG) + ((size_t)((b * 2 + d) * NCH + nat)) * D + blk * 64 + (lv & 15);
#pragma unroll
            for (int n = 0; n < 4; ++n) sg[n * 16] = (f32x2){tot[n].P, tot[n].Q}; }
    }
    for (; cvi < cvend; cvi += cvstep) { const CvJob jb = cv32_job(p, cvi); float v[16]; cv32_issue(jb, lane, v); cv32_finish(jb, lane, v, (LAS float*)(wl + P3_VOFF)); }
    for (; gci < GC_ITEMS; gci += cvstep) { GcLoads g; gc_issue(p, gci, lane, g); gc_finish(p, gci, lane, g); }
    __syncthreads();
}
__device__ __forceinline__ void p3b_carries(Frame& F) {
    const P& p = F.p; const int tid = F.tid, c = tid & 63, seg = tid >> 6;
    LAS f32x2* sc = (LAS f32x2*)F.lds;
    constexpr int SEGL = NCH / 8;
    static_assert(SEGL * 8 == NCH, "segments");
    for (int w = F.vcu; w < NB * 2 * 16; w += F.G) {
        const int cg = w & 15, d = (w >> 4) & 1, b = w >> 5;
        const f32x2* sg = (const f32x2*)(p.ws + WS_SUMG) + (size_t)((b * 2 + d) * NCH) * D + cg * 64 + c; float* cr = (float*)(p.ws + WS_CARRY) + (size_t)((b * 2 + d) * NCH) * D + cg * 64 + c;
        f32x2 cv[SEGL];
#pragma unroll
        for (int u = 0; u < SEGL; ++u) { const int j = seg * SEGL + u, nat = d == 0 ? j : (j < NCTXC ? NCTXC - 1 - j : NCH + NCTXC - 1 - j); cv[u] = sg[(size_t)nat * D]; }
        float Pt = 1.f, Qt = 0.f;
#pragma unroll
        for (int u = 0; u < SEGL; ++u) { Qt = cv[u].x * Qt + cv[u].y; Pt *= cv[u].x; }
        __syncthreads();
        sc[seg * 64 + c] = (f32x2){Pt, Qt};
        LDS_WAIT(); __syncthreads();
        float h = 0.f;
#pragma unroll
        for (int s2 = 0; s2 < 8; ++s2) { const f32x2 q = sc[s2 * 64 + c]; if (s2 < seg) h = q.x * h + q.y; }
#pragma unroll
        for (int u = 0; u < SEGL; ++u) { const int j = seg * SEGL + u, nat = d == 0 ? j : (j < NCTXC ? NCTXC - 1 - j : NCH + NCTXC - 1 - j); cr[(size_t)nat * D] = h; h = cv[u].x * h + cv[u].y; }
    }
    __syncthreads();
}
__device__ __forceinline__ void p3c_apply(Frame& F) {
    const P& p = F.p; const int lane = F.lane;
    if (F.G < 16) return;
    const int blk = F.vcu & 15, bpb = F.G >> 4, bidx = F.vcu >> 4;
    p3_tables(F, blk);
    LAS unsigned char* wl = F.lds + F.wave * P3_WAVE_LDS;
    const int jstep = bpb * NWAVES, NJ = NB * (SEQ / TC);
    int j = bidx * NWAVES + F.wave, ubi = 0;
    const int cvstep = F.G * NWAVES, cvend = CV_ITEMS; int cvi = CV_ITEMS / 3 + (int)blockIdx.x * NWAVES + F.wave;
#define P3C_PREFETCH(jj, ub_, ln_) do { const int b_ = (jj) & 3, nat_ = NCTXC + ((jj) >> 2); p3_tile_dma(p, ub_, b_, blk, nat_, ln_); } while (0)
    if (j < NJ) P3C_PREFETCH(j, wl, lane);
    for (; j < NJ; j += jstep, ubi ^= 1) {
        const int b = j & 3, nat = NCTXC + (j >> 2), t0 = (nat - NCTXC) * TC;
        unsigned hpk[2][4][2];
        int lv = lane; asm volatile("" : "+v"(lv));
        const int cc = lv & 7;
        VM_WAIT();
        float cb_[4], cf_[4];
        { const float* cr_ = (const float*)(p.ws + WS_CARRY) + ((size_t)(b * 2 * NCH + nat)) * D + blk * 64 + (lv & 15);
#pragma unroll
          for (int n = 0; n < 4; ++n) { cf_[n] = cr_[n * 16]; cb_[n] = cr_[(size_t)NCH * D + n * 16]; } }
        const int jn = j + jstep;
        if (jn < NJ) P3C_PREFETCH(jn, wl + (ubi ^ 1) * P3_UBUF, lv);
        Comp tot[4];
        CvJob cj[4]; float cvv[4][16]; bool cvon[4];
#pragma unroll
        for (int q = 0; q < 4; ++q) { cvon[q] = cvi < cvend; if (cvon[q]) { cj[q] = cv32_job(p, cvi); cv32_issue(cj[q], lv, cvv[q]); cvi += cvstep; } }
        p3_chunk<2>(F, lv, wl, wl + ubi * P3_UBUF, 1, tot, cb_, hpk);
        u32x4 gg[4];
#pragma unroll
        for (int i = 0; i < 4; ++i) { const int tl = (lv >> 3) + 8 * i; gg[i] = __builtin_nontemporal_load((const u32x4*)((const bf16*)(p.ws + WS_GG) + ((size_t)b * SEQ + t0 + tl) * D + blk * 64 + cc * 8)); }
        p3_chunk<2>(F, lv, wl, wl + ubi * P3_UBUF, 0, tot, cf_, hpk);
        LDS_WAIT();
#pragma unroll
        for (int i = 0; i < 4; ++i) { const int tl = (lv >> 3) + 8 * i; const size_t mrow = (size_t)b * SEQ + t0 + tl;
            const u32x4 hv = *(const LAS u32x4*)(wl + P3_VOFF + tl * P3_VPITCH + (cc << 4)); const u32x4 g = gg[i];
            u32x4 o; o.x = cvt_pk_bf16(bflo(hv.x) * bflo(g.x), bfhi(hv.x) * bfhi(g.x)); o.y = cvt_pk_bf16(bflo(hv.y) * bflo(g.y), bfhi(hv.y) * bfhi(g.y));
            o.z = cvt_pk_bf16(bflo(hv.z) * bflo(g.z), bfhi(hv.z) * bfhi(g.z)); o.w = cvt_pk_bf16(bflo(hv.w) * bflo(g.w), bfhi(hv.w) * bfhi(g.w));
            *(u32x4*)((bf16*)(p.ws + WS_Z) + mrow * 2048 + 1024 + blk * 64 + cc * 8) = o; }
        LDS_WAIT();
#pragma unroll
        for (int q = 0; q < 4; ++q) if (cvon[q]) cv32_finish(cj[q], lv, cvv[q], (LAS float*)(wl + P3_VOFF));
    }
    for (; cvi < cvend; cvi += cvstep) { const CvJob jb = cv32_job(p, cvi); float v[16]; cv32_issue(jb, lane, v); cv32_finish(jb, lane, v, (LAS float*)(wl + P3_VOFF)); }
#undef P3C_PREFETCH
    __syncthreads();
}
__device__ __forceinline__ void p3_conv(Frame& F) {
    const P& p = F.p; const int c8 = (F.tid & 127) * 8, tsub = F.tid >> 7;
    float w[3][8];
#pragma unroll
    for (int k = 0; k < 3; ++k)
#pragma unroll
        for (int c = 0; c < 8; ++c) w[k][c] = p.conv_a_w[k * D + c8 + c];
    const bool horiz = c8 < 512; const int off = horiz ? 1 : GW;
    const bf16* U = (const bf16*)(p.ws + WS_U) + c8; const bf16* GBp = (const bf16*)(p.ws + WS_GB) + c8; bf16* Z = (bf16*)(p.ws + WS_Z) + c8;
    for (int m0 = F.vcu * 4 + tsub; m0 < M; m0 += F.G * 16) {
        u32x4 um[4], u0[4], up[4], gb[4];
#pragma unroll
        for (int q = 0; q < 4; ++q) { const int m = m0 + q * F.G * 4; const u32x4 z4 = (u32x4){0u, 0u, 0u, 0u}; um[q] = z4; u0[q] = z4; up[q] = z4; gb[q] = z4;
            if (m < M) { const int tb = m & (SEQ - 1), row = tb >> 6, col = tb & 63; const bool okm = horiz ? col > 0 : row > 0, okp = horiz ? col < GW - 1 : row < GROWS - 1;
                if (okm) um[q] = *(const u32x4*)(U + (size_t)(m - off) * D); u0[q] = *(const u32x4*)(U + (size_t)m * D); if (okp) up[q] = *(const u32x4*)(U + (size_t)(m + off) * D); gb[q] = __builtin_nontemporal_load((const u32x4*)(GBp + (size_t)m * D)); } }
#pragma unroll
        for (int q = 0; q < 4; ++q) { const int m = m0 + q * F.G * 4; if (m >= M) continue;
            const unsigned um_[4] = {um[q].x, um[q].y, um[q].z, um[q].w}, u0_[4] = {u0[q].x, u0[q].y, u0[q].z, u0[q].w}, up_[4] = {up[q].x, up[q].y, up[q].z, up[q].w}, gb_[4] = {gb[q].x, gb[q].y, gb[q].z, gb[q].w};
            unsigned o[4];
#pragma unroll
            for (int j = 0; j < 4; ++j) {
                const float lo = (w[0][2 * j] * bflo(um_[j]) + w[1][2 * j] * bflo(u0_[j]) + w[2][2 * j] * bflo(up_[j])) * bflo(gb_[j]);
                const float hi = (w[0][2 * j + 1] * bfhi(um_[j]) + w[1][2 * j + 1] * bfhi(u0_[j]) + w[2][2 * j + 1] * bfhi(up_[j])) * bfhi(gb_[j]);
                o[j] = cvt_pk_bf16(lo, hi);
            }
            *(u32x4*)(Z + (size_t)m * 2048) = (u32x4){o[0], o[1], o[2], o[3]}; }
    }
}

__device__ __forceinline__ void p2_ctx_tiles(Frame& F) {
    const P& p = F.p; const int lane = F.lane, r16 = lane & 15, kq = lane >> 4;
    const bf16* HC = (const bf16*)(p.ws + WS_HC); const bf16* WL = (const bf16*)(p.ws + WS_WIN) + (size_t)3072 * D; bf16* CS = (bf16*)(p.ws + WS_CS3);
    for (int t = F.vcu; t < 256; t += F.G) {
        const int m0 = (t >> 4) * 64 + (F.wave & 3) * 16, n0 = (t & 15) * 64 + (F.wave >> 2) * 32;
        const bf16* ap = HC + (size_t)(m0 + r16) * D + 8 * kq; const bf16* bp0 = WL + (size_t)(n0 + r16) * D + 8 * kq; const bf16* bp1 = bp0 + (size_t)16 * D;
        f32x4 c0 = (f32x4){0.f, 0.f, 0.f, 0.f}, c1 = c0;
#pragma unroll 8
        for (int s2 = 0; s2 < 32; ++s2) { const bf16x8 a = *(const bf16x8*)(ap + 32 * s2), b0 = *(const bf16x8*)(bp0 + 32 * s2), b1 = *(const bf16x8*)(bp1 + 32 * s2);
            c0 = __builtin_amdgcn_mfma_f32_16x16x32_bf16(a, b0, c0, 0, 0, 0); c1 = __builtin_amdgcn_mfma_f32_16x16x32_bf16(a, b1, c1, 0, 0, 0); }
#pragma unroll
        for (int i = 0; i < 4; ++i) { bf16* o = CS + (size_t)(m0 + 4 * kq + i) * D + n0 + r16; o[0] = f2bf(c0[i]); o[16] = f2bf(c1[i]); }
    }
}

struct Args { P p; int ph_lo, ph_hi, region, pad; };
constexpr int NPHASE = 10;
#ifndef P2_ALIGN
#define P2_ALIGN true
#endif
__global__ void __launch_bounds__(NTHR, 2) mega_fwd(Args args) {
    extern __shared__ __attribute__((aligned(16))) unsigned char lds_raw[];
    Frame F{(LAS unsigned char*)lds_raw, args.p, 0, 0, 0, 0, 0, 0};
    F.var = 0;
    F.tid = threadIdx.x; F.lane = F.tid & 63; F.wave = __builtin_amdgcn_readfirstlane(F.tid >> 6);
    __builtin_assume(F.wave >= 0 && F.wave < NWAVES); __builtin_assume(gridDim.x >= 1 && gridDim.x <= 1024);
    F.G = gridDim.x; { const int bx = blockIdx.x; F.vcu = (F.G % 8 == 0) ? (bx % 8) * (F.G / 8) + bx / 8 : bx; }
    volatile LAS unsigned* MISC = (volatile LAS unsigned*)(F.lds + MISC_OFF);
    for (int u = F.tid; u < 128; u += NTHR) MISC[u] = 0u;
    __syncthreads();
    const int lo = args.ph_lo, hi = args.ph_hi;
    const P& p = F.p; unsigned char* ws = p.ws;
    unsigned* barw = (unsigned*)(ws + WS_CTL) + CW_BAR + (args.region & 7) * XCD_BAR_WORDS;
    XcdBarrier bar; bar.bar = barw; bar.x = 0; bar.st = nullptr;
    if (hi - lo > 1 || (lo == 3 && args.region < 8)) bar = xcd_barrier_post(barw, MISC + 8);
#ifndef CTM
#define CTM 0x3FFu
#endif
#define IN(k) (((CTM >> (k)) & 1u) && lo <= (k) && (k) < hi)
#define SEAM(k) do { if (IN(k) && IN((k) + 1)) xcd_barrier(bar); } while (0)
#define PHASE(k, ...) do { if (IN(k)) { __VA_ARGS__ } SEAM(k); } while (0)
    PHASE(0, { p0_prologue(F); });
    PHASE(1, { p1_rows(F); });
    PHASE(2, {
        SchedInProj S{(const char*)(ws + WS_HXP), (const char*)(ws + WS_HC), (const char*)(ws + WS_WIN), F.G, (int)blockIdx.x, ((args.region >> 8) & 4) ? 0 : 16, 0};
        EpiInProj E{ws, p.b_merge, (int)((args.region >> 8) & 3)};
        pg8::gemm_phase<EpiInProj, SchedInProj, false, false, P2_ALIGN>(F.lds, D, S, E, PA * 2);
    });
    if (IN(3)) {
        const int part = (args.region >> 3) & 31;
#ifdef PROBE_P3VAR
        if (part == 1 && (args.region >> 8)) p3a_summaries<PROBE_P3VAR>(F); else
#endif
        if (part == 0 || part == 1) p3a_summaries<0>(F);
        if (part == 0) xcd_barrier(bar);
        if (part == 0 || part == 2) p3b_carries(F);
        if (part == 0) xcd_barrier(bar);
        if (part == 0 || part == 3) p3c_apply(F);
    } SEAM(3);
    PHASE(4, {
        SchedDense S{(const char*)(ws + WS_Z), (const char*)(ws + WS_WAB), 2048, F.G, (int)blockIdx.x};
        EpiMerge E{ws};
        pg8::gemm_phase<EpiMerge, SchedDense, true>(F.lds, 2048, S, E);
    });
    PHASE(5, {
        SchedDense S{(const char*)(ws + WS_MG), (const char*)(ws + WS_WO), D, F.G, (int)blockIdx.x};
        EpiWo E{p.x, (bf16*)(ws + WS_X1), (const float*)(ws + WS_MX)};
        pg8::gemm_phase<EpiWo, SchedDense, false>(F.lds, D, S, E);
    });
    PHASE(6, { p6_route(F); });
    PHASE(7, {
        LAS int* tab = (LAS int*)(F.lds + AUX_OFF);
        __syncthreads();
        moe_tables(tab, (const unsigned*)(ws + WS_CTL) + CW_CNT, 8, F.G, (int)blockIdx.x);
        SchedMoe S{(const char*)(ws + WS_FX8), (const char*)(ws + WS_W1), (const int*)(ws + WS_TOK), tab, 8, F.G, (int)blockIdx.x, 1, 2048, 1};
        EpiMoe1 E{ws, p.b1};
        pg8::gemm_phase<EpiMoe1, SchedMoe, false, true>(F.lds, D, S, E);
    });
    PHASE(8, {
        LAS int* tab = (LAS int*)(F.lds + AUX_OFF);
        __syncthreads();
        moe_tables(tab, (const unsigned*)(ws + WS_CTL) + CW_CNT, 4, F.G, (int)blockIdx.x);
        SchedMoe S{(const char*)(ws + WS_ACT), (const char*)(ws + WS_W2), (const int*)(ws + WS_TOK), tab, 4, F.G, (int)blockIdx.x, 0, 1024, 1};
        EpiMoe2 E{ws, p.b2};
        pg8::gemm_phase<EpiMoe2, SchedMoe, false, true>(F.lds, DE, S, E);
    });
    if (IN(9)) { __syncthreads(); p9_final(F); }
#undef PHASE
#undef IN
#undef SEAM
}
#ifndef FAST_MASK
#define FAST_MASK 0x3FFu
#endif
#ifndef ONE_LAUNCH
#define ONE_LAUNCH 1
#endif
static void launch_mega(const P& p, int lo, int hi, int grid, hipStream_t stream, int region = 0) {
    Args a{}; a.p = p; a.ph_lo = lo; a.ph_hi = hi; a.region = region; a.pad = 0;
    hipLaunchKernelGGL(mega_fwd, dim3(grid), dim3(NTHR), LDS_BYTES, stream, a);
}
extern "C" void kernel_launch(void* const* d_in, const int* in_sizes, int n_in, void* d_out, int out_size, void* d_ws, size_t ws_size, hipStream_t stream) {
    static int grid = 0;
    if (grid == 0) {
        if (n_in != 28 || out_size != M * D || ws_size < WS_END) { fprintf(stderr, "kernel_launch: unexpected shapes n_in %d out %d ws %zu\n", n_in, out_size, ws_size); grid = -1; return; }
        int dev = 0, cus = 0, per_cu = 0;
        if (hipGetDevice(&dev) != hipSuccess || hipDeviceGetAttribute(&cus, hipDeviceAttributeMultiprocessorCount, dev) != hipSuccess) { grid = -1; return; }
        if (hipFuncSetAttribute((const void*)mega_fwd, hipFuncAttributeMaxDynamicSharedMemorySize, LDS_BYTES) != hipSuccess) { fprintf(stderr, "kernel_launch: hipFuncSetAttribute failed\n"); grid = -1; return; }
        if (hipOccupancyMaxActiveBlocksPerMultiprocessor(&per_cu, (const void*)mega_fwd, NTHR, LDS_BYTES) != hipSuccess || per_cu < 1) { fprintf(stderr, "kernel_launch: occupancy query reports %d blocks per CU\n", per_cu); }
        (void)hipGetLastError();
        grid = cus;
    }
    if (grid < 0) return;
    P p{};
    const float** f = (const float**)&p;
    for (int i = 0; i < 28; ++i) f[i] = (const float*)d_in[i];
    p.out = (float*)d_out; p.ws = (unsigned char*)d_ws;
    (void)hipMemsetAsync((char*)d_ws + WS_CTL, 0, CTL_ZERO_BYTES, stream);
    const unsigned fm = FAST_MASK;
#ifdef PROBE_LO
    launch_mega(p, 0, PROBE_HI, grid, stream, 0);
    if (PROBE_LO <= 6 && 6 < PROBE_HI) (void)hipMemsetAsync((char*)d_ws + WS_CTL + CW_CNT * 4, 0, 128, stream);
#if defined(PROBE_P2VAR)
    launch_mega(p, 2, 3, grid, stream, 256 * PROBE_P2VAR + 2);
#elif defined(PROBE_P3PART)
#ifdef PROBE_P3VAR
    launch_mega(p, 3, 4, grid, stream, 256 + 8 * PROBE_P3PART + 2);
#else
    launch_mega(p, 3, 4, grid, stream, 8 * PROBE_P3PART + 2);
#endif
#else
    for (int k = PROBE_LO; k < PROBE_HI; ++k) launch_mega(p, k, k + 1, grid, stream, 2);
#endif
    if (PROBE_HI < NPHASE) launch_mega(p, PROBE_HI, NPHASE, grid, stream, 1);
    return;
#endif
    if (ONE_LAUNCH && fm == 0x3FFu) { launch_mega(p, 0, NPHASE, grid, stream); return; }
    for (int ph = 0; ph < NPHASE; ++ph) {
        if ((fm >> ph) & 1u) { launch_mega(p, ph, ph + 1, grid, stream); continue; }
        switch (ph) {
        case 0: nv_adaln<<<6144 / 256, 256, 0, stream>>>(p); if (fm & 0x1B4u) launch_mega(p, 0, 1, grid, stream); break;
        case 1: nv_hx<<<(M + MC) / 4, 256, 0, stream>>>(p); break;
        case 2: for (int mode = 0; mode < 6; ++mode) { FInProj fi{p, mode, D}; const dim3 g(D / 128, (mode == 5 ? MC : M) / 128, 1);
                    if (mode == 1 || mode == 4) nv_gemm<true, FInProj><<<g, 256, 0, stream>>>(fi); else nv_gemm<false, FInProj><<<g, 256, 0, stream>>>(fi); } break;
        case 3: nv_lru<<<NB * 2 * 16, 64, 0, stream>>>(p); nv_mix<<<(unsigned)((size_t)M * D / 256), 256, 0, stream>>>(p); break;
        case 4: { FMerge fm_{p, D, 0}; nv_gemm<true, FMerge><<<dim3(D / 128, M / 128, 1), 256, 0, stream>>>(fm_); } break;
        case 5: { FWo fw{p, D, 0}; nv_gemm<false, FWo><<<dim3(D / 128, M / 128, 1), 256, 0, stream>>>(fw); } break;
        case 6: nv_route<<<M / 4, 256, 0, stream>>>(p); break;
        case 7: { FMoe1 f1{p, D, 0}; nv_gemm<true, FMoe1><<<dim3(DE / 128, M / 128, NE), 256, 0, stream>>>(f1); } break;
        case 8: { FMoe2 f2{p, DE, 0}; nv_gemm<false, FMoe2><<<dim3(D / 128, M / 128, NE), 256, 0, stream>>>(f2); } break;
        case 9: nv_final<<<M / 4, 256, 0, stream>>>(p); break;
        }
    }
}
```

```cpp
#define UEW_ALL 1
#define PADX 64
#include <hip/hip_runtime.h>
#include <stdint.h>
#include <cstdio>

typedef unsigned short bf16;
__device__ __forceinline__ float bf2f(bf16 v) { return __uint_as_float(((unsigned)v) << 16); }
__device__ __forceinline__ bf16 f2bf(float f) { unsigned u = __float_as_uint(f); u += 0x7fffu + ((u >> 16) & 1u); return (bf16)(u >> 16); }

constexpr int NB = 4, SEQ = 8192, D = 1024, M = NB * SEQ, CTX = 256, MC = NB * CTX, INC = 7168;
constexpr int NE = 32, TOPK = 4, DE = 1024, GW = 64, GROWS = SEQ / GW;
constexpr float EPS = 1e-6f;
constexpr size_t MiB = 1u << 20;
constexpr size_t WS_CTL = 0, CTL_BYTES = 1 * MiB;
constexpr int CW_CNT = 16384;
constexpr size_t WS_MX = 1 * MiB;
constexpr size_t WS_TOK = 2 * MiB, WS_GATE = 6 * MiB, WS_INV = 10 * MiB;
#ifndef PADX
#define PADX 0
#endif
constexpr int PA = D + PADX;
constexpr size_t WS_CS3 = 11 * MiB, WS_HC = 13 * MiB;
constexpr size_t WS_WIN = (PADX ? 936 : 16) * MiB, WS_WAB = 30 * MiB, WS_WO = 34 * MiB, WS_W1 = 36 * MiB, WS_W2 = 164 * MiB;
constexpr size_t WS_HX = 228 * MiB, WS_GB = 292 * MiB, WS_U = 356 * MiB, WS_ULRU = 420 * MiB, WS_GG = 484 * MiB;
constexpr size_t WS_ACT = 228 * MiB;
constexpr size_t WS_RAT = 548 * MiB, WS_SBG = 612 * MiB, WS_Z = 676 * MiB, WS_MG = 804 * MiB;
constexpr size_t WS_FX = 548 * MiB, WS_OUTP = 548 * MiB;
constexpr size_t WS_HF = WS_HX, WS_HB = WS_MG;
constexpr size_t WS_END = (PADX ? 952 : 868) * MiB;
constexpr size_t WS_HXP = PADX ? 868 * MiB : WS_HX;

struct P {
    const float *x, *c, *ctx, *c_ctx, *w_ada, *b_ada, *norm_mix, *w_in, *conv_a_w, *w_out_a, *lru_conv_w, *lru_conv_b, *lru_wa, *lru_ba, *lru_wx, *lru_bx,
        *lru_lambda, *w_out_b, *b_merge, *w_o, *norm_ffn, *router_w, *router_b, *w1, *b1, *w2, *b2, *norm_final;
    float* out; unsigned char* ws;
};

__device__ __forceinline__ float wave_sum(float v) {
#pragma unroll
    for (int o = 1; o < 64; o <<= 1) v += __shfl_xor(v, o);
    return v;
}
__device__ __forceinline__ float sigmoidf_(float v) { return 1.0f / (1.0f + __expf(-v)); }
__device__ __forceinline__ float gelu_tanh(float v) { const float u = 0.7978845608028654f * (v + 0.044715f * v * v * v); return v * sigmoidf_(2.0f * u); }
__device__ __forceinline__ int pad256(int v) { return (v + 255) & ~255; }

__global__ __launch_bounds__(256) void nv_adaln(P p) {
    __shared__ float sc[5][D];
    for (int i = threadIdx.x; i < 5 * D; i += 256) { const int r = i / D, k = i % D; const float v = r < 4 ? p.c[r * D + k] : p.c_ctx[k]; sc[r][k] = v * sigmoidf_(v); }
    __syncthreads();
    const int n = blockIdx.x * 256 + threadIdx.x;
    float a[5] = {0, 0, 0, 0, 0};
    for (int k = 0; k < D; ++k) { const float w = p.w_ada[(size_t)k * 6144 + n];
#pragma unroll
        for (int r = 0; r < 5; ++r) a[r] += sc[r][k] * w; }
    float* mx = (float*)(p.ws + WS_MX);
#pragma unroll
    for (int r = 0; r < 5; ++r) mx[r * 6144 + n] = a[r] + p.b_ada[n];
}
__global__ __launch_bounds__(256) void nv_hx(P p) {
    const int row = blockIdx.x * 4 + (threadIdx.x >> 6), lane = threadIdx.x & 63;
    const float* mx = (const float*)(p.ws + WS_MX);
    const float* src; bf16* dst; const float* md;
    if (row < M) { src = p.x + (size_t)row * D; dst = (bf16*)(p.ws + WS_HX) + (size_t)row * D; md = mx + (row / SEQ) * 6144; }
    else { const int r = row - M; src = p.ctx + (size_t)r * D; dst = (bf16*)(p.ws + WS_HC) + (size_t)r * D; md = mx + 4 * 6144; }
    float v[16]; float s = 0.f;
#pragma unroll
    for (int j = 0; j < 16; ++j) { v[j] = src[lane + 64 * j]; s += v[j] * v[j]; }
    const float rstd = rsqrtf(wave_sum(s) * (1.0f / D) + EPS);
#pragma unroll
    for (int j = 0; j < 16; ++j) { const int k = lane + 64 * j; dst[k] = f2bf(v[j] * rstd * p.norm_mix[k] * (1.0f + md[1024 + k]) + md[k]); }
}

template <bool DUAL, class F>
__global__ __launch_bounds__(256) void nv_gemm(F f) {
    const int K = f.K;
    __shared__ float As[2][16][128 + 4], Bs[2][16][128 + 4];
    const int z = blockIdx.z, m0 = blockIdx.y * 128, n0 = blockIdx.x * 128, tid = threadIdx.x, tx = tid & 15, ty = tid >> 4;
    if (m0 >= f.rows(z)) return;
    float acc[8][8], acc2[8][8];
#pragma unroll
    for (int i = 0; i < 8; ++i)
#pragma unroll
        for (int j = 0; j < 8; ++j) { acc[i][j] = 0.f; acc2[i][j] = 0.f; }
    for (int k0 = 0; k0 < K; k0 += 16) {
#pragma unroll
        for (int i = 0; i < 8; ++i) { const int idx = tid + 256 * i; const int mm = idx >> 4, kk = idx & 15; As[0][kk][mm] = f.a(z, m0 + mm, k0 + kk); if (DUAL) As[1][kk][mm] = f.a2(z, m0 + mm, k0 + kk); }
#pragma unroll
        for (int i = 0; i < 8; ++i) { const int idx = tid + 256 * i; const int kk = idx >> 7, nn = idx & 127; Bs[0][kk][nn] = f.b(z, k0 + kk, n0 + nn); if (DUAL) Bs[1][kk][nn] = f.b2(z, k0 + kk, n0 + nn); }
        __syncthreads();
#pragma unroll
        for (int kk = 0; kk < 16; ++kk) {
            float av[8], bv[8];
#pragma unroll
            for (int i = 0; i < 8; ++i) { av[i] = As[0][kk][ty + 16 * i]; bv[i] = Bs[0][kk][tx + 16 * i]; }
#pragma unroll
            for (int i = 0; i < 8; ++i)
#pragma unroll
                for (int j = 0; j < 8; ++j) acc[i][j] += av[i] * bv[j];
            if (DUAL) {
#pragma unroll
                for (int i = 0; i < 8; ++i) { av[i] = As[1][kk][ty + 16 * i]; bv[i] = Bs[1][kk][tx + 16 * i]; }
#pragma unroll
                for (int i = 0; i < 8; ++i)
#pragma unroll
                    for (int j = 0; j < 8; ++j) acc2[i][j] += av[i] * bv[j];
            }
        }
        __syncthreads();
    }
#pragma unroll
    for (int i = 0; i < 8; ++i)
#pragma unroll
        for (int j = 0; j < 8; ++j) f.ep(z, m0 + ty + 16 * i, n0 + tx + 16 * j, acc[i][j], acc2[i][j]);
}
struct FInProj {
    P p; int mode, K;
    __device__ int rows(int) const { return mode == 5 ? MC : M; }
    __device__ float a(int, int m, int k) const { const bf16* A = (const bf16*)(p.ws + (mode == 5 ? WS_HC : WS_HX)); return bf2f(A[(size_t)m * D + k]); }
    __device__ float a2(int z, int m, int k) const { return a(z, m, k); }
    __device__ int col1() const { return mode == 0 ? 0 : mode == 1 ? 1024 : mode == 2 ? 3072 : mode == 3 ? 4096 : mode == 4 ? 5120 : 3072; }
    __device__ float b(int, int k, int n) const { return p.w_in[(size_t)k * INC + col1() + n]; }
    __device__ float b2(int, int k, int n) const { return p.w_in[(size_t)k * INC + col1() + 1024 + n]; }
    __device__ void ep(int, int m, int n, float v, float v2) const {
        const size_t o = (size_t)m * D + n;
        if (mode == 0) ((bf16*)(p.ws + WS_GB))[o] = f2bf(v);
        else if (mode == 1) ((bf16*)(p.ws + WS_U))[o] = f2bf(v * v2);
        else if (mode == 2) ((bf16*)(p.ws + WS_ULRU))[o] = f2bf(v);
        else if (mode == 3) ((bf16*)(p.ws + WS_GG))[o] = f2bf(gelu_tanh(v));
        else if (mode == 4) { const float sa = sigmoidf_(v + p.b_merge[n]), sb = sigmoidf_(v2 + p.b_merge[D + n]); ((bf16*)(p.ws + WS_RAT))[o] = f2bf(sa / sb); ((bf16*)(p.ws + WS_SBG))[o] = f2bf(sb); }
        else ((bf16*)(p.ws + WS_CS3))[o] = f2bf(v);
    }
};
struct FMerge {
    P p; int K, pad;
    __device__ int rows(int) const { return M; }
    __device__ float a(int, int m, int k) const { return bf2f(((const bf16*)(p.ws + WS_Z))[(size_t)m * 2048 + k]); }
    __device__ float a2(int, int m, int k) const { return bf2f(((const bf16*)(p.ws + WS_Z))[(size_t)m * 2048 + 1024 + k]); }
    __device__ float b(int, int k, int n) const { return p.w_out_a[(size_t)k * D + n]; }
    __device__ float b2(int, int k, int n) const { return p.w_out_b[(size_t)k * D + n]; }
    __device__ void ep(int, int m, int n, float v, float v2) const {
        const size_t o = (size_t)m * D + n; const float rat = bf2f(((const bf16*)(p.ws + WS_RAT))[o]), sb = bf2f(((const bf16*)(p.ws + WS_SBG))[o]);
        ((bf16*)(p.ws + WS_MG))[o] = f2bf((v * rat + v2) * sb);
    }
};
struct FWo {
    P p; int K, pad;
    __device__ int rows(int) const { return M; }
    __device__ float a(int, int m, int k) const { return bf2f(((const bf16*)(p.ws + WS_MG))[(size_t)m * D + k]); }
    __device__ float a2(int, int, int) const { return 0.f; }
    __device__ float b(int, int k, int n) const { return p.w_o[(size_t)k * D + n]; }
    __device__ float b2(int, int, int) const { return 0.f; }
    __device__ void ep(int, int m, int n, float v, float) const { const float* mx = (const float*)(p.ws + WS_MX); const size_t o = (size_t)m * D + n; p.out[o] = p.x[o] + mx[(m / SEQ) * 6144 + 2 * 1024 + n] * v; }
};
__device__ __forceinline__ int expert_base(const unsigned* cnt, int e) { int b = 0; for (int i = 0; i < e; ++i) b += pad256((int)cnt[i]); return b; }
struct FMoe1 {
    P p; int K, pad;
    __device__ const unsigned* cnt() const { return (const unsigned*)(p.ws + WS_CTL) + CW_CNT; }
    __device__ int rows(int z) const { return (int)cnt()[z]; }
    __device__ float a(int z, int m, int k) const { if (m >= rows(z)) return 0.f; const int tok = ((const int*)(p.ws + WS_TOK))[(size_t)z * M + m]; return bf2f(((const bf16*)(p.ws + WS_FX))[(size_t)tok * D + k]); }
    __device__ float a2(int z, int m, int k) const { return a(z, m, k); }
    __device__ float b(int z, int k, int n) const { return p.w1[((size_t)z * D + k) * 2048 + 2 * n]; }
    __device__ float b2(int z, int k, int n) const { return p.w1[((size_t)z * D + k) * 2048 + 2 * n + 1]; }
    __device__ void ep(int z, int m, int n, float v, float v2) const {
        if (m >= rows(z)) return;
        const float hg = v + p.b1[(size_t)z * 2048 + 2 * n], hl = v2 + p.b1[(size_t)z * 2048 + 2 * n + 1];
        const float glu = fminf(hg, 7.0f), lin = fminf(fmaxf(hl, -7.0f), 7.0f);
        const float act = glu * sigmoidf_(1.702f * glu) * (lin + 1.0f);
        ((bf16*)(p.ws + WS_ACT))[(size_t)(expert_base(cnt(), z) + m) * DE + n] = f2bf(act);
    }
};
struct FMoe2 {
    P p; int K, pad;
    __device__ const unsigned* cnt() const { return (const unsigned*)(p.ws + WS_CTL) + CW_CNT; }
    __device__ int rows(int z) const { return (int)cnt()[z]; }
    __device__ float a(int z, int m, int k) const { if (m >= rows(z)) return 0.f; return bf2f(((const bf16*)(p.ws + WS_ACT))[(size_t)(expert_base(cnt(), z) + m) * DE + k]); }
    __device__ float a2(int, int, int) const { return 0.f; }
    __device__ float b(int z, int k, int n) const { return p.w2[((size_t)z * DE + k) * D + n]; }
    __device__ float b2(int, int, int) const { return 0.f; }
    __device__ void ep(int z, int m, int n, float v, float) const {
        if (m >= rows(z)) return;
        const float g = ((const float*)(p.ws + WS_GATE))[(size_t)z * M + m];
        ((bf16*)(p.ws + WS_OUTP))[(size_t)(expert_base(cnt(), z) + m) * D + n] = f2bf((v + p.b2[(size_t)z * D + n]) * g);
    }
};

__global__ __launch_bounds__(64) void nv_lru(P p) {
    __shared__ float vs[64];
    const int j = threadIdx.x, blk = blockIdx.x & 15, dir = (blockIdx.x >> 4) & 1, b = blockIdx.x >> 5, ch = blk * 64 + j;
    float wa[64], wx[64];
    const float* WA = p.lru_wa + ((size_t)(dir * 16 + blk) * 64) * 64; const float* WX = p.lru_wx + ((size_t)(dir * 16 + blk) * 64) * 64;
#pragma unroll
    for (int k = 0; k < 64; ++k) { wa[k] = WA[k * 64 + j]; wx[k] = WX[k * 64 + j]; }
    const float ba = p.lru_ba[dir * D + ch], bx = p.lru_bx[dir * D + ch], cb = p.lru_conv_b[dir * D + ch];
    float cw[4];
#pragma unroll
    for (int q = 0; q < 4; ++q) cw[q] = p.lru_conv_w[(size_t)(dir * 4 + q) * D + ch];
    const float lam = p.lru_lambda[dir * D + ch];
    const float c1 = -8.0f * log1pf(__expf(-lam));
    float h = 0.f;
    bf16* hout = (bf16*)(p.ws + (dir == 0 ? WS_HF : WS_HB));
    for (int seq = 0; seq < 2; ++seq) {
        const int L = seq == 0 ? CTX : SEQ;
        const bf16* u = seq == 0 ? (const bf16*)(p.ws + WS_CS3) + (size_t)b * CTX * D : (const bf16*)(p.ws + WS_ULRU) + (size_t)b * SEQ * D;
        for (int step = 0; step < L; ++step) {
            const int t = dir == 0 ? step : L - 1 - step;
            float v = cb;
#pragma unroll
            for (int q = 0; q < 4; ++q) { const int tt = dir == 0 ? t + q - 3 : t + 3 - q; if (tt >= 0 && tt < L) v += cw[q] * bf2f(u[(size_t)tt * D + ch]); }
            vs[j] = v;
            __syncthreads();
            float r = ba, i = bx;
#pragma unroll
            for (int k = 0; k < 64; ++k) { const float vk = vs[k]; r += vk * wa[k]; i += vk * wx[k]; }
            __syncthreads();
            r = sigmoidf_(r); i = sigmoidf_(i);
            const float la = c1 * r, a = __expf(la), bb = sqrtf(fmaxf(1.0f - __expf(2.0f * la), 0.f)) * (i * v);
            h = a * h + bb;
            if (seq == 1) hout[((size_t)b * SEQ + t) * D + ch] = f2bf(h);
        }
    }
}
__global__ __launch_bounds__(256) void nv_mix(P p) {
    const size_t idx = (size_t)blockIdx.x * 256 + threadIdx.x; const int m = (int)(idx / D), ch = (int)(idx % D);
    const int tb = m % SEQ, row = tb / GW, col = tb % GW;
    const bf16* U = (const bf16*)(p.ws + WS_U);
    float s = 0.f;
#pragma unroll
    for (int k = 0; k < 3; ++k) {
        const float w = p.conv_a_w[k * D + ch]; int mm; bool ok;
        if (ch < 512) { const int c2 = col + k - 1; ok = c2 >= 0 && c2 < GW; mm = m + k - 1; }
        else { const int r2 = row + k - 1; ok = r2 >= 0 && r2 < GROWS; mm = m + (k - 1) * GW; }
        if (ok) s += w * bf2f(U[(size_t)mm * D + ch]);
    }
    bf16* Z = (bf16*)(p.ws + WS_Z);
    Z[(size_t)m * 2048 + ch] = f2bf(bf2f(((const bf16*)(p.ws + WS_GB))[idx]) * s);
    const float hh = bf2f(((const bf16*)(p.ws + WS_HF))[idx]) + bf2f(((const bf16*)(p.ws + WS_HB))[idx]);
    Z[(size_t)m * 2048 + 1024 + ch] = f2bf(bf2f(((const bf16*)(p.ws + WS_GG))[idx]) * hh);
}
__global__ __launch_bounds__(256) void nv_route(P p) {
    const int row = blockIdx.x * 4 + (threadIdx.x >> 6), lane = threadIdx.x & 63;
    const float* mx = (const float*)(p.ws + WS_MX) + (row / SEQ) * 6144;
    const float* src = p.out + (size_t)row * D;
    float v[16]; float s = 0.f;
#pragma unroll
    for (int j = 0; j < 16; ++j) { v[j] = src[lane + 64 * j]; s += v[j] * v[j]; }
    const float rstd = rsqrtf(wave_sum(s) * (1.0f / D) + EPS);
    bf16* fx = (bf16*)(p.ws + WS_FX) + (size_t)row * D;
#pragma unroll
    for (int j = 0; j < 16; ++j) { const int k = lane + 64 * j; v[j] = v[j] * rstd * p.norm_ffn[k] * (1.0f + mx[4 * 1024 + k]) + mx[3 * 1024 + k]; fx[k] = f2bf(v[j]); }
    float lg[NE];
#pragma unroll
    for (int e = 0; e < NE; ++e) { float a = 0.f;
#pragma unroll
        for (int j = 0; j < 16; ++j) a += v[j] * p.router_w[(size_t)(lane + 64 * j) * NE + e];
        lg[e] = wave_sum(a) + p.router_b[e]; }
    if (lane == 0) {
        int idx[TOPK]; float val[TOPK]; unsigned used = 0u;
#pragma unroll
        for (int t = 0; t < TOPK; ++t) { int bi = -1; float bv = -3.0e38f;
#pragma unroll
            for (int e = 0; e < NE; ++e) { const bool free_ = !((used >> e) & 1u); if (free_ && lg[e] > bv) { bv = lg[e]; bi = e; } }
            idx[t] = bi; val[t] = bv; used |= 1u << bi; }
        float ex[TOPK], se = 0.f;
#pragma unroll
        for (int t = 0; t < TOPK; ++t) { ex[t] = __expf(val[t] - val[0]); se += ex[t]; }
        unsigned* cnt = (unsigned*)(p.ws + WS_CTL) + CW_CNT;
#pragma unroll
        for (int t = 0; t < TOPK; ++t) {
            const int e = idx[t]; const unsigned slot = atomicAdd(&cnt[e], 1u);
            ((int*)(p.ws + WS_TOK))[(size_t)e * M + slot] = row;
            ((float*)(p.ws + WS_GATE))[(size_t)e * M + slot] = ex[t] / se;
            ((int*)(p.ws + WS_INV))[(size_t)row * 4 + t] = e * M + (int)slot;
        }
    }
}
__global__ __launch_bounds__(256) void nv_final(P p) {
    const int row = blockIdx.x * 4 + (threadIdx.x >> 6), lane = threadIdx.x & 63;
    const float* mx = (const float*)(p.ws + WS_MX) + (row / SEQ) * 6144 + 5 * 1024;
    const unsigned* cnt = (const unsigned*)(p.ws + WS_CTL) + CW_CNT;
    const int* inv = (const int*)(p.ws + WS_INV) + (size_t)row * 4;
    const bf16* op[TOPK];
#pragma unroll
    for (int t = 0; t < TOPK; ++t) { const int e = inv[t] / M, slot = inv[t] % M; op[t] = (const bf16*)(p.ws + WS_OUTP) + (size_t)(expert_base(cnt, e) + slot) * D; }
    float* xo = p.out + (size_t)row * D;
    float v[16]; float s = 0.f;
#pragma unroll
    for (int j = 0; j < 16; ++j) { const int k = lane + 64 * j; float y = 0.f;
#pragma unroll
        for (int t = 0; t < TOPK; ++t) y += bf2f(op[t][k]);
        v[j] = xo[k] + mx[k] * y; s += v[j] * v[j]; }
    const float rstd = rsqrtf(wave_sum(s) * (1.0f / D) + EPS);
#pragma unroll
    for (int j = 0; j < 16; ++j) { const int k = lane + 64 * j; xo[k] = v[j] * rstd * p.norm_final[k]; }
}

#define LAS __attribute__((address_space(3)))
#define GAS __attribute__((address_space(1)))
typedef short bf16x8 __attribute__((ext_vector_type(8)));
typedef float f32x4 __attribute__((ext_vector_type(4)));
typedef float f32x2 __attribute__((ext_vector_type(2)));
typedef unsigned u32x4 __attribute__((ext_vector_type(4)));
typedef unsigned u32x2 __attribute__((ext_vector_type(2)));
typedef int i32x4 __attribute__((ext_vector_type(4)));
typedef int i32x8 __attribute__((ext_vector_type(8)));
constexpr size_t WS_X1 = WS_GG;
constexpr size_t WS_FX8 = 612 * MiB;
__device__ __forceinline__ unsigned pk4_fp8(float a, float b, float c, float d) { int w = 0; w = __builtin_amdgcn_cvt_pk_fp8_f32(a, b, w, false); w = __builtin_amdgcn_cvt_pk_fp8_f32(c, d, w, true); return (unsigned)w; }
constexpr int NWAVES = 8, NTHR = 512;
constexpr int RING_BYTES = 131072, AUX_OFF = RING_BYTES, AUX_BYTES = 28672, MISC_OFF = AUX_OFF + AUX_BYTES, LDS_BYTES = MISC_OFF + 512;
constexpr size_t WS_ZERO = WS_CTL + 66048;
constexpr int CW_BAR = 4096;
constexpr size_t CTL_ZERO_BYTES = 131072;

__device__ __forceinline__ unsigned cvt_pk_bf16(float lo, float hi) { unsigned r; asm volatile("v_cvt_pk_bf16_f32 %0, %1, %2" : "=v"(r) : "v"(lo), "v"(hi)); return r; }
__device__ __forceinline__ unsigned pk2(float lo, float hi) { return (unsigned)f2bf(lo) | ((unsigned)f2bf(hi) << 16); }
__device__ __forceinline__ float bflo(unsigned w) { return __uint_as_float(w << 16); }
__device__ __forceinline__ float bfhi(unsigned w) { return __uint_as_float(w & 0xffff0000u); }
__device__ __forceinline__ float gelu_fast(float v) { const float t = v * (-2.3022082f - 0.10294324f * v * v); return v * __builtin_amdgcn_rcpf(1.0f + __builtin_amdgcn_exp2f(t)); }
__device__ __forceinline__ float fsig(float v) { return __builtin_amdgcn_rcpf(1.0f + __expf(-v)); }
__device__ __forceinline__ void mfma_f8_inplace(f32x4& acc, const i32x8& a, const i32x8& b, int sa, int sb) {
    asm volatile("v_mfma_scale_f32_16x16x128_f8f6f4 %0, %1, %2, %0, %3, %4 op_sel_hi:[0,0,0]" : "+v"(acc) : "v"(a), "v"(b), "v"(sa), "v"(sb));
}
__device__ __forceinline__ void mfma_bf16_inplace(f32x4& acc, const bf16x8& a, const bf16x8& b) {
    asm volatile("v_mfma_f32_16x16x32_bf16 %0, %1, %2, %0" : "+v"(acc) : "v"(a), "v"(b));
}
#define LDS_WAIT() asm volatile("s_waitcnt lgkmcnt(0)" ::: "memory")
#define VM_WAIT() asm volatile("s_waitcnt vmcnt(0)" ::: "memory")

namespace pg8 {
constexpr int BM = 256, BK = 64, HALF = 128, HTB = HALF * BK * 2, STAGE_BYTES = 8 * HTB;
__host__ __device__ __forceinline__ int lds_byte(int r, int c) { const int st = (r >> 4) * 2 + (c >> 5), rr = r & 15, cc = c & 31, ob = rr * 64 + cc * 2; return st * 1024 + (ob ^ (((ob >> 9) & 1) << 5)); }
__host__ __device__ __forceinline__ void stage_rc(int b, int& R, int& C) { const int st = b / 1024, sb = b % 1024, swz = sb ^ (((sb >> 9) & 1) << 5); R = (st >> 1) * 16 + swz / 64; C = (st & 1) * 32 + (swz % 64) / 2; }
__host__ __device__ __forceinline__ int perm32(int rho) { const int n = rho >> 4, i = rho & 15; return 8 * (i >> 2) + 4 * n + (i & 3); }

struct Unit { const char* A; const char* B; const int* gat; int gcnt, grow0; int kind, row0, ocol, e, slot0; };

__device__ __forceinline__ void arows(const Unit& u, unsigned (&rp)[2]) {
    int R[2], C[2]; int tx = (int)threadIdx.x; asm volatile("" : "+v"(tx));
#pragma unroll
    for (int i = 0; i < 2; ++i) stage_rc(tx * 16 + i * 8192, R[i], C[i]);
#pragma unroll
    for (int h = 0; h < 2; ++h) {
        int r[2];
#pragma unroll
        for (int i = 0; i < 2; ++i) { r[i] = h * HALF + R[i]; if (u.gat) { const int gr = u.grow0 + r[i]; r[i] = gr < u.gcnt ? u.gat[gr] : 0; } }
        rp[h] = (unsigned)r[0] | ((unsigned)r[1] << 16);
    }
}
__device__ __forceinline__ void arows_issue(const Unit& u, LAS unsigned char* idx) {
    int R[2], C[2]; int tx = (int)threadIdx.x; asm volatile("" : "+v"(tx));
    const unsigned wofs = (unsigned)__builtin_amdgcn_readfirstlane(tx >> 6) * 256u;
#pragma unroll
    for (int i = 0; i < 2; ++i) stage_rc(tx * 16 + i * 8192, R[i], C[i]);
#pragma unroll
    for (int h = 0; h < 2; ++h)
#pragma unroll
        for (int i = 0; i < 2; ++i) { int gr = u.grow0 + h * HALF + R[i]; gr = gr < u.gcnt ? gr : u.gcnt - 1;
            __builtin_amdgcn_global_load_lds((const unsigned*)(u.gat + gr), (LAS unsigned*)(idx + (h * 2 + i) * 2048 + wofs), 4, 0, 0); }
}
__device__ __forceinline__ void arows_fetch(const LAS unsigned char* idx, unsigned (&rp)[2]) {
    int tx = (int)threadIdx.x; asm volatile("" : "+v"(tx));
    const LAS unsigned* q = (const LAS unsigned*)idx + tx;
    rp[0] = q[0] | (q[512] << 16); rp[1] = q[1024] | (q[1536] << 16);
}

template <class Epi, class Sched, bool MID, bool F8 = false, bool ALIGN = true>
__device__ __forceinline__ void gemm_phase(LAS unsigned char* lds, const int K, const Sched& S, const Epi& E, const int pitch_ = 0) {
    const int tid = threadIdx.x, wid = __builtin_amdgcn_readfirstlane(tid >> 6), lane = tid & 63, wr = wid >> 2, wc = wid & 3, fr = lane & 15, fq = lane >> 4;
#ifndef UEW_ALL
#define UEW_ALL 0
#endif
    constexpr bool UEW = F8 || UEW_ALL;
    const int nt = F8 ? K / 128 : K / BK;
    unsigned voffB[2], cpk = 0u;
    const int pitch = pitch_ ? pitch_ : (F8 ? K : 2 * K);
#pragma unroll
    for (int i = 0; i < 2; ++i) { int R, C; stage_rc(tid * 16 + i * 8192, R, C); const int Rb = Epi::PERM ? ((R & ~31) + perm32(R & 31)) : R; voffB[i] = (unsigned)(Rb * pitch + C * 2); cpk |= (unsigned)(C * 2) << (8 * i); }
    const size_t kstep = (size_t)(BK * 2);
    const size_t hstep = (size_t)HALF * pitch;
    const unsigned ldsw = (unsigned)wid * 1024u;
    const int aoff = lds_byte(wr * 64 + fr, fq * 8), boff = lds_byte(wc * 32 + fr, fq * 8);
#define PG8_SA(b, h) (((b) * 2 + (h)) * HTB)
#define PG8_SB(b, h) ((4 + (b) * 2 + (h)) * HTB)
#define PG8_STAGE(bufoff, gbase, voff) do { _Pragma("unroll") for (int _i = 0; _i < 2; ++_i) \
        __builtin_amdgcn_global_load_lds((const unsigned*)((const char*)(gbase) + (voff)[_i]), (LAS unsigned*)(lds + (bufoff) + ldsw + _i * 8192), 16, 0, 0); } while (0)
#define PG8_STAGE_A(bufoff, gbase, rpk) do { _Pragma("unroll") for (int _i = 0; _i < 2; ++_i) \
        __builtin_amdgcn_global_load_lds((const unsigned*)((const char*)(gbase) + ((unsigned)__mul24((int)(((rpk) >> (16 * _i)) & 0xffffu), pitch) + ((cpk >> (8 * _i)) & 0xffu))), (LAS unsigned*)(lds + (bufoff) + ldsw + _i * 8192), 16, 0, 0); } while (0)
#define PG8_LDA(dst, b, h) do { _Pragma("unroll") for (int m = 0; m < 4; ++m) _Pragma("unroll") for (int k = 0; k < 2; ++k) dst[m][k] = *(const LAS bf16x8*)(lds + PG8_SA(b, h) + aoff + m * 2048 + k * 1024); } while (0)
#define PG8_LDB(dst, b, h) do { _Pragma("unroll") for (int n = 0; n < 2; ++n) _Pragma("unroll") for (int k = 0; k < 2; ++k) dst[n][k] = *(const LAS bf16x8*)(lds + PG8_SB(b, h) + boff + n * 2048 + k * 1024); } while (0)
#define PG8_CAT(x) __builtin_shufflevector((i32x4)(x)[0], (i32x4)(x)[1], 0, 1, 2, 3, 4, 5, 6, 7)
#define PG8_MMA(ai, bj, At, Bt) do { __builtin_amdgcn_s_setprio(1); \
        if constexpr (F8) { _Pragma("unroll") for (int m = 0; m < 4; ++m) _Pragma("unroll") for (int n = 0; n < 2; ++n) mfma_f8_inplace(acc[ai][bj][m][n], PG8_CAT(Bt[n]), PG8_CAT(At[m]), f8sa, f8sb); } \
        else { _Pragma("unroll") for (int m = 0; m < 4; ++m) _Pragma("unroll") for (int n = 0; n < 2; ++n) _Pragma("unroll") for (int k = 0; k < 2; ++k) acc[ai][bj][m][n] = __builtin_amdgcn_mfma_f32_16x16x32_bf16(Bt[n][k], At[m][k], acc[ai][bj][m][n], 0, 0, 0); } \
        __builtin_amdgcn_s_setprio(0); } while (0)
#define PG8_WAIT_V(n) asm volatile("s_waitcnt vmcnt(" #n ")" ::: "memory")
#define PG8_WAIT_L(n) asm volatile("s_waitcnt lgkmcnt(" #n ")" ::: "memory")
#define PG8_BAR __builtin_amdgcn_s_barrier()
#define PG8_SCHED __builtin_amdgcn_sched_barrier(0)
    Unit cur, nxt; int ui = 0;
    if (!S.next(0, cur)) return;
    const int f8sa = 0x7A7A7A7A, f8sb = 0x7F7F7F7F;
    f32x4 acc[2][2][4][2];
#pragma unroll
    for (int a = 0; a < 2; ++a)
#pragma unroll
        for (int b = 0; b < 2; ++b)
#pragma unroll
            for (int m = 0; m < 4; ++m)
#pragma unroll
                for (int n = 0; n < 2; ++n) acc[a][b][m][n] = (f32x4){0.f, 0.f, 0.f, 0.f};
    bf16x8 At[4][2], B0[2][2], B1[2][2];
    unsigned oA[2];
    arows(cur, oA);
    const char* cA = cur.A; const char* cB = cur.B;
    PG8_STAGE(PG8_SB(0, 0), cB, voffB); PG8_STAGE(PG8_SB(0, 1), cB + hstep, voffB); PG8_STAGE_A(PG8_SA(0, 0), cA, oA[0]); PG8_STAGE_A(PG8_SA(0, 1), cA, oA[1]);
    if (wr == 1) PG8_BAR;
    PG8_WAIT_V(2); PG8_BAR;
    PG8_STAGE(PG8_SB(1, 0), cB + kstep, voffB); PG8_STAGE_A(PG8_SA(1, 0), cA + kstep, oA[0]); PG8_STAGE(PG8_SB(1, 1), cB + hstep + kstep, voffB);
    PG8_WAIT_V(6); PG8_BAR;
    bool has_next = false;
    unsigned nO[2] = {oA[0], oA[1]};
    if constexpr (Sched::GATHER) { has_next = S.next(1, nxt); if (has_next) arows(nxt, nO); }
    for (;;) {
        if constexpr (!Sched::GATHER) has_next = S.next(ui + 1, nxt);
        const char* nA = has_next ? nxt.A : cA; const char* nB = has_next ? nxt.B : cB;
        bool nraw_on = false;
        for (int t = 0; t < nt; t += 2) {
            const bool last = (t == nt - 2);
            if constexpr (Sched::GATHER) { if (t == 0 && has_next) { Unit t2; if (S.next(ui + 2, t2) && t2.gat) { arows_issue(t2, lds + AUX_OFF + 8192); nraw_on = true; } } }
            if (MID && t == nt / 2) E.mid(acc, cur, wr, wc, fr, fq);
            const char* a1 = cA + (size_t)(t + 1) * kstep;
            const char* a2 = last ? nA : cA + (size_t)(t + 2) * kstep; const char* b2 = last ? nB : cB + (size_t)(t + 2) * kstep;
            const char* a3 = a2 + kstep; const char* b3 = b2 + kstep;
            PG8_LDB(B0, 0, 0); PG8_LDB(B1, 0, 1); PG8_SCHED; PG8_LDA(At, 0, 0); PG8_STAGE_A(PG8_SA(1, 1), a1, oA[1]);
            PG8_WAIT_V(8);
            PG8_WAIT_L(0); PG8_BAR; PG8_MMA(0, 0, At, B0); PG8_MMA(0, 1, At, B1); PG8_BAR; PG8_SCHED;
            if constexpr (Sched::GATHER) { if (last) { oA[0] = nO[0]; oA[1] = nO[1]; } }
            PG8_LDA(At, 0, 1); PG8_STAGE(PG8_SB(0, 0), b2, voffB); PG8_STAGE(PG8_SB(0, 1), b2 + hstep, voffB); PG8_STAGE_A(PG8_SA(0, 0), a2, oA[0]);
            PG8_WAIT_V(8);
            PG8_WAIT_L(0); PG8_BAR; PG8_MMA(1, 0, At, B0); PG8_MMA(1, 1, At, B1); PG8_BAR; PG8_SCHED;
            PG8_LDB(B0, 1, 0); PG8_LDB(B1, 1, 1); PG8_SCHED; PG8_LDA(At, 1, 0); PG8_STAGE_A(PG8_SA(0, 1), a2, oA[1]);
            PG8_WAIT_V(8); PG8_WAIT_L(0); PG8_BAR; PG8_MMA(0, 0, At, B0); PG8_MMA(0, 1, At, B1); PG8_BAR; PG8_SCHED;
            PG8_LDA(At, 1, 1); PG8_STAGE(PG8_SB(1, 0), b3, voffB); PG8_STAGE(PG8_SB(1, 1), b3 + hstep, voffB); PG8_STAGE_A(PG8_SA(1, 0), a3, oA[0]);
            PG8_WAIT_V(8); PG8_WAIT_L(0); PG8_BAR; PG8_MMA(1, 0, At, B0); PG8_MMA(1, 1, At, B1); PG8_BAR; PG8_SCHED;
        }
        Unit nn; bool has_nn = false; unsigned nnO[2] = {nO[0], nO[1]};
        if constexpr (Sched::GATHER) { if (has_next) { has_nn = S.next(ui + 2, nn); if (has_nn && !nraw_on) arows(nn, nnO); } }
        f32x4 epf[6];
        E.pre(cur, wr, wc, fr, fq, epf);
        if constexpr (UEW) PG8_WAIT_V(0);
        if constexpr (Sched::GATHER) { if (has_nn && nraw_on) arows_fetch(lds + AUX_OFF + 8192, nnO); asm volatile("" : "+v"(nnO[0]), "+v"(nnO[1])); }
        if constexpr (ALIGN) { if (wr == 0) PG8_BAR; }
        if constexpr (F8) asm volatile("s_nop 15\n\ts_nop 7" ::: "memory");
        E(acc, cur, wr, wc, fr, fq, epf);
        if (!has_next) break;
#pragma unroll
        for (int a = 0; a < 2; ++a)
#pragma unroll
            for (int b = 0; b < 2; ++b)
#pragma unroll
                for (int m = 0; m < 4; ++m)
#pragma unroll
                    for (int n = 0; n < 2; ++n) acc[a][b][m][n] = (f32x4){0.f, 0.f, 0.f, 0.f};
        cur = nxt; cA = nA; cB = nB; ++ui;
        if constexpr (Sched::GATHER) { nxt = nn; has_next = has_nn; nO[0] = nnO[0]; nO[1] = nnO[1]; }
        if constexpr (ALIGN) { if (wr == 1) PG8_BAR; }
    }
    PG8_WAIT_V(0);
    if constexpr (!ALIGN) { if (wr == 0) PG8_BAR; }
    PG8_BAR;
#undef PG8_SA
#undef PG8_SB
#undef PG8_STAGE
#undef PG8_STAGE_A
#undef PG8_LDA
#undef PG8_LDB
#undef PG8_MMA
#undef PG8_CAT
#undef PG8_WAIT_V
#undef PG8_WAIT_L
#undef PG8_BAR
#undef PG8_SCHED
}
__device__ __forceinline__ void static_order(int L, int nM, int nN, int& pm, int& pn) {
    const int nwg = nM * nN; int wgid = L;
    { const int q = nwg / 8, r = nwg % 8, xcd = wgid % 8, off = wgid / 8; wgid = (xcd < r ? xcd * (q + 1) : r * (q + 1) + (xcd - r) * q) + off; }
    const int nig = 8 * nN, gid = wgid / nig, fm = gid * 8, gsz = (nM - fm) < 8 ? (nM - fm) : 8;
    pm = fm + ((wgid % nig) % gsz); pn = (wgid % nig) / gsz;
}
}
using pg8::Unit;

struct SchedInProj {
    static constexpr bool GATHER = false;
    const char *HX, *HC, *WIN; int G, c, nctx, same;
    __device__ __forceinline__ bool next(int i, Unit& u) const {
        const int L = i * G + c; if (L >= 3584 + nctx) return false;
        int pm, pn; bool ctx = false;
        if (L < 3584) { pg8::static_order(L, 128, 28, pm, pn); u.A = HX + (size_t)(same ? 0 : pm) * 256 * PA * 2; }
        else { const int r = L - 3584; pm = r >> 2; pn = 12 + (r & 3); u.A = HC + (size_t)pm * 256 * PA * 2; ctx = true; }
        u.B = WIN + (size_t)(same ? 0 : pn) * 256 * PA * 2; u.gat = nullptr; u.gcnt = 0; u.grow0 = 0; u.row0 = pm * 256; u.e = 0; u.slot0 = 0;
        if (pn < 4) { u.kind = 0; u.ocol = pn * 256; }
        else if (pn < 12) { u.kind = 1; u.ocol = (pn - 4) * 128; }
        else if (pn < 16) { u.kind = ctx ? 5 : 2; u.ocol = (pn - 12) * 256; }
        else if (pn < 20) { u.kind = 3; u.ocol = (pn - 16) * 256; }
        else { u.kind = 4; u.ocol = (pn - 20) * 128; }
        return true;
    }
};
struct SchedCtx {
    static constexpr bool GATHER = false;
    const char *HC, *WIN; int v;
    __device__ __forceinline__ bool next(int i, Unit& u) const {
        if (i > 0) return false;
        const int pm = v >> 2, pn = 12 + (v & 3);
        u.A = HC + (size_t)pm * 256 * D * 2; u.B = WIN + (size_t)pn * 256 * D * 2; u.gat = nullptr; u.gcnt = 0; u.grow0 = 0; u.row0 = pm * 256; u.e = 0; u.slot0 = 0; u.kind = 5; u.ocol = (pn - 12) * 256;
        return true;
    }
};
struct SchedDense {
    static constexpr bool GATHER = false;
    const char *A, *B; int K, G, c;
    __device__ __forceinline__ bool next(int i, Unit& u) const {
        const int L = i * G + c; if (L >= 128 * 4) return false;
        int pm, pn; pg8::static_order(L, 128, 4, pm, pn);
        u.A = A + (size_t)pm * 256 * K * 2; u.B = B + (size_t)pn * 256 * K * 2; u.gat = nullptr; u.gcnt = 0; u.grow0 = 0; u.kind = 0; u.row0 = pm * 256; u.ocol = pn * 256; u.e = 0; u.slot0 = 0;
        return true;
    }
};
constexpr int MOE_NREC = 64;
struct SchedMoe {
    static constexpr bool GATHER = true;
    const char *Abase, *W; const int* tok; const LAS int* tab; int npn, G, c, gather, wrows, esz;
    __device__ __forceinline__ bool next(int i, Unit& u) const {
#define RFL(x) __builtin_amdgcn_readfirstlane(x)
        if (i >= MOE_NREC) return false;
        const i32x4 r = *(const LAS i32x4*)(tab + 128 + 4 * i);
        if (RFL(r[0]) == 0) return false;
        const int pk = RFL(r[1]), cnt = RFL(r[2]), rb = RFL(r[3]), e = pk & 255, pn = (pk >> 8) & 255, mt = pk >> 16;
#undef RFL
        u.e = e; u.slot0 = mt * 256; u.row0 = rb; u.kind = 0; u.gcnt = cnt; u.grow0 = mt * 256;
        u.B = W + ((size_t)e * wrows + (size_t)pn * 256) * DE * esz;
        if (gather) { u.A = Abase; u.gat = tok + (size_t)e * M; u.ocol = pn * 128; }
        else { u.A = Abase + (size_t)rb * DE * esz; u.gat = nullptr; u.ocol = pn * 256; }
        return true;
    }
};
__device__ __forceinline__ void moe_tables(LAS int* tab, const unsigned* gcnt, int npn, int G = 0, int c = 0) {
    if (threadIdx.x == 0) { int pu = 0, pr = 0; for (int e = 0; e < NE; ++e) { const int cn = (int)gcnt[e], t = (cn + 255) >> 8; tab[e] = pu; tab[33 + e] = cn; tab[65 + e] = pr; pu += t * npn; pr += t * 256; } tab[32] = pu; }
    __syncthreads();
    if (G > 0 && (int)threadIdx.x < MOE_NREC) {
        const int i = (int)threadIdx.x, T = tab[32]; i32x4 r = (i32x4){0, 0, 0, 0};
        int L = -1;
        if ((G & 7) == 0) { const int x = c & 7, j = c >> 3, per = G >> 3, Q = (T + 7) >> 3, q = i * per + j; if (q < Q && x * Q + q < T) L = x * Q + q; }
        else if (i * G + c < T) L = i * G + c;
        if (L >= 0) { int e = 0;
#pragma unroll
            for (int s = 16; s >= 1; s >>= 1) if (tab[e + s] <= L) e += s;
            const int cnt = tab[33 + e], tiles = (cnt + 255) >> 8, l = L - tab[e], bm = npn == 8 ? 4 : 8;
            const int mb = l >> 5, left = tiles - bm * mb, nd = left < bm ? left : bm, rr = l - (mb << 5), pn = rr / nd, mt = bm * mb + (rr - pn * nd);
            r = (i32x4){1, e | (pn << 8) | (mt << 16), cnt, tab[65 + e] + mt * 256}; }
        *(LAS i32x4*)(tab + 128 + 4 * i) = r;
    }
    if (G > 0) __syncthreads();
}

struct EpiInProj {
    static constexpr bool PERM = true;
    unsigned char* ws; const float* bmerge; int skip;
    __device__ __forceinline__ void mid(f32x4 (&)[2][2][4][2], const Unit&, int, int, int, int) const {}
    __device__ __forceinline__ void pre(const Unit& u, int wr, int wc, int fr, int fq, f32x4 (&epf)[6]) const {
        if (u.kind == 4) { const int cl = wc * 32 + 8 * fq;
#pragma unroll
            for (int n = 0; n < 2; ++n) { epf[n] = *(const f32x4*)(bmerge + u.ocol + cl + 4 * n); epf[2 + n] = *(const f32x4*)(bmerge + D + u.ocol + cl + 4 * n); } }
    }
    __device__ __forceinline__ void operator()(const f32x4 (&acc)[2][2][4][2], const Unit& u, int wr, int wc, int fr, int fq, const f32x4 (&epf)[6]) const {
        if (skip == 1) return;
        const bool st_ = !(skip == 2 && u.row0 >= 0);
        int row0 = u.row0 + wr * 64 + fr; asm volatile("" : "+v"(row0)); const int cl = wc * 32 + 8 * fq;
        if (u.kind == 1) {
            bf16* base = (bf16*)(ws + WS_U) + u.ocol + cl;
#pragma unroll
            for (int ai = 0; ai < 2; ++ai)
#pragma unroll
                for (int m = 0; m < 4; ++m) { const f32x4 v0 = acc[ai][0][m][0] * acc[ai][1][m][0], v1 = acc[ai][0][m][1] * acc[ai][1][m][1];
                    u32x4 w; w.x = cvt_pk_bf16(v0[0], v0[1]); w.y = cvt_pk_bf16(v0[2], v0[3]); w.z = cvt_pk_bf16(v1[0], v1[1]); w.w = cvt_pk_bf16(v1[2], v1[3]);
                    if (st_) *(u32x4*)(base + (size_t)(row0 + ai * 128 + m * 16) * D) = w; }
        } else if (u.kind == 4) {
            bf16* rat = (bf16*)(ws + WS_RAT) + u.ocol + cl; bf16* sbg = (bf16*)(ws + WS_SBG) + u.ocol + cl;
            f32x4 ba[2], bb[2];
#pragma unroll
            for (int n = 0; n < 2; ++n) { ba[n] = epf[n] * -1.4426950409f; bb[n] = epf[2 + n] * -1.4426950409f; }
#pragma unroll
            for (int ai = 0; ai < 2; ++ai)
#pragma unroll
                for (int m = 0; m < 4; ++m) { f32x4 r[2], s[2];
#pragma unroll
                    for (int n = 0; n < 2; ++n)
#pragma unroll
                        for (int j = 0; j < 4; ++j) { const float ea = __builtin_amdgcn_exp2f(acc[ai][0][m][n][j] * -1.4426950409f + ba[n][j]), eb = __builtin_amdgcn_exp2f(acc[ai][1][m][n][j] * -1.4426950409f + bb[n][j]);
                            s[n][j] = __builtin_amdgcn_rcpf(1.0f + eb); r[n][j] = (1.0f + eb) * __builtin_amdgcn_rcpf(1.0f + ea); }
                    u32x4 w; w.x = cvt_pk_bf16(r[0][0], r[0][1]); w.y = cvt_pk_bf16(r[0][2], r[0][3]); w.z = cvt_pk_bf16(r[1][0], r[1][1]); w.w = cvt_pk_bf16(r[1][2], r[1][3]);
                    u32x4 x; x.x = cvt_pk_bf16(s[0][0], s[0][1]); x.y = cvt_pk_bf16(s[0][2], s[0][3]); x.z = cvt_pk_bf16(s[1][0], s[1][1]); x.w = cvt_pk_bf16(s[1][2], s[1][3]);
                    const size_t o = (size_t)(row0 + ai * 128 + m * 16) * D; if (st_) { *(u32x4*)(rat + o) = w; *(u32x4*)(sbg + o) = x; } }
        } else {
            bf16* base = (bf16*)(ws + (u.kind == 0 ? WS_GB : u.kind == 2 ? WS_ULRU : u.kind == 3 ? WS_GG : WS_CS3)) + u.ocol + cl;
            const bool gelu = u.kind == 3;
#pragma unroll
            for (int ai = 0; ai < 2; ++ai)
#pragma unroll
                for (int m = 0; m < 4; ++m)
#pragma unroll
                    for (int bj = 0; bj < 2; ++bj) { f32x4 v0 = acc[ai][bj][m][0], v1 = acc[ai][bj][m][1];
                        if (gelu) {
#pragma unroll
                            for (int j = 0; j < 4; ++j) { v0[j] = gelu_fast(v0[j]); v1[j] = gelu_fast(v1[j]); } }
                        u32x4 w; w.x = cvt_pk_bf16(v0[0], v0[1]); w.y = cvt_pk_bf16(v0[2], v0[3]); w.z = cvt_pk_bf16(v1[0], v1[1]); w.w = cvt_pk_bf16(v1[2], v1[3]);
                        if (st_) *(u32x4*)(base + (size_t)(row0 + ai * 128 + m * 16) * D + bj * 128) = w; }
        }
    }
};
struct EpiMerge {
    static constexpr bool PERM = true;
    unsigned char* ws;
    __device__ __forceinline__ void mid(f32x4 (&acc)[2][2][4][2], const Unit& u, int wr, int wc, int fr, int fq) const {
        const bf16* rat = (const bf16*)(ws + WS_RAT) + u.ocol + wc * 32 + 8 * fq; int row0 = u.row0 + wr * 64 + fr; asm volatile("" : "+v"(row0));
#pragma unroll
        for (int ai = 0; ai < 2; ++ai) {
            u32x4 w[4][2];
#pragma unroll
            for (int m = 0; m < 4; ++m)
#pragma unroll
                for (int bj = 0; bj < 2; ++bj) w[m][bj] = __builtin_nontemporal_load((const u32x4*)(rat + (size_t)(row0 + ai * 128 + m * 16) * D + bj * 128));
#pragma unroll
            for (int m = 0; m < 4; ++m)
#pragma unroll
                for (int bj = 0; bj < 2; ++bj) { const u32x4 q = w[m][bj];
                    acc[ai][bj][m][0] *= (f32x4){bflo(q.x), bfhi(q.x), bflo(q.y), bfhi(q.y)}; acc[ai][bj][m][1] *= (f32x4){bflo(q.z), bfhi(q.z), bflo(q.w), bfhi(q.w)}; }
            asm volatile("" ::: "memory"); }
    }
    __device__ __forceinline__ void pre(const Unit&, int, int, int, int, f32x4 (&)[6]) const {}
    __device__ __forceinline__ void operator()(const f32x4 (&acc)[2][2][4][2], const Unit& u, int wr, int wc, int fr, int fq, const f32x4 (&)[6]) const {
        const bf16* sbg = (const bf16*)(ws + WS_SBG) + u.ocol + wc * 32 + 8 * fq; bf16* mg = (bf16*)(ws + WS_MG) + u.ocol + wc * 32 + 8 * fq; int row0 = u.row0 + wr * 64 + fr; asm volatile("" : "+v"(row0));
#pragma unroll
        for (int ai = 0; ai < 2; ++ai) {
            u32x4 w[4][2];
#pragma unroll
            for (int m = 0; m < 4; ++m)
#pragma unroll
                for (int bj = 0; bj < 2; ++bj) w[m][bj] = __builtin_nontemporal_load((const u32x4*)(sbg + (size_t)(row0 + ai * 128 + m * 16) * D + bj * 128));
#pragma unroll
            for (int m = 0; m < 4; ++m)
#pragma unroll
                for (int bj = 0; bj < 2; ++bj) { const size_t o = (size_t)(row0 + ai * 128 + m * 16) * D + bj * 128; const u32x4 q = w[m][bj];
                    const f32x4 v0 = acc[ai][bj][m][0] * (f32x4){bflo(q.x), bfhi(q.x), bflo(q.y), bfhi(q.y)}, v1 = acc[ai][bj][m][1] * (f32x4){bflo(q.z), bfhi(q.z), bflo(q.w), bfhi(q.w)};
                    u32x4 x; x.x = cvt_pk_bf16(v0[0], v0[1]); x.y = cvt_pk_bf16(v0[2], v0[3]); x.z = cvt_pk_bf16(v1[0], v1[1]); x.w = cvt_pk_bf16(v1[2], v1[3]);
                    *(u32x4*)(mg + o) = x; }
            asm volatile("" ::: "memory"); }
    }
};

struct EpiWo {
    static constexpr bool PERM = false;
    const float* x; bf16* out; const float* mx;
    __device__ __forceinline__ void mid(f32x4 (&)[2][2][4][2], const Unit&, int, int, int, int) const {}
    __device__ __forceinline__ void pre(const Unit& u, int wr, int wc, int fr, int fq, f32x4 (&epf)[6]) const {
        const float* gp = mx + (u.row0 / SEQ) * 6144 + 2 * 1024 + u.ocol + wc * 32 + 4 * fq;
#pragma unroll
        for (int bj = 0; bj < 2; ++bj)
#pragma unroll
            for (int n = 0; n < 2; ++n) epf[bj * 2 + n] = *(const f32x4*)(gp + bj * 128 + n * 16);
    }
    __device__ __forceinline__ void operator()(const f32x4 (&acc)[2][2][4][2], const Unit& u, int wr, int wc, int fr, int fq, const f32x4 (&epf)[6]) const {
        int row0 = u.row0 + wr * 64 + fr; asm volatile("" : "+v"(row0)); const int col0 = u.ocol + wc * 32 + 4 * fq;
        f32x4 g[2][2];
#pragma unroll
        for (int bj = 0; bj < 2; ++bj)
#pragma unroll
            for (int n = 0; n < 2; ++n) g[bj][n] = epf[bj * 2 + n];
#pragma unroll
        for (int ai = 0; ai < 2; ++ai)
#pragma unroll
            for (int m2 = 0; m2 < 4; m2 += 2) { f32x4 xv[2][2][2];
#pragma unroll
                for (int mm = 0; mm < 2; ++mm)
#pragma unroll
                    for (int bj = 0; bj < 2; ++bj)
#pragma unroll
                        for (int n = 0; n < 2; ++n) xv[mm][bj][n] = __builtin_nontemporal_load((const f32x4*)(x + (size_t)(row0 + ai * 128 + (m2 + mm) * 16) * D + col0 + bj * 128 + n * 16));
#pragma unroll
                for (int mm = 0; mm < 2; ++mm)
#pragma unroll
                    for (int bj = 0; bj < 2; ++bj)
#pragma unroll
                        for (int n = 0; n < 2; ++n) { const f32x4 o = xv[mm][bj][n] + g[bj][n] * acc[ai][bj][m2 + mm][n]; u32x2 w; w.x = cvt_pk_bf16(o[0], o[1]); w.y = cvt_pk_bf16(o[2], o[3]);
                            *(u32x2*)(out + (size_t)(row0 + ai * 128 + (m2 + mm) * 16) * D + col0 + bj * 128 + n * 16) = w; }
                asm volatile("" ::: "memory"); }
    }
};
struct EpiMoe1 {
    static constexpr bool PERM = true;
    unsigned char* ws; const float* b1;
    __device__ __forceinline__ void mid(f32x4 (&)[2][2][4][2], const Unit&, int, int, int, int) const {}
    __device__ __forceinline__ void pre(const Unit& u, int wr, int wc, int fr, int fq, f32x4 (&epf)[6]) const {
        const float* bp = b1 + (size_t)u.e * 2048 + 2 * (u.ocol + wc * 32 + 8 * fq);
#pragma unroll
        for (int i = 0; i < 4; ++i) epf[i] = *(const f32x4*)(bp + 4 * i);
    }
    __device__ __forceinline__ void operator()(const f32x4 (&acc)[2][2][4][2], const Unit& u, int wr, int wc, int fr, int fq, const f32x4 (&epf)[6]) const {
        int row0 = u.row0 + wr * 64 + fr; asm volatile("" : "+v"(row0)); const int j0 = u.ocol + wc * 32 + 8 * fq;
        f32x4 bv[4];
#pragma unroll
        for (int i = 0; i < 4; ++i) bv[i] = epf[i];
        unsigned char* base = ws + WS_ACT + j0;
#pragma unroll
        for (int ai = 0; ai < 2; ++ai)
#pragma unroll
            for (int m = 0; m < 4; ++m) { f32x4 a[2];
#pragma unroll
                for (int n = 0; n < 2; ++n)
#pragma unroll
                    for (int jj = 0; jj < 4; ++jj) { const float hg = acc[ai][0][m][n][jj] + bv[2 * n + (jj >> 1)][2 * (jj & 1)], hl = acc[ai][1][m][n][jj] + bv[2 * n + (jj >> 1)][2 * (jj & 1) + 1];
                        const float glu = fminf(hg, 7.0f), lin = fminf(fmaxf(hl, -7.0f), 7.0f);
                        a[n][jj] = glu * fsig(1.702f * glu) * (lin + 1.0f); }
                u32x2 w; w.x = pk4_fp8(a[0][0], a[0][1], a[0][2], a[0][3]); w.y = pk4_fp8(a[1][0], a[1][1], a[1][2], a[1][3]);
                *(u32x2*)(base + (size_t)(row0 + ai * 128 + m * 16) * DE) = w; }
    }
};
struct EpiMoe2 {
    static constexpr bool PERM = true;
    unsigned char* ws; const float* b2;
    __device__ __forceinline__ void mid(f32x4 (&)[2][2][4][2], const Unit&, int, int, int, int) const {}
    __device__ __forceinline__ void pre(const Unit& u, int wr, int wc, int fr, int fq, f32x4 (&epf)[6]) const {
        const float* bp = b2 + (size_t)u.e * D + u.ocol + wc * 32 + 8 * fq; const float* gp = (const float*)(ws + WS_GATE) + (size_t)u.e * M + u.slot0 + wr * 64 + fr;
#pragma unroll
        for (int bj = 0; bj < 2; ++bj)
#pragma unroll
            for (int n = 0; n < 2; ++n) epf[bj * 2 + n] = *(const f32x4*)(bp + bj * 128 + 4 * n);
#pragma unroll
        for (int ai = 0; ai < 2; ++ai) epf[4 + ai] = (f32x4){gp[ai * 128], gp[ai * 128 + 16], gp[ai * 128 + 32], gp[ai * 128 + 48]};
    }
    __device__ __forceinline__ void operator()(const f32x4 (&acc)[2][2][4][2], const Unit& u, int wr, int wc, int fr, int fq, const f32x4 (&epf)[6]) const {
        int rl = wr * 64 + fr; asm volatile("" : "+v"(rl)); const int c0 = u.ocol + wc * 32 + 8 * fq;
        f32x4 bv[2][2]; float g[2][4];
#pragma unroll
        for (int bj = 0; bj < 2; ++bj)
#pragma unroll
            for (int n = 0; n < 2; ++n) bv[bj][n] = epf[bj * 2 + n];
#pragma unroll
        for (int ai = 0; ai < 2; ++ai)
#pragma unroll
            for (int m = 0; m < 4; ++m) g[ai][m] = epf[4 + ai][m];
        unsigned char* base = ws + WS_OUTP + c0;
#pragma unroll
        for (int ai = 0; ai < 2; ++ai)
#pragma unroll
            for (int m = 0; m < 4; ++m) {
#pragma unroll
                for (int bj = 0; bj < 2; ++bj) { const f32x4 v0 = (acc[ai][bj][m][0] + bv[bj][0]) * g[ai][m], v1 = (acc[ai][bj][m][1] + bv[bj][1]) * g[ai][m];
                    u32x2 w; w.x = pk4_fp8(v0[0], v0[1], v0[2], v0[3]); w.y = pk4_fp8(v1[0], v1[1], v1[2], v1[3]);
                    *(u32x2*)(base + (size_t)(u.row0 + rl + ai * 128 + m * 16) * D + bj * 128) = w; } }
    }
};

#define XB_TMO      128
#define XB_XCNT(j)  (256  + 64 * (j))
#define XB_XSUB(j)  (1280 + 64 * (j))
#define XB_XGEN(j)  (2304 + 64 * (j))
#define XB_TOP      3328
#define XB_TOPGEN   3392
#define XCD_BAR_WORDS 3456
#define XB_SPIN_CAP (1u << 18)
__device__ __forceinline__ unsigned xb_ld(unsigned* p)              { return __hip_atomic_load(p, __ATOMIC_RELAXED, __HIP_MEMORY_SCOPE_AGENT); }
__device__ __forceinline__ unsigned xb_add(unsigned* p, unsigned v) { return __hip_atomic_fetch_add(p, v, __ATOMIC_RELAXED, __HIP_MEMORY_SCOPE_AGENT); }
__device__ __forceinline__ unsigned xb_xcc_id() { return (unsigned)__builtin_amdgcn_s_getreg((3 << 11) | 20) & 0xFu; }
#define XB_SPIN(cond, bar) do { unsigned _sp = 0; while (cond) { __builtin_amdgcn_s_sleep(1); \
    if ((++_sp & 255u) == 0u) { if (xb_ld(&(bar)[XB_TMO])) break; if (_sp > XB_SPIN_CAP) { atomicAdd(&(bar)[XB_TMO], 1u); break; } } } } while (0)
struct XcdBarrier { unsigned* bar; unsigned x; volatile LAS unsigned* st; };
__device__ __forceinline__ XcdBarrier xcd_barrier_post(unsigned* bar, volatile LAS unsigned* st) {
    XcdBarrier b; b.bar = bar; b.x = xb_xcc_id(); b.st = st;
    if (threadIdx.x == 0) (void)xb_add(&bar[XB_XCNT(b.x)], 1u);
    return b;
}
__device__ __forceinline__ void xcd_barrier_complete(unsigned* bar, unsigned x, unsigned& nloc, unsigned& nx) {
    const unsigned G = gridDim.x * gridDim.y * gridDim.z;
    unsigned sum, cnt, mine, sp = 0u;
    for (;;) {
        sum = 0u; cnt = 0u; mine = 0u;
#pragma unroll
        for (unsigned j = 0; j < 16; ++j) { const unsigned c = xb_ld(&bar[XB_XCNT(j)]); sum += c; cnt += (c > 0u) ? 1u : 0u; mine = (j == x) ? c : mine; }
        if (sum == G) break;
        __builtin_amdgcn_s_sleep(1);
        if ((++sp & 255u) == 0u) { if (xb_ld(&bar[XB_TMO])) break; if (sp > XB_SPIN_CAP) { atomicAdd(&bar[XB_TMO], 1u); break; } }
    }
    nloc = mine > 0u ? mine : 1u; nx = cnt > 0u ? cnt : 1u;
}
__device__ __forceinline__ void xcd_barrier(const XcdBarrier& b) {
    asm volatile("s_waitcnt vmcnt(0)" ::: "memory");
    __syncthreads();
    if (threadIdx.x == 0) {
        unsigned* bar = b.bar;
        __builtin_amdgcn_s_waitcnt(0);
        unsigned nloc = b.st[0], nx = b.st[1];
        if (nloc == 0u) { xcd_barrier_complete(bar, b.x, nloc, nx); b.st[0] = nloc; b.st[1] = nx; }
        const unsigned old = xb_add(&bar[XB_XSUB(b.x)], 1u);
        const unsigned gen = old / nloc;
        if (old + 1u == (gen + 1u) * nloc) {
            __builtin_amdgcn_fence(__ATOMIC_RELEASE, "agent");
            asm volatile("s_waitcnt vmcnt(0)" ::: "memory");
            const unsigned og = xb_add(&bar[XB_TOP], 1u);
            const unsigned tg = og / nx;
            if (og + 1u == (tg + 1u) * nx) xb_add(&bar[XB_TOPGEN], 1u);
            else XB_SPIN(xb_ld(&bar[XB_TOPGEN]) == tg, bar);
            __builtin_amdgcn_fence(__ATOMIC_ACQUIRE, "agent");
            xb_add(&bar[XB_XGEN(b.x)], 1u);
            asm volatile("s_waitcnt vmcnt(0)" ::: "memory");
        } else {
            XB_SPIN(xb_ld(&bar[XB_XGEN(b.x)]) == gen, bar);
            __builtin_amdgcn_fence(__ATOMIC_ACQUIRE, "agent");
            asm volatile("s_waitcnt vmcnt(0)" ::: "memory");
        }
    }
    __syncthreads();
}

struct Frame {
    LAS unsigned char* lds; const P& p;
    int tid, lane, wave, vcu, G, var;
};

template <class RowMap>
__device__ __forceinline__ void p0_transpose_item(const float* W, int N, bf16* WT, int ldt, int coloff, LAS float* scr, int kb, int nb, int lane, RowMap rm) {
    const int k0 = 64 * kb, n0 = 32 * nb;
    float v[32];
#pragma unroll
    for (int i = 0; i < 32; ++i) { const int kk = 2 * i + (lane >> 5); v[i] = W[(size_t)(k0 + kk) * N + n0 + (lane & 31)]; }
#pragma unroll
    for (int i = 0; i < 32; ++i) { const int kk = 2 * i + (lane >> 5); scr[kk * 33 + (lane & 31)] = v[i]; }
    LDS_WAIT(); asm volatile("" ::: "memory");
    const int c = lane & 7;
#pragma unroll
    for (int j = 0; j < 4; ++j) { const int n = (lane >> 3) + 8 * j; const LAS float* s = scr + (8 * c) * 33 + n;
        u32x4 o; o.x = pk2(s[0 * 33], s[1 * 33]); o.y = pk2(s[2 * 33], s[3 * 33]); o.z = pk2(s[4 * 33], s[5 * 33]); o.w = pk2(s[6 * 33], s[7 * 33]);
        *(u32x4*)(WT + (size_t)rm(n0 + n) * ldt + coloff + k0 + 8 * c) = o; }
    LDS_WAIT(); asm volatile("" ::: "memory");
}
template <class RowMap>
__device__ __forceinline__ void p0_transpose_item_f8(const float* W, int N, unsigned char* WT, int ldt, LAS float* scr, int kb, int nb, int lane, RowMap rm) {
    const int k0 = 64 * kb, n0 = 32 * nb;
    float v[32];
#pragma unroll
    for (int i = 0; i < 32; ++i) { const int kk = 2 * i + (lane >> 5); v[i] = W[(size_t)(k0 + kk) * N + n0 + (lane & 31)]; }
#pragma unroll
    for (int i = 0; i < 32; ++i) { const int kk = 2 * i + (lane >> 5); scr[kk * 33 + (lane & 31)] = v[i] * 32.0f; }
    LDS_WAIT(); asm volatile("" ::: "memory");
    const int c = lane & 3;
#pragma unroll
    for (int j = 0; j < 2; ++j) { const int n = (lane >> 2) + 16 * j; const LAS float* s = scr + (16 * c) * 33 + n;
        u32x4 o; o.x = pk4_fp8(s[0 * 33], s[1 * 33], s[2 * 33], s[3 * 33]); o.y = pk4_fp8(s[4 * 33], s[5 * 33], s[6 * 33], s[7 * 33]);
        o.z = pk4_fp8(s[8 * 33], s[9 * 33], s[10 * 33], s[11 * 33]); o.w = pk4_fp8(s[12 * 33], s[13 * 33], s[14 * 33], s[15 * 33]);
        *(u32x4*)(WT + (size_t)rm(n0 + n) * ldt + k0 + 16 * c) = o; }
    LDS_WAIT(); asm volatile("" ::: "memory");
}
struct RmId { __device__ __forceinline__ int operator()(int n) const { return n; } };
struct RmWin { __device__ __forceinline__ int operator()(int n) const { const int g = n >> 10, ch = n & 1023;
    return g == 0 ? ch : g == 1 ? 1024 + 256 * (ch >> 7) + (ch & 127) : g == 2 ? 1024 + 256 * (ch >> 7) + 128 + (ch & 127) : g == 3 ? 3072 + ch : g == 4 ? 4096 + ch : g == 5 ? 5120 + 256 * (ch >> 7) + (ch & 127) : 5120 + 256 * (ch >> 7) + 128 + (ch & 127); } };
struct RmW1 { __device__ __forceinline__ int operator()(int n) const { const int j = n >> 1, h = n & 1; return 256 * (j >> 7) + 128 * h + (j & 127); } };
struct RmGen { int kind, off; __device__ __forceinline__ int operator()(int n) const { return kind == 1 ? RmWin{}(n) : kind == 2 ? RmW1{}(n) : off + n; } };

constexpr int I_ADA = 96 * 8, I_WIN = 16 * 224, I_WA = 16 * 32, I_WO = 16 * 32, I_W1 = NE * 16 * 64, I_W2 = NE * 16 * 32, I_LG = 2 * 16 * 2 * 2;
constexpr int P0_ITEMS = I_ADA + I_WIN + 2 * I_WA + I_WO + I_LG;
constexpr size_t WS_RTAB = WS_MX + 256 * 1024;
constexpr size_t WS_WG = 15 * MiB + 512 * 1024;

struct P0Desc { const float* src; unsigned char* dst; int N, ldtb, n0, rmk, roff, f8; float sc; };
__device__ __forceinline__ P0Desc p0_describe(const P& p, int r) {
    const float* W; int N, ldt, coloff = 0, kb, nb, rmk = 0, roff = 0, f8 = 0; unsigned char* WT; float sc = 1.0f;
    if (r < I_WIN) { W = p.w_in; N = INC; WT = p.ws + WS_WIN; ldt = PA; kb = r / 224; nb = r % 224; rmk = 1; }
    else if ((r -= I_WIN) < I_WA) { W = p.w_out_a; N = D; WT = p.ws + WS_WAB; ldt = 2048; kb = r >> 5; nb = r & 31; }
    else if ((r -= I_WA) < I_WA) { W = p.w_out_b; N = D; WT = p.ws + WS_WAB; ldt = 2048; coloff = 1024; kb = r >> 5; nb = r & 31; }
    else if ((r -= I_WA) < I_WO) { W = p.w_o; N = D; WT = p.ws + WS_WO; ldt = D; kb = r >> 5; nb = r & 31; }
    else { r -= I_WO; const int gate = (r >> 1) & 1, db = r >> 2;
        W = (gate ? p.lru_wx : p.lru_wa) + (size_t)db * 4096; N = 64; WT = p.ws + WS_WG + (size_t)db * 128 * 64 * 2; ldt = 64; kb = 0; nb = r & 1; roff = gate * 64; sc = -1.4426950408889634f; }
    const int esz = f8 ? 1 : 2;
    return P0Desc{W + (size_t)(64 * kb) * N + 32 * nb, WT + (size_t)(coloff + 64 * kb) * esz, N, ldt * esz, 32 * nb, rmk, roff, f8, f8 ? 32.0f : sc};
}
__device__ __forceinline__ void p0_prologue(Frame& F) {
    const P& p = F.p; const int lane = F.lane;
    LAS float* sil = (LAS float*)(F.lds + AUX_OFF);
    for (int i = F.tid; i < 5 * D; i += NTHR) { const int r = i >> 10, k = i & 1023; const float v = r < 4 ? p.c[r * D + k] : p.c_ctx[k]; sil[i] = v * sigmoidf_(v); }
    __syncthreads();
    for (int i = F.vcu * NTHR + F.tid; i < D * NE; i += F.G * NTHR) {
        const int e = i & 31, k = i >> 5; const float w = p.router_w[i]; const bf16 hi = f2bf(w), lo = f2bf(w - bf2f(hi));
        const int off = e * 2048 + ((((k >> 3) ^ (e & 15))) << 4) + (k & 7) * 2; *(bf16*)(p.ws + WS_RTAB + off) = hi; *(bf16*)(p.ws + WS_RTAB + 65536 + off) = lo; }
    LAS float* scr = (LAS float*)(F.lds + F.wave * 16384);
    const int gw = F.vcu * NWAVES + F.wave, NGW = F.G * NWAVES;
    int it = gw;
    for (; it < I_ADA; it += NGW) {
        const int cg = it % 96, ks = it / 96, n = 64 * cg + lane, k0 = 128 * ks; float a[5] = {0.f, 0.f, 0.f, 0.f, 0.f};
        for (int kh = 0; kh < 4; ++kh) {
            float w[32];
#pragma unroll
            for (int j = 0; j < 32; ++j) w[j] = __builtin_nontemporal_load(&p.w_ada[(size_t)(k0 + 32 * kh + j) * 6144 + n]);
#pragma unroll
            for (int j4 = 0; j4 < 8; ++j4)
#pragma unroll
                for (int rr = 0; rr < 5; ++rr) { const f32x4 s = *(const LAS f32x4*)(sil + rr * D + k0 + 32 * kh + 4 * j4); a[rr] += s[0] * w[4 * j4] + s[1] * w[4 * j4 + 1] + s[2] * w[4 * j4 + 2] + s[3] * w[4 * j4 + 3]; }
        }
        float* part = (float*)(p.ws + WS_RAT);
#pragma unroll
        for (int rr = 0; rr < 5; ++rr) __hip_atomic_store(&part[(size_t)(ks * 5 + rr) * 6144 + n], a[rr], __ATOMIC_RELAXED, __HIP_MEMORY_SCOPE_AGENT);
        VM_WAIT();
        unsigned tk = 0; if (lane == 0) tk = __hip_atomic_fetch_add((unsigned*)(p.ws + WS_CTL) + 17408 + cg, 1u, __ATOMIC_RELAXED, __HIP_MEMORY_SCOPE_AGENT);
        tk = __builtin_amdgcn_readfirstlane(tk);
        if (tk == 7u) {
            float* mx = (float*)(p.ws + WS_MX); const float bias = p.b_ada[n];
#pragma unroll
            for (int rr = 0; rr < 5; ++rr) { float sacc = bias;
#pragma unroll
                for (int k2 = 0; k2 < 8; ++k2) sacc += __hip_atomic_load(&part[(size_t)(k2 * 5 + rr) * 6144 + n], __ATOMIC_RELAXED, __HIP_MEMORY_SCOPE_AGENT);
                mx[rr * 6144 + n] = sacc; }
        }
    }
    if (it >= P0_ITEMS) return;
    P0Desc cur = p0_describe(p, it - I_ADA);
    float v[32];
#pragma unroll
    for (int i = 0; i < 32; ++i) v[i] = __builtin_nontemporal_load(&cur.src[(size_t)(2 * i + (lane >> 5)) * cur.N + (lane & 31)]);
    for (;;) {
        const int itn = it + NGW; const bool more = itn < P0_ITEMS;
        P0Desc nxt = cur; float vn[32];
        if (more) { nxt = p0_describe(p, itn - I_ADA);
#pragma unroll
            for (int i = 0; i < 32; ++i) vn[i] = __builtin_nontemporal_load(&nxt.src[(size_t)(2 * i + (lane >> 5)) * nxt.N + (lane & 31)]); }
        const float sc = cur.sc;
#pragma unroll
        for (int i = 0; i < 32; ++i) scr[(2 * i + (lane >> 5)) * 33 + (lane & 31)] = v[i] * sc;
        LDS_WAIT(); asm volatile("" ::: "memory");
        if (cur.f8) {
            const int c = lane & 3;
#pragma unroll
            for (int j = 0; j < 2; ++j) { const int n = (lane >> 2) + 16 * j; const LAS float* s = scr + (16 * c) * 33 + n;
                u32x4 o; o.x = pk4_fp8(s[0 * 33], s[1 * 33], s[2 * 33], s[3 * 33]); o.y = pk4_fp8(s[4 * 33], s[5 * 33], s[6 * 33], s[7 * 33]);
                o.z = pk4_fp8(s[8 * 33], s[9 * 33], s[10 * 33], s[11 * 33]); o.w = pk4_fp8(s[12 * 33], s[13 * 33], s[14 * 33], s[15 * 33]);
                *(u32x4*)(cur.dst + (size_t)RmGen{cur.rmk, cur.roff}(cur.n0 + n) * cur.ldtb + 16 * c) = o; }
        } else {
            const int c = lane & 7;
#pragma unroll
            for (int j = 0; j < 4; ++j) { const int n = (lane >> 3) + 8 * j; const LAS float* s = scr + (8 * c) * 33 + n;
                u32x4 o; o.x = pk2(s[0 * 33], s[1 * 33]); o.y = pk2(s[2 * 33], s[3 * 33]); o.z = pk2(s[4 * 33], s[5 * 33]); o.w = pk2(s[6 * 33], s[7 * 33]);
#ifdef EXP_Q8
                if (cur.rmk == 1 && ((EXP_Q8 >> ((cur.n0 + n) >> 10)) & 1)) {
#define Q8W(x) (__builtin_amdgcn_cvt_f32_fp8(__builtin_amdgcn_cvt_pk_fp8_f32((x) * 32.0f, 0.f, 0, false), 0) * 0.03125f)
                    o.x = pk2(Q8W(s[0 * 33]), Q8W(s[1 * 33])); o.y = pk2(Q8W(s[2 * 33]), Q8W(s[3 * 33])); o.z = pk2(Q8W(s[4 * 33]), Q8W(s[5 * 33])); o.w = pk2(Q8W(s[6 * 33]), Q8W(s[7 * 33])); }
#endif
                *(u32x4*)(cur.dst + (size_t)RmGen{cur.rmk, cur.roff}(cur.n0 + n) * cur.ldtb + 16 * c) = o; }
        }
        LDS_WAIT(); asm volatile("" ::: "memory");
        if (!more) break;
#pragma unroll
        for (int i = 0; i < 32; ++i) v[i] = vn[i];
        cur = nxt; it = itn;
    }
}

__device__ __forceinline__ void p1_row(const float* src, bf16* dst, const f32x4 (&am)[4], const f32x4 (&sh)[4], int lane) {
    f32x4 v[4]; float s = 0.f;
#pragma unroll
    for (int j = 0; j < 4; ++j) { v[j] = *(const f32x4*)(src + 4 * lane + 256 * j); s += (v[j][0] * v[j][0] + v[j][1] * v[j][1]) + (v[j][2] * v[j][2] + v[j][3] * v[j][3]); }
    const float rstd = rsqrtf(wave_sum(s) * (1.0f / D) + EPS);
#pragma unroll
    for (int j = 0; j < 4; ++j) { const f32x4 o = v[j] * rstd * am[j] + sh[j]; u32x2 w; w.x = cvt_pk_bf16(o[0], o[1]); w.y = cvt_pk_bf16(o[2], o[3]); *(u32x2*)(dst + 4 * lane + 256 * j) = w; }
}
__device__ __forceinline__ void p1_mods(const P& p, int b, int lane, f32x4 (&am)[4], f32x4 (&sh)[4]) {
    const float* md = (const float*)(p.ws + WS_MX) + b * 6144;
#pragma unroll
    for (int j = 0; j < 4; ++j) { const int k = 4 * lane + 256 * j; const f32x4 g = *(const f32x4*)(p.norm_mix + k), sc = *(const f32x4*)(md + 1024 + k); am[j] = g * (sc + 1.0f); sh[j] = *(const f32x4*)(md + k); }
}
__device__ __forceinline__ void p1_rows4(const float* src0, bf16* dst0, int r, int rs, int rend, const f32x4 (&am)[4], const f32x4 (&sh)[4], int lane) {
    f32x4 v[4][4]; float s[4];
#pragma unroll
    for (int q = 0; q < 4; ++q) { const int rr = r + q * rs; s[q] = 0.f;
#pragma unroll
        for (int j = 0; j < 4; ++j) v[q][j] = rr < rend ? __builtin_nontemporal_load((const f32x4*)(src0 + (size_t)rr * D + 4 * lane + 256 * j)) : (f32x4){0.f, 0.f, 0.f, 0.f}; }
#pragma unroll
    for (int q = 0; q < 4; ++q) {
#pragma unroll
        for (int j = 0; j < 4; ++j) s[q] += (v[q][j][0] * v[q][j][0] + v[q][j][1] * v[q][j][1]) + (v[q][j][2] * v[q][j][2] + v[q][j][3] * v[q][j][3]); }
#pragma unroll
    for (int o = 1; o < 64; o <<= 1) {
#pragma unroll
        for (int q = 0; q < 4; ++q) s[q] += __shfl_xor(s[q], o); }
#pragma unroll
    for (int q = 0; q < 4; ++q) { const int rr = r + q * rs; if (rr >= rend) continue; const float rstd = rsqrtf(s[q] * (1.0f / D) + EPS); bf16* dst = dst0 + (size_t)rr * PA;
#pragma unroll
        for (int j = 0; j < 4; ++j) { f32x4 o = v[q][j] * rstd * am[j] + sh[j];
#ifdef EXP_Q8
            if (EXP_Q8 & 128) {
#pragma unroll
                for (int e = 0; e < 4; ++e) o[e] = __builtin_amdgcn_cvt_f32_fp8(__builtin_amdgcn_cvt_pk_fp8_f32(o[e], 0.f, 0, false), 0); }
#endif
            u32x2 w; w.x = cvt_pk_bf16(o[0], o[1]); w.y = cvt_pk_bf16(o[2], o[3]); *(u32x2*)(dst + 4 * lane + 256 * j) = w; } }
}
__device__ __forceinline__ void p1_rows(Frame& F) {
    const P& p = F.p; const int lane = F.lane;
    const int gw = F.vcu * NWAVES + F.wave, NGW = F.G * NWAVES;
    f32x4 am[4], sh[4];
    for (int b = 0; b < NB; ++b) {
        p1_mods(p, b, lane, am, sh);
        for (int r = gw; r < SEQ; r += 4 * NGW) p1_rows4(p.x + (size_t)b * SEQ * D, (bf16*)(p.ws + WS_HXP) + (size_t)b * SEQ * PA, r, NGW, SEQ, am, sh, lane);
    }
    p1_mods(p, 4, lane, am, sh);
    for (int r = gw; r < MC; r += 4 * NGW) p1_rows4(p.ctx, (bf16*)(p.ws + WS_HC), r, NGW, MC, am, sh, lane);
}
__device__ __forceinline__ void p1_ctx_rows(Frame& F, int pm) {
    const P& p = F.p; const int lane = F.lane; f32x4 am[4], sh[4];
    p1_mods(p, 4, lane, am, sh);
    for (int r0 = pm * 256 + F.wave * 32; r0 < pm * 256 + F.wave * 32 + 32; r0 += 4) {
        f32x4 v[4][4]; float s[4];
#pragma unroll
        for (int r = 0; r < 4; ++r) { const float* src = p.ctx + (size_t)(r0 + r) * D; s[r] = 0.f;
#pragma unroll
            for (int j = 0; j < 4; ++j) v[r][j] = *(const f32x4*)(src + 4 * lane + 256 * j); }
#pragma unroll
        for (int r = 0; r < 4; ++r) {
#pragma unroll
            for (int j = 0; j < 4; ++j) s[r] += (v[r][j][0] * v[r][j][0] + v[r][j][1] * v[r][j][1]) + (v[r][j][2] * v[r][j][2] + v[r][j][3] * v[r][j][3]); }
#pragma unroll
        for (int o = 1; o < 64; o <<= 1) {
#pragma unroll
            for (int r = 0; r < 4; ++r) s[r] += __shfl_xor(s[r], o); }
#pragma unroll
        for (int r = 0; r < 4; ++r) { const float rstd = rsqrtf(s[r] * (1.0f / D) + EPS); bf16* dst = (bf16*)(p.ws + WS_HC) + (size_t)(r0 + r) * PA;
#pragma unroll
            for (int j = 0; j < 4; ++j) { const f32x4 o = v[r][j] * rstd * am[j] + sh[j]; u32x2 w; w.x = cvt_pk_bf16(o[0], o[1]); w.y = cvt_pk_bf16(o[2], o[3]); *(u32x2*)(dst + 4 * lane + 256 * j) = w; } }
    }
}

__device__ __forceinline__ unsigned dpp_max_u32(unsigned x) {
    x = max(x, (unsigned)__builtin_amdgcn_update_dpp(0, (int)x, 0xB1, 0xF, 0xF, false));
    x = max(x, (unsigned)__builtin_amdgcn_update_dpp(0, (int)x, 0x4E, 0xF, 0xF, false));
    x = max(x, (unsigned)__builtin_amdgcn_update_dpp(0, (int)x, 0x141, 0xF, 0xF, false));
    x = max(x, (unsigned)__builtin_amdgcn_update_dpp(0, (int)x, 0x140, 0xF, 0xF, false));
    return x;
}
__device__ __forceinline__ unsigned rkey(float v, int e) { unsigned u = __float_as_uint(v); u = (u & 0x80000000u) ? ~u : (u | 0x80000000u); return (u & ~31u) | (unsigned)(31 - e); }
__device__ __forceinline__ float rkey_val(unsigned k) { const unsigned u = k & ~31u; return __uint_as_float((u & 0x80000000u) ? (u & 0x7fffffffu) : ~u); }
__device__ __forceinline__ void p6_route(Frame& F) {
    const P& p = F.p; const int tid = F.tid, lane = F.lane, wave = F.wave;
    LAS unsigned char* WH = F.lds; LAS unsigned char* WL = F.lds + 65536;
    for (int i = tid; i < 8192; i += NTHR) *(LAS u32x4*)(F.lds + i * 16) = *(const u32x4*)(p.ws + WS_RTAB + (size_t)i * 16);
    LAS int* cntl = (LAS int*)(F.lds + AUX_OFF);
    LAS int* basel = cntl + 32;
    LAS int* sel_e = cntl + 64; LAS int* sel_r = sel_e + 512; LAS float* sel_g = (LAS float*)(sel_r + 512);
    LAS f32x4* amsh = (LAS f32x4*)(F.lds + AUX_OFF + 8192);
    unsigned* gcnt = (unsigned*)(p.ws + WS_CTL) + CW_CNT;
    const float* mxall = (const float*)(p.ws + WS_MX);
    for (int rg = F.vcu; rg < M / 128; rg += F.G) {
        int tv = F.tid; asm volatile("" : "+v"(tv));
        const int lv = tv & 63;
        __syncthreads();
        if (tv < 32) cntl[tv] = 0;
        const int b = (rg * 128) / SEQ; const float* md = mxall + b * 6144;
        if (wave == 0) {
#pragma unroll
            for (int j = 0; j < 4; ++j) { const int k = 4 * lv + 256 * j; const f32x4 g = *(const f32x4*)(p.norm_ffn + k), sc = *(const f32x4*)(md + 4 * 1024 + k); amsh[j * 64 + lv] = g * (sc + 1.0f); amsh[(4 + j) * 64 + lv] = *(const f32x4*)(md + 3 * 1024 + k); }
        }
        __syncthreads();
        const int row0 = rg * 128 + wave * 16;
        const int er = lv & 15, rq = lv >> 4;
        u32x4 xv[32];
        { const bf16* xr = (const bf16*)(p.ws + WS_X1) + (size_t)(row0 + er) * D + 8 * rq;
#pragma unroll
          for (int s_ = 0; s_ < 32; ++s_) xv[s_] = __builtin_nontemporal_load((const u32x4*)(xr + 32 * s_)); }
        float ss0 = 0.f, ss1 = 0.f;
#pragma unroll
        for (int s_ = 0; s_ < 32; ++s_) { const u32x4 w = xv[s_];
            ss0 += (bflo(w.x) * bflo(w.x) + bfhi(w.x) * bfhi(w.x)) + (bflo(w.y) * bflo(w.y) + bfhi(w.y) * bfhi(w.y));
            ss1 += (bflo(w.z) * bflo(w.z) + bfhi(w.z) * bfhi(w.z)) + (bflo(w.w) * bflo(w.w) + bfhi(w.w) * bfhi(w.w)); }
#pragma unroll
        for (int s_ = 0; s_ < 32; ++s_) asm volatile("" : "+v"(xv[s_]));
        float ssq = ss0 + ss1; ssq += __shfl_xor(ssq, 16); ssq += __shfl_xor(ssq, 32);
        const float rstd = rsqrtf(ssq * (1.0f / D) + EPS);
        { const LAS float* amf = (const LAS float*)amsh; unsigned char* fx8 = p.ws + WS_FX8 + (size_t)(row0 + er) * D + 8 * rq;
#pragma unroll
          for (int s_ = 0; s_ < 32; ++s_) { const int k = 32 * s_ + 8 * rq; const u32x4 w = xv[s_];
            const f32x4 am0 = *(const LAS f32x4*)(amf + k), am1 = *(const LAS f32x4*)(amf + k + 4), sh0 = *(const LAS f32x4*)(amf + 1024 + k), sh1 = *(const LAS f32x4*)(amf + 1024 + k + 4);
            const f32x4 o0 = (f32x4){bflo(w.x), bfhi(w.x), bflo(w.y), bfhi(w.y)} * rstd * am0 + sh0, o1 = (f32x4){bflo(w.z), bfhi(w.z), bflo(w.w), bfhi(w.w)} * rstd * am1 + sh1;
            xv[s_] = (u32x4){cvt_pk_bf16(o0[0], o0[1]), cvt_pk_bf16(o0[2], o0[3]), cvt_pk_bf16(o1[0], o1[1]), cvt_pk_bf16(o1[2], o1[3])};
            u32x2 q8; q8.x = pk4_fp8(o0[0], o0[1], o0[2], o0[3]); q8.y = pk4_fp8(o1[0], o1[1], o1[2], o1[3]);
            *(u32x2*)(fx8 + 32 * s_) = q8; asm volatile("" ::: "memory"); } }
        f32x4 a0 = (f32x4){0.f, 0.f, 0.f, 0.f}, a1 = a0, a2 = a0, a3 = a0;
        const int cb = er * 2048 + ((((er & 12) | (rq ^ (er & 3)))) << 4);
#pragma unroll
        for (int sI = 0; sI < 32; ++sI) { const int co = cb ^ (sI << 6); const bf16x8 af = (bf16x8)xv[sI];
            const bf16x8 h0 = *(const LAS bf16x8*)(WH + co), l0 = *(const LAS bf16x8*)(WL + co);
            const bf16x8 h1 = *(const LAS bf16x8*)(WH + 32768 + co), l1 = *(const LAS bf16x8*)(WL + 32768 + co);
            a0 = __builtin_amdgcn_mfma_f32_16x16x32_bf16(af, h0, a0, 0, 0, 0); a2 = __builtin_amdgcn_mfma_f32_16x16x32_bf16(af, l0, a2, 0, 0, 0);
            a1 = __builtin_amdgcn_mfma_f32_16x16x32_bf16(af, h1, a1, 0, 0, 0); a3 = __builtin_amdgcn_mfma_f32_16x16x32_bf16(af, l1, a3, 0, 0, 0);
            if ((sI & 3) == 3) asm volatile("" ::: "memory"); }
        a0 += a2; a1 += a3;
        const float rb0 = p.router_b[er], rb1 = p.router_b[16 + er];
#pragma unroll
        for (int i = 0; i < 4; ++i) {
            unsigned k0 = rkey(a0[i] + rb0, er), k1 = rkey(a1[i] + rb1, 16 + er), wk[TOPK];
#pragma unroll
            for (int t = 0; t < TOPK; ++t) { const unsigned m = dpp_max_u32(max(k0, k1)); wk[t] = m; k0 = (k0 == m) ? 0u : k0; k1 = (k1 == m) ? 0u : k1; }
            const float v0 = rkey_val(wk[0]); float ex[TOPK], se = 0.f;
#pragma unroll
            for (int t = 0; t < TOPK; ++t) { ex[t] = __expf(rkey_val(wk[t]) - v0); se += ex[t]; }
            const float inv = 1.0f / se;
            if (er < TOPK) { const unsigned w_ = er == 0 ? wk[0] : er == 1 ? wk[1] : er == 2 ? wk[2] : wk[3]; const float g = (er == 0 ? ex[0] : er == 1 ? ex[1] : er == 2 ? ex[2] : ex[3]) * inv;
                const int e = 31 - (int)(w_ & 31u), rl = wave * 16 + 4 * rq + i;
                const int rank = __hip_atomic_fetch_add((int*)&cntl[e], 1, __ATOMIC_RELAXED, __HIP_MEMORY_SCOPE_WORKGROUP); sel_e[rl * 4 + er] = e; sel_r[rl * 4 + er] = rank; sel_g[rl * 4 + er] = g; }
        }
        __syncthreads();
        if (tv < 32) basel[tv] = (int)atomicAdd(&gcnt[tv], (unsigned)cntl[tv]);
        __syncthreads();
        { const int rl = tv >> 2, t = tv & 3, row = rg * 128 + rl, e = sel_e[tv], slot = basel[e] + sel_r[tv];
          ((int*)(p.ws + WS_TOK))[(size_t)e * M + slot] = row; ((float*)(p.ws + WS_GATE))[(size_t)e * M + slot] = sel_g[tv]; ((int*)(p.ws + WS_INV))[(size_t)row * 4 + t] = e * M + slot; }
    }
    __syncthreads();
}

__device__ __forceinline__ void p9_final(Frame& F) {
    const P& p = F.p; const int lane = F.lane;
    LAS int* tab = (LAS int*)(F.lds + AUX_OFF);
    moe_tables(tab, (const unsigned*)(p.ws + WS_CTL) + CW_CNT, 1);
    const int gw = F.vcu * NWAVES + F.wave, NGW = F.G * NWAVES, b = gw & 3;
    const float* gp = (const float*)(p.ws + WS_MX) + b * 6144 + 5 * 1024;
    f32x4 g[4], nf[4];
#pragma unroll
    for (int j = 0; j < 4; ++j) { const int k = 8 * lane + 512 * (j >> 1) + 4 * (j & 1); g[j] = *(const f32x4*)(gp + k); nf[j] = *(const f32x4*)(p.norm_final + k); }
    const int rs = NGW >> 2;
    for (int r = gw >> 2; r < SEQ; r += 2 * rs) {
        int4 iv[2]; bool ok[2];
#pragma unroll
        for (int q = 0; q < 2; ++q) { const int rr = r + q * rs; ok[q] = rr < SEQ; iv[q] = *(const int4*)((const int*)(p.ws + WS_INV) + (size_t)(b * SEQ + (ok[q] ? rr : r)) * 4); }
        u32x2 ow[2][TOPK][2]; u32x4 xw[2][2];
#pragma unroll
        for (int q = 0; q < 2; ++q) { const int row = b * SEQ + (ok[q] ? r + q * rs : r); const int ivs[4] = {iv[q].x, iv[q].y, iv[q].z, iv[q].w};
#pragma unroll
            for (int t = 0; t < TOPK; ++t) { const int e = ivs[t] >> 15, slot = ivs[t] & (M - 1); const unsigned char* op = p.ws + WS_OUTP + (size_t)(tab[65 + e] + slot) * D;
#pragma unroll
                for (int h = 0; h < 2; ++h) ow[q][t][h] = __builtin_nontemporal_load((const u32x2*)(op + 8 * lane + 512 * h)); }
            const bf16* x1 = (const bf16*)(p.ws + WS_X1) + (size_t)row * D;
#pragma unroll
            for (int h = 0; h < 2; ++h) xw[q][h] = __builtin_nontemporal_load((const u32x4*)(x1 + 8 * lane + 512 * h)); }
#pragma unroll
        for (int q = 0; q < 2; ++q) { if (!ok[q]) continue; const int row = b * SEQ + r + q * rs;
            f32x4 y[4];
#pragma unroll
            for (int j = 0; j < 4; ++j) y[j] = (f32x4){0.f, 0.f, 0.f, 0.f};
#pragma unroll
            for (int t = 0; t < TOPK; ++t)
#pragma unroll
                for (int h = 0; h < 2; ++h) { const u32x2 w = ow[q][t][h];
                    y[2 * h] += (f32x4){__builtin_amdgcn_cvt_f32_fp8((int)w.x, 0), __builtin_amdgcn_cvt_f32_fp8((int)w.x, 1), __builtin_amdgcn_cvt_f32_fp8((int)w.x, 2), __builtin_amdgcn_cvt_f32_fp8((int)w.x, 3)};
                    y[2 * h + 1] += (f32x4){__builtin_amdgcn_cvt_f32_fp8((int)w.y, 0), __builtin_amdgcn_cvt_f32_fp8((int)w.y, 1), __builtin_amdgcn_cvt_f32_fp8((int)w.y, 2), __builtin_amdgcn_cvt_f32_fp8((int)w.y, 3)}; }
            float* xo = p.out + (size_t)row * D; f32x4 v[4]; float s = 0.f;
#pragma unroll
            for (int h = 0; h < 2; ++h) { const u32x4 w = xw[q][h];
                v[2 * h] = (f32x4){bflo(w.x), bfhi(w.x), bflo(w.y), bfhi(w.y)} + g[2 * h] * y[2 * h]; v[2 * h + 1] = (f32x4){bflo(w.z), bfhi(w.z), bflo(w.w), bfhi(w.w)} + g[2 * h + 1] * y[2 * h + 1]; }
#pragma unroll
            for (int j = 0; j < 4; ++j) s += (v[j][0] * v[j][0] + v[j][1] * v[j][1]) + (v[j][2] * v[j][2] + v[j][3] * v[j][3]);
            const float rstd = rsqrtf(wave_sum(s) * (1.0f / D) + EPS);
#pragma unroll
            for (int j = 0; j < 4; ++j) { const int k = 8 * lane + 512 * (j >> 1) + 4 * (j & 1); __builtin_nontemporal_store(v[j] * rstd * nf[j], (f32x4*)(xo + k)); }
        }
    }
}
constexpr int TC = 32, NCTXC = CTX / TC, NCH = NCTXC + SEQ / TC;
constexpr int P3_UPITCH = 128, P3_UBUF = 5120, P3_VOFF = 2 * P3_UBUF, P3_VPITCH = 144, P3_WAVE_LDS = P3_VOFF + 4608;
constexpr int P3_WG = 8 * P3_WAVE_LDS, P3_WPITCH = 144, P3_CW = P3_WG + 256 * P3_WPITCH, P3_GB = P3_CW + 2560;
static_assert(P3_VOFF + TC * P3_VPITCH <= P3_WAVE_LDS && P3_GB + 1536 <= RING_BYTES + AUX_BYTES, "P3 LDS map");
constexpr size_t WS_SUMG = WS_HX;
constexpr size_t WS_CARRY = WS_HX + 32 * MiB;
struct Comp { float P, Q; };
__device__ __forceinline__ Comp comp_then(const Comp& e, const Comp& l) { return Comp{e.P * l.P, l.P * e.Q + l.Q}; }

__device__ __forceinline__ void p3_tables(Frame& F, int blk) {
    const P& p = F.p; LAS unsigned char* lds = F.lds; const int tid = F.tid;
    __syncthreads();
    for (int i = tid; i < 2 * 128 * 8; i += NTHR) { const int ck = i & 7, n = (i >> 3) & 127, d = i >> 10;
        *(LAS u32x4*)(lds + P3_WG + (d * 128 + n) * P3_WPITCH + (ck << 4)) = *(const u32x4*)((const bf16*)(p.ws + WS_WG) + ((size_t)(d * 16 + blk) * 128 + n) * 64 + ck * 8); }
    for (int i = tid; i < 2 * 5 * 64; i += NTHR) { const int c = i & 63, t = (i >> 6) % 5, d = i / 320;
        *(LAS float*)(lds + P3_CW + i * 4) = t < 4 ? p.lru_conv_w[(size_t)(d * 4 + (d ? 3 - t : t)) * D + blk * 64 + c] : p.lru_conv_b[d * D + blk * 64 + c]; }
    for (int i = tid; i < 2 * 3 * 64; i += NTHR) { const int c = i & 63, k = (i >> 6) % 3, d = i / 192, g = d * D + blk * 64 + c;
        *(LAS float*)(lds + P3_GB + i * 4) = k == 0 ? -1.4426950408889634f * p.lru_ba[g] : k == 1 ? -1.4426950408889634f * p.lru_bx[g] : 1.4426950408889634f * -8.0f * log1pf(__expf(-p.lru_lambda[g])); }
    LDS_WAIT(); __syncthreads();
}
__device__ __forceinline__ void p3_tile_dma(const P& p, LAS unsigned char* ub, int b, int blk, int nat, int lane) {
    const bool isctx = nat < NCTXC; const int t0 = (isctx ? nat : nat - NCTXC) * TC, L = isctx ? CTX : SEQ;
    const bf16* U = (isctx ? (const bf16*)(p.ws + WS_CS3) + (size_t)b * CTX * D : (const bf16*)(p.ws + WS_ULRU) + (size_t)b * SEQ * D) + blk * 64;
    const bf16* Zp = (const bf16*)(p.ws + WS_ZERO);
#pragma unroll
    for (int i = 0; i < 5; ++i) { const int idx = lane + 64 * i, r = idx >> 3, c = idx & 7, t = t0 - 3 + r; const bf16* src = (t >= 0 && t < L) ? U + (size_t)t * D + c * 8 : Zp;
        __builtin_amdgcn_global_load_lds((const unsigned*)src, (LAS unsigned*)(ub + i * 1024), 16, 0, 0); }
}
template <int PASS, int V = 0>
__device__ __forceinline__ void p3_chunk(Frame& F, int lane, LAS unsigned char* wl, LAS unsigned char* ub, int d, Comp (&tot)[4], const float (&cin)[4], unsigned (&hpk)[2][4][2]) {
    LAS unsigned char* lds = F.lds; const int ch = lane & 15, qd = lane >> 4;
#define TEXP(x) ((V & 1) ? ((x) * 0.5f + 1.0f) : __builtin_amdgcn_exp2f(x))
#define TRCP(x) ((V & 1) ? ((x) * 0.25f) : __builtin_amdgcn_rcpf(x))
#define TSQRT(x) ((V & 1) ? ((x) * 0.5f) : __builtin_amdgcn_sqrtf(x))
    if (!(V & 8)) {
        const int cc = lane & 7, tg = lane >> 3, ro = d ? 3 : 0;
        u32x4 ur[7];
#pragma unroll
        for (int r = 0; r < 7; ++r) ur[r] = *(const LAS u32x4*)(ub + (4 * tg + ro + r) * P3_UPITCH + cc * 16);
        f32x4 cwv[5][2];
#pragma unroll
        for (int t = 0; t < 5; ++t) { cwv[t][0] = *(const LAS f32x4*)(lds + P3_CW + ((d * 5 + t) * 64 + cc * 8) * 4); cwv[t][1] = *(const LAS f32x4*)(lds + P3_CW + ((d * 5 + t) * 64 + cc * 8 + 4) * 4); }
#pragma unroll
        for (int i = 0; i < 4; ++i) {
            f32x4 v0 = cwv[4][0], v1 = cwv[4][1];
#pragma unroll
            for (int t = 0; t < 4; ++t) { const u32x4 w = ur[i + t];
                v0 += cwv[t][0] * (f32x4){bflo(w.x), bfhi(w.x), bflo(w.y), bfhi(w.y)}; v1 += cwv[t][1] * (f32x4){bflo(w.z), bfhi(w.z), bflo(w.w), bfhi(w.w)}; }
            const int tl = 4 * tg + i, s = d ? TC - 1 - tl : tl;
            u32x4 o; o.x = cvt_pk_bf16(v0[0], v0[1]); o.y = cvt_pk_bf16(v0[2], v0[3]); o.z = cvt_pk_bf16(v1[0], v1[1]); o.w = cvt_pk_bf16(v1[2], v1[3]);
            *(LAS u32x4*)(wl + P3_VOFF + s * P3_VPITCH + (cc << 4)) = o;
        }
        LDS_WAIT();
    }
    float hrun[4];
#pragma unroll
    for (int n = 0; n < 4; ++n) { tot[n] = Comp{1.f, 0.f}; hrun[n] = cin[n]; }
#pragma unroll
    for (int m = 0; m < 2; ++m) {
        const int sa = 16 * m + (lane & 15);
        bf16x8 af[2];
#pragma unroll
        for (int kk = 0; kk < 2; ++kk) af[kk] = *(const LAS bf16x8*)(wl + P3_VOFF + sa * P3_VPITCH + ((kk * 4 + qd) << 4));
#pragma unroll
        for (int np = 0; np < 4; np += 2) {
            f32x4 ar[2], ai[2]; int nr[2]; f32x2 ba, bx, c1;
#pragma unroll
            for (int q = 0; q < 2; ++q) { const int n = np + q; nr[q] = n * 16 + ch; ar[q] = (f32x4){0.f, 0.f, 0.f, 0.f}; ai[q] = ar[q];
#pragma unroll
                for (int kk = 0; kk < 2; ++kk) { const int co = ((kk * 4 + qd) << 4);
                    const bf16x8 wa = *(const LAS bf16x8*)(lds + P3_WG + (d * 128 + nr[q]) * P3_WPITCH + co), wx = *(const LAS bf16x8*)(lds + P3_WG + (d * 128 + 64 + nr[q]) * P3_WPITCH + co);
                    ar[q] = __builtin_amdgcn_mfma_f32_16x16x32_bf16(af[kk], wa, ar[q], 0, 0, 0); ai[q] = __builtin_amdgcn_mfma_f32_16x16x32_bf16(af[kk], wx, ai[q], 0, 0, 0); }
                ba[q] = *(const LAS float*)(lds + P3_GB + ((d * 3 + 0) * 64 + nr[q]) * 4); bx[q] = *(const LAS float*)(lds + P3_GB + ((d * 3 + 1) * 64 + nr[q]) * 4); c1[q] = *(const LAS float*)(lds + P3_GB + ((d * 3 + 2) * 64 + nr[q]) * 4); }
            f32x2 Pi[4], Qi[4]; f32x2 Pl = (f32x2){1.f, 1.f}, Ql = (f32x2){0.f, 0.f};
#pragma unroll
            for (int i = 0; i < 4; ++i) {
                const int s = 16 * m + 4 * qd + i;
                const f32x2 v = (f32x2){bf2f(*(const LAS bf16*)(wl + P3_VOFF + s * P3_VPITCH + nr[0] * 2)), bf2f(*(const LAS bf16*)(wl + P3_VOFF + s * P3_VPITCH + nr[1] * 2))};
                const f32x2 tr = (f32x2){ar[0][i], ar[1][i]} + ba, ti = (f32x2){ai[0][i], ai[1][i]} + bx;
                const f32x2 er = (f32x2){TEXP(tr.x), TEXP(tr.y)} + 1.0f, ei = (f32x2){TEXP(ti.x), TEXP(ti.y)} + 1.0f;
                const f32x2 r = (f32x2){TRCP(er.x), TRCP(er.y)}, ig = (f32x2){TRCP(ei.x), TRCP(ei.y)};
                const f32x2 la = c1 * r; const f32x2 a = (f32x2){TEXP(la.x), TEXP(la.y)};
                const f32x2 om = 1.0f - a * a; const f32x2 bq = (f32x2){TSQRT(om.x), TSQRT(om.y)} * (ig * v);
#ifdef EXP_P3TRANS
                { const f32x2 d1 = (f32x2){__builtin_amdgcn_exp2f(la.x - 1.0f), __builtin_amdgcn_exp2f(la.y - 1.0f)}, d2 = (f32x2){__builtin_amdgcn_rcpf(er.x + 1.0f), __builtin_amdgcn_rcpf(er.y + 1.0f)}, d3 = (f32x2){__builtin_amdgcn_sqrtf(om.x + 1.0f), __builtin_amdgcn_sqrtf(om.y + 1.0f)};
                  Ql = Ql + 0.0f * (d1 + d2 + d3); }
#endif
                Ql = a * Ql + bq; Pl = Pl * a; Pi[i] = Pl; Qi[i] = Ql;
            }
            const f32x2 oP = (V & 2) ? Pl : (f32x2){__shfl_xor(Pl.x, 16), __shfl_xor(Pl.y, 16)}, oQ = (V & 2) ? Ql : (f32x2){__shfl_xor(Ql.x, 16), __shfl_xor(Ql.y, 16)};
            const bool odd = (qd & 1) != 0, hi = (qd & 2) != 0;
            const f32x2 eP = odd ? oP : Pl, eQ = odd ? oQ : Ql, lP = odd ? Pl : oP, lQ = odd ? Ql : oQ;
            const f32x2 pP = eP * lP, pQ = lP * eQ + lQ;
            const f32x2 qP = (V & 2) ? pP : (f32x2){__shfl_xor(pP.x, 32), __shfl_xor(pP.y, 32)}, qQ = (V & 2) ? pQ : (f32x2){__shfl_xor(pQ.x, 32), __shfl_xor(pQ.y, 32)};
            const f32x2 e2P = hi ? qP : pP, e2Q = hi ? qQ : pQ, l2P = hi ? pP : qP, l2Q = hi ? pQ : qQ;
            const f32x2 tP = e2P * l2P, tQ = l2P * e2Q + l2Q;
            if (PASS == 1) {
#pragma unroll
                for (int q = 0; q < 2; ++q) { const int n = np + q; tot[n] = Comp{tot[n].P * tP[q], tP[q] * tot[n].Q + tQ[q]}; }
            } else {
                const f32x2 xP = qd == 0 ? (f32x2){1.f, 1.f} : qd == 1 ? oP : qd == 2 ? qP : qP * oP, xQ = qd == 0 ? (f32x2){0.f, 0.f} : qd == 1 ? oQ : qd == 2 ? qQ : oP * qQ + oQ;
                const f32x2 hr = (f32x2){hrun[np], hrun[np + 1]}; const f32x2 hs = xP * hr + xQ;
                f32x2 h[4];
#pragma unroll
                for (int i = 0; i < 4; ++i) h[i] = Pi[i] * hs + Qi[i];
                const f32x2 hn = tP * hr + tQ; hrun[np] = hn.x; hrun[np + 1] = hn.y;
#pragma unroll
                for (int q = 0; q < 2; ++q) { const int n = np + q;
                    if (d == 1) { hpk[m][n][0] = cvt_pk_bf16(h[0][q], h[1][q]); hpk[m][n][1] = cvt_pk_bf16(h[2][q], h[3][q]); }
                    else {
                        const unsigned m0 = __shfl_xor(hpk[1 - m][n][0], 48), m1 = __shfl_xor(hpk[1 - m][n][1], 48);
                        const float hb[4] = {bfhi(m1), bflo(m1), bfhi(m0), bflo(m0)};
#pragma unroll
                        for (int i = 0; i < 4; ++i) { const int s = 16 * m + 4 * qd + i;
                            *(LAS bf16*)(wl + P3_VOFF + s * P3_VPITCH + nr[q] * 2) = (bf16)cvt_pk_bf16(h[i][q] + hb[i], 0.f); }
                    }
                }
            }
        }
    }
}
constexpr int CV_W1 = NE * 32 * 64, CV_ITEMS = CV_W1 + NE * 32 * 32;
struct CvJob { const float* src; unsigned char* dst; int N, n0, w1; };
__device__ __forceinline__ CvJob cv32_job(const P& p, int idx) {
    CvJob j;
    if (idx < CV_W1) { const int e = idx >> 11, l = idx & 2047, kb = l >> 6, nb = l & 63; j.N = 2048; j.src = p.w1 + (size_t)e * D * 2048 + (size_t)(32 * kb) * 2048 + 32 * nb; j.dst = p.ws + WS_W1 + (size_t)e * 2048 * D + 32 * kb; j.n0 = 32 * nb; j.w1 = 1; }
    else { const int r = idx - CV_W1, e = r >> 10, l = r & 1023, kb = l >> 5, nb = l & 31; j.N = D; j.src = p.w2 + (size_t)e * DE * D + (size_t)(32 * kb) * D + 32 * nb; j.dst = p.ws + WS_W2 + (size_t)e * D * DE + 32 * kb; j.n0 = 32 * nb; j.w1 = 0; }
    return j;
}
__device__ __forceinline__ void cv32_issue(const CvJob& j, int lane, float (&v)[16]) {
#pragma unroll
    for (int i = 0; i < 16; ++i) v[i] = __builtin_nontemporal_load(&j.src[(size_t)(2 * i + (lane >> 5)) * j.N + (lane & 31)]);
}
__device__ __forceinline__ void cv32_finish(const CvJob& j, int lane, const float (&v)[16], LAS float* scr) {
#pragma unroll
    for (int i = 0; i < 16; ++i) scr[(2 * i + (lane >> 5)) * 33 + (lane & 31)] = v[i] * 32.0f;
    LDS_WAIT(); asm volatile("" ::: "memory");
    const int c = lane & 1, n = lane >> 1; const LAS float* s = scr + (16 * c) * 33 + n;
    u32x4 o; o.x = pk4_fp8(s[0 * 33], s[1 * 33], s[2 * 33], s[3 * 33]); o.y = pk4_fp8(s[4 * 33], s[5 * 33], s[6 * 33], s[7 * 33]);
    o.z = pk4_fp8(s[8 * 33], s[9 * 33], s[10 * 33], s[11 * 33]); o.w = pk4_fp8(s[12 * 33], s[13 * 33], s[14 * 33], s[15 * 33]);
    const int nn = j.n0 + n, row = j.w1 ? 256 * ((nn >> 1) >> 7) + 128 * (nn & 1) + ((nn >> 1) & 127) : nn;
    *(u32x4*)(j.dst + (size_t)row * D + 16 * c) = o;
    LDS_WAIT(); asm volatile("" ::: "memory");
}
struct GcLoads { u32x4 um, u0, up, gb; };
__device__ __forceinline__ void gc_issue(const P& p, int c, int lane, GcLoads& g) {
    const int m = c >> 1, h = c & 1, c8 = 512 * h + 8 * lane, off = h ? GW : 1, tb = m & (SEQ - 1), row = tb >> 6, col = tb & 63;
    const bool okm = h ? row > 0 : col > 0, okp = h ? row < GROWS - 1 : col < GW - 1;
    const bf16* U = (const bf16*)(p.ws + WS_U) + c8; const u32x4 z4 = (u32x4){0u, 0u, 0u, 0u};
    g.um = z4; g.up = z4;
    if (okm) g.um = *(const u32x4*)(U + (size_t)(m - off) * D);
    g.u0 = *(const u32x4*)(U + (size_t)m * D);
    if (okp) g.up = *(const u32x4*)(U + (size_t)(m + off) * D);
    g.gb = __builtin_nontemporal_load((const u32x4*)((const bf16*)(p.ws + WS_GB) + (size_t)m * D + c8));
}
__device__ __forceinline__ void gc_finish(const P& p, int c, int lane, const GcLoads& g) {
    const int m = c >> 1, c8 = 512 * (c & 1) + 8 * lane;
    f32x4 w[3][2];
#pragma unroll
    for (int k = 0; k < 3; ++k) { w[k][0] = *(const f32x4*)(p.conv_a_w + k * D + c8); w[k][1] = *(const f32x4*)(p.conv_a_w + k * D + c8 + 4); }
    const unsigned um_[4] = {g.um.x, g.um.y, g.um.z, g.um.w}, u0_[4] = {g.u0.x, g.u0.y, g.u0.z, g.u0.w}, up_[4] = {g.up.x, g.up.y, g.up.z, g.up.w}, gb_[4] = {g.gb.x, g.gb.y, g.gb.z, g.gb.w};
    unsigned o[4];
#pragma unroll
    for (int j = 0; j < 4; ++j) { const int q = j >> 1, e0 = 2 * (j & 1);
        const float lo = (w[0][q][e0] * bflo(um_[j]) + w[1][q][e0] * bflo(u0_[j]) + w[2][q][e0] * bflo(up_[j])) * bflo(gb_[j]);
        const float hi = (w[0][q][e0 + 1] * bfhi(um_[j]) + w[1][q][e0 + 1] * bfhi(u0_[j]) + w[2][q][e0 + 1] * bfhi(up_[j])) * bfhi(gb_[j]);
        o[j] = cvt_pk_bf16(lo, hi); }
    *(u32x4*)((bf16*)(p.ws + WS_Z) + (size_t)m * 2048 + c8) = (u32x4){o[0], o[1], o[2], o[3]};
}
constexpr int GC_ITEMS = 2 * M;
template <int PV = 0>
__device__ __forceinline__ void p3a_summaries(Frame& F) {
    const P& p = F.p; const int lane = F.lane, ch = lane & 15, qd = lane >> 4;
    if (F.G < 16) return;
    const int blk = F.vcu & 15, bpb = F.G >> 4, bidx = F.vcu >> 4;
    p3_tables(F, blk);
    LAS unsigned char* wl = F.lds + F.wave * P3_WAVE_LDS;
    const float cin[4] = {0.f, 0.f, 0.f, 0.f}; unsigned hpk[2][4][2];
    const int jstep = bpb * NWAVES, NJ = NB * 2 * NCH;
    int j = bidx * NWAVES + F.wave, ubi = 0;
    const int cvstep = F.G * NWAVES, cvend = CV_ITEMS / 3; int cvi = (int)blockIdx.x * NWAVES + F.wave, gci = cvi;
    constexpr bool nobg = (PV & 16) != 0;
    if (nobg) { cvi = cvend; gci = GC_ITEMS; }
    if (j < NJ) p3_tile_dma(p, wl, (j >> 1) & 3, blk, j >> 3, lane);
    for (; j < NJ; j += jstep, ubi ^= 1) {
        const int d = j & 1, b = (j >> 1) & 3, nat = j >> 3; Comp tot[4];
        int lv = lane; asm volatile("" : "+v"(lv));
        VM_WAIT();
        const int jn = j + jstep;
        if (jn < NJ) p3_tile_dma(p, wl + (ubi ^ 1) * P3_UBUF, (jn >> 1) & 3, blk, jn >> 3, lv);
        CvJob cj[1]; float cvv[1][16]; bool cvon[1]; GcLoads gl[2]; int gcc[2];
#pragma unroll
        for (int q = 0; q < 1; ++q) { cvon[q] = cvi < cvend && !nobg; if (cvon[q]) { cj[q] = cv32_job(p, cvi); cv32_issue(cj[q], lv, cvv[q]); cvi += cvstep; } }
#pragma unroll
        for (int q = 0; q < 2; ++q) { gcc[q] = (gci < GC_ITEMS && !nobg) ? gci : -1; if (gcc[q] >= 0) { gc_issue(p, gcc[q], lv, gl[q]); gci += cvstep; } }
        p3_chunk<1, (PV & 15)>(F, lv, wl, wl + ubi * P3_UBUF, d, tot, cin, hpk);
#pragma unroll
        for (int q = 0; q < 1; ++q) if (cvon[q]) cv32_finish(cj[q], lv, cvv[q], (LAS float*)(wl + P3_VOFF));
#pragma unroll
        for (int q = 0; q < 2; ++q) if (gcc[q] >= 0) gc_finish(p, gcc[q], lv, gl[q]);
        if ((lv >> 4) == 0) { f32x2* sg = (f32x2*)(p.ws + WS_SUMG) + ((size_t)((b * 2 + d) * NCH + nat)) * D + blk * 64 + (lv & 15);
#pragma unroll
            for (int n = 0; n < 4; ++n) sg[n * 16] = (f32x2){tot[n].P, tot[n].Q}; }
    }
    for (; cvi < cvend; cvi += cvstep) { const CvJob jb = cv32_job(p, cvi); float v[16]; cv32_issue(jb, lane, v); cv32_finish(jb, lane, v, (LAS float*)(wl + P3_VOFF)); }
    for (; gci < GC_ITEMS; gci += cvstep) { GcLoads g; gc_issue(p, gci, lane, g); gc_finish(p, gci, lane, g); }
    __syncthreads();
}
__device__ __forceinline__ void p3b_carries(Frame& F) {
    const P& p = F.p; const int tid = F.tid, c = tid & 63, seg = tid >> 6;
    LAS f32x2* sc = (LAS f32x2*)F.lds;
    constexpr int SEGL = NCH / 8;
    static_assert(SEGL * 8 == NCH, "segments");
    for (int w = F.vcu; w < NB * 2 * 16; w += F.G) {
        const int cg = w & 15, d = (w >> 4) & 1, b = w >> 5;
        const f32x2* sg = (const f32x2*)(p.ws + WS_SUMG) + (size_t)((b * 2 + d) * NCH) * D + cg * 64 + c; float* cr = (float*)(p.ws + WS_CARRY) + (size_t)((b * 2 + d) * NCH) * D + cg * 64 + c;
        f32x2 cv[SEGL];
#pragma unroll
        for (int u = 0; u < SEGL; ++u) { const int j = seg * SEGL + u, nat = d == 0 ? j : (j < NCTXC ? NCTXC - 1 - j : NCH + NCTXC - 1 - j); cv[u] = sg[(size_t)nat * D]; }
        float Pt = 1.f, Qt = 0.f;
#pragma unroll
        for (int u = 0; u < SEGL; ++u) { Qt = cv[u].x * Qt + cv[u].y; Pt *= cv[u].x; }
        __syncthreads();
        sc[seg * 64 + c] = (f32x2){Pt, Qt};
        LDS_WAIT(); __syncthreads();
        float h = 0.f;
#pragma unroll
        for (int s2 = 0; s2 < 8; ++s2) { const f32x2 q = sc[s2 * 64 + c]; if (s2 < seg) h = q.x * h + q.y; }
#pragma unroll
        for (int u = 0; u < SEGL; ++u) { const int j = seg * SEGL + u, nat = d == 0 ? j : (j < NCTXC ? NCTXC - 1 - j : NCH + NCTXC - 1 - j); cr[(size_t)nat * D] = h; h = cv[u].x * h + cv[u].y; }
    }
    __syncthreads();
}
__device__ __forceinline__ void p3c_apply(Frame& F) {
    const P& p = F.p; const int lane = F.lane;
    if (F.G < 16) return;
    const int blk = F.vcu & 15, bpb = F.G >> 4, bidx = F.vcu >> 4;
    p3_tables(F, blk);
    LAS unsigned char* wl = F.lds + F.wave * P3_WAVE_LDS;
    const int jstep = bpb * NWAVES, NJ = NB * (SEQ / TC);
    int j = bidx * NWAVES + F.wave, ubi = 0;
    const int cvstep = F.G * NWAVES, cvend = CV_ITEMS; int cvi = CV_ITEMS / 3 + (int)blockIdx.x * NWAVES + F.wave;
#define P3C_PREFETCH(jj, ub_, ln_) do { const int b_ = (jj) & 3, nat_ = NCTXC + ((jj) >> 2); p3_tile_dma(p, ub_, b_, blk, nat_, ln_); } while (0)
    if (j < NJ) P3C_PREFETCH(j, wl, lane);
    for (; j < NJ; j += jstep, ubi ^= 1) {
        const int b = j & 3, nat = NCTXC + (j >> 2), t0 = (nat - NCTXC) * TC;
        unsigned hpk[2][4][2];
        int lv = lane; asm volatile("" : "+v"(lv));
        const int cc = lv & 7;
        VM_WAIT();
        float cb_[4], cf_[4];
        { const float* cr_ = (const float*)(p.ws + WS_CARRY) + ((size_t)(b * 2 * NCH + nat)) * D + blk * 64 + (lv & 15);
#pragma unroll
          for (int n = 0; n < 4; ++n) { cf_[n] = cr_[n * 16]; cb_[n] = cr_[(size_t)NCH * D + n * 16]; } }
        const int jn = j + jstep;
        if (jn < NJ) P3C_PREFETCH(jn, wl + (ubi ^ 1) * P3_UBUF, lv);
        Comp tot[4];
        CvJob cj[4]; float cvv[4][16]; bool cvon[4];
#pragma unroll
        for (int q = 0; q < 4; ++q) { cvon[q] = cvi < cvend; if (cvon[q]) { cj[q] = cv32_job(p, cvi); cv32_issue(cj[q], lv, cvv[q]); cvi += cvstep; } }
        p3_chunk<2>(F, lv, wl, wl + ubi * P3_UBUF, 1, tot, cb_, hpk);
        u32x4 gg[4];
#pragma unroll
        for (int i = 0; i < 4; ++i) { const int tl = (lv >> 3) + 8 * i; gg[i] = __builtin_nontemporal_load((const u32x4*)((const bf16*)(p.ws + WS_GG) + ((size_t)b * SEQ + t0 + tl) * D + blk * 64 + cc * 8)); }
        p3_chunk<2>(F, lv, wl, wl + ubi * P3_UBUF, 0, tot, cf_, hpk);
        LDS_WAIT();
#pragma unroll
        for (int i = 0; i < 4; ++i) { const int tl = (lv >> 3) + 8 * i; const size_t mrow = (size_t)b * SEQ + t0 + tl;
            const u32x4 hv = *(const LAS u32x4*)(wl + P3_VOFF + tl * P3_VPITCH + (cc << 4)); const u32x4 g = gg[i];
            u32x4 o; o.x = cvt_pk_bf16(bflo(hv.x) * bflo(g.x), bfhi(hv.x) * bfhi(g.x)); o.y = cvt_pk_bf16(bflo(hv.y) * bflo(g.y), bfhi(hv.y) * bfhi(g.y));
            o.z = cvt_pk_bf16(bflo(hv.z) * bflo(g.z), bfhi(hv.z) * bfhi(g.z)); o.w = cvt_pk_bf16(bflo(hv.w) * bflo(g.w), bfhi(hv.w) * bfhi(g.w));
            *(u32x4*)((bf16*)(p.ws + WS_Z) + mrow * 2048 + 1024 + blk * 64 + cc * 8) = o; }
        LDS_WAIT();
#pragma unroll
        for (int q = 0; q < 4; ++q) if (cvon[q]) cv32_finish(cj[q], lv, cvv[q], (LAS float*)(wl + P3_VOFF));
    }
    for (; cvi < cvend; cvi += cvstep) { const CvJob jb = cv32_job(p, cvi); float v[16]; cv32_issue(jb, lane, v); cv32_finish(jb, lane, v, (LAS float*)(wl + P3_VOFF)); }
#undef P3C_PREFETCH
    __syncthreads();
}
__device__ __forceinline__ void p3_conv(Frame& F) {
    const P& p = F.p; const int c8 = (F.tid & 127) * 8, tsub = F.tid >> 7;
    float w[3][8];
#pragma unroll
    for (int k = 0; k < 3; ++k)
#pragma unroll
        for (int c = 0; c < 8; ++c) w[k][c] = p.conv_a_w[k * D + c8 + c];
    const bool horiz = c8 < 512; const int off = horiz ? 1 : GW;
    const bf16* U = (const bf16*)(p.ws + WS_U) + c8; const bf16* GBp = (const bf16*)(p.ws + WS_GB) + c8; bf16* Z = (bf16*)(p.ws + WS_Z) + c8;
    for (int m0 = F.vcu * 4 + tsub; m0 < M; m0 += F.G * 16) {
        u32x4 um[4], u0[4], up[4], gb[4];
#pragma unroll
        for (int q = 0; q < 4; ++q) { const int m = m0 + q * F.G * 4; const u32x4 z4 = (u32x4){0u, 0u, 0u, 0u}; um[q] = z4; u0[q] = z4; up[q] = z4; gb[q] = z4;
            if (m < M) { const int tb = m & (SEQ - 1), row = tb >> 6, col = tb & 63; const bool okm = horiz ? col > 0 : row > 0, okp = horiz ? col < GW - 1 : row < GROWS - 1;
                if (okm) um[q] = *(const u32x4*)(U + (size_t)(m - off) * D); u0[q] = *(const u32x4*)(U + (size_t)m * D); if (okp) up[q] = *(const u32x4*)(U + (size_t)(m + off) * D); gb[q] = __builtin_nontemporal_load((const u32x4*)(GBp + (size_t)m * D)); } }
#pragma unroll
        for (int q = 0; q < 4; ++q) { const int m = m0 + q * F.G * 4; if (m >= M) continue;
            const unsigned um_[4] = {um[q].x, um[q].y, um[q].z, um[q].w}, u0_[4] = {u0[q].x, u0[q].y, u0[q].z, u0[q].w}, up_[4] = {up[q].x, up[q].y, up[q].z, up[q].w}, gb_[4] = {gb[q].x, gb[q].y, gb[q].z, gb[q].w};
            unsigned o[4];
#pragma unroll
            for (int j = 0; j < 4; ++j) {
                const float lo = (w[0][2 * j] * bflo(um_[j]) + w[1][2 * j] * bflo(u0_[j]) + w[2][2 * j] * bflo(up_[j])) * bflo(gb_[j]);
                const float hi = (w[0][2 * j + 1] * bfhi(um_[j]) + w[1][2 * j + 1] * bfhi(u0_[j]) + w[2][2 * j + 1] * bfhi(up_[j])) * bfhi(gb_[j]);
                o[j] = cvt_pk_bf16(lo, hi);
            }
            *(u32x4*)(Z + (size_t)m * 2048) = (u32x4){o[0], o[1], o[2], o[3]}; }
    }
}

__device__ __forceinline__ void p2_ctx_tiles(Frame& F) {
    const P& p = F.p; const int lane = F.lane, r16 = lane & 15, kq = lane >> 4;
    const bf16* HC = (const bf16*)(p.ws + WS_HC); const bf16* WL = (const bf16*)(p.ws + WS_WIN) + (size_t)3072 * D; bf16* CS = (bf16*)(p.ws + WS_CS3);
    for (int t = F.vcu; t < 256; t += F.G) {
        const int m0 = (t >> 4) * 64 + (F.wave & 3) * 16, n0 = (t & 15) * 64 + (F.wave >> 2) * 32;
        const bf16* ap = HC + (size_t)(m0 + r16) * D + 8 * kq; const bf16* bp0 = WL + (size_t)(n0 + r16) * D + 8 * kq; const bf16* bp1 = bp0 + (size_t)16 * D;
        f32x4 c0 = (f32x4){0.f, 0.f, 0.f, 0.f}, c1 = c0;
#pragma unroll 8
        for (int s2 = 0; s2 < 32; ++s2) { const bf16x8 a = *(const bf16x8*)(ap + 32 * s2), b0 = *(const bf16x8*)(bp0 + 32 * s2), b1 = *(const bf16x8*)(bp1 + 32 * s2);
            c0 = __builtin_amdgcn_mfma_f32_16x16x32_bf16(a, b0, c0, 0, 0, 0); c1 = __builtin_amdgcn_mfma_f32_16x16x32_bf16(a, b1, c1, 0, 0, 0); }
#pragma unroll
        for (int i = 0; i < 4; ++i) { bf16* o = CS + (size_t)(m0 + 4 * kq + i) * D + n0 + r16; o[0] = f2bf(c0[i]); o[16] = f2bf(c1[i]); }
    }
}

struct Args { P p; int ph_lo, ph_hi, region, pad; };
constexpr int NPHASE = 10;
#ifndef P2_ALIGN
#define P2_ALIGN true
#endif
__global__ void __launch_bounds__(NTHR, 2) mega_fwd(Args args) {
    extern __shared__ __attribute__((aligned(16))) unsigned char lds_raw[];
    Frame F{(LAS unsigned char*)lds_raw, args.p, 0, 0, 0, 0, 0, 0};
    F.var = 0;
    F.tid = threadIdx.x; F.lane = F.tid & 63; F.wave = __builtin_amdgcn_readfirstlane(F.tid >> 6);
    __builtin_assume(F.wave >= 0 && F.wave < NWAVES); __builtin_assume(gridDim.x >= 1 && gridDim.x <= 1024);
    F.G = gridDim.x; { const int bx = blockIdx.x; F.vcu = (F.G % 8 == 0) ? (bx % 8) * (F.G / 8) + bx / 8 : bx; }
    volatile LAS unsigned* MISC = (volatile LAS unsigned*)(F.lds + MISC_OFF);
    for (int u = F.tid; u < 128; u += NTHR) MISC[u] = 0u;
    __syncthreads();
    const int lo = args.ph_lo, hi = args.ph_hi;
    const P& p = F.p; unsigned char* ws = p.ws;
    unsigned* barw = (unsigned*)(ws + WS_CTL) + CW_BAR + (args.region & 7) * XCD_BAR_WORDS;
    XcdBarrier bar; bar.bar = barw; bar.x = 0; bar.st = nullptr;
    if (hi - lo > 1 || (lo == 3 && args.region < 8)) bar = xcd_barrier_post(barw, MISC + 8);
#ifndef CTM
#define CTM 0x3FFu
#endif
#define IN(k) (((CTM >> (k)) & 1u) && lo <= (k) && (k) < hi)
#define SEAM(k) do { if (IN(k) && IN((k) + 1)) xcd_barrier(bar); } while (0)
#define PHASE(k, ...) do { if (IN(k)) { __VA_ARGS__ } SEAM(k); } while (0)
    PHASE(0, { p0_prologue(F); });
    PHASE(1, { p1_rows(F); });
    PHASE(2, {
        SchedInProj S{(const char*)(ws + WS_HXP), (const char*)(ws + WS_HC), (const char*)(ws + WS_WIN), F.G, (int)blockIdx.x, ((args.region >> 8) & 4) ? 0 : 16, 0};
        EpiInProj E{ws, p.b_merge, (int)((args.region >> 8) & 3)};
        pg8::gemm_phase<EpiInProj, SchedInProj, false, false, P2_ALIGN>(F.lds, D, S, E, PA * 2);
    });
    if (IN(3)) {
        const int part = (args.region >> 3) & 31;
#ifdef PROBE_P3VAR
        if (part == 1 && (args.region >> 8)) p3a_summaries<PROBE_P3VAR>(F); else
#endif
        if (part == 0 || part == 1) p3a_summaries<0>(F);
        if (part == 0) xcd_barrier(bar);
        if (part == 0 || part == 2) p3b_carries(F);
        if (part == 0) xcd_barrier(bar);
        if (part == 0 || part == 3) p3c_apply(F);
    } SEAM(3);
    PHASE(4, {
        SchedDense S{(const char*)(ws + WS_Z), (const char*)(ws + WS_WAB), 2048, F.G, (int)blockIdx.x};
        EpiMerge E{ws};
        pg8::gemm_phase<EpiMerge, SchedDense, true>(F.lds, 2048, S, E);
    });
    PHASE(5, {
        SchedDense S{(const char*)(ws + WS_MG), (const char*)(ws + WS_WO), D, F.G, (int)blockIdx.x};
        EpiWo E{p.x, (bf16*)(ws + WS_X1), (const float*)(ws + WS_MX)};
        pg8::gemm_phase<EpiWo, SchedDense, false>(F.lds, D, S, E);
    });
    PHASE(6, { p6_route(F); });
    PHASE(7, {
        LAS int* tab = (LAS int*)(F.lds + AUX_OFF);
        __syncthreads();
        moe_tables(tab, (const unsigned*)(ws + WS_CTL) + CW_CNT, 8, F.G, (int)blockIdx.x);
        SchedMoe S{(const char*)(ws + WS_FX8), (const char*)(ws + WS_W1), (const int*)(ws + WS_TOK), tab, 8, F.G, (int)blockIdx.x, 1, 2048, 1};
        EpiMoe1 E{ws, p.b1};
        pg8::gemm_phase<EpiMoe1, SchedMoe, false, true>(F.lds, D, S, E);
    });
    PHASE(8, {
        LAS int* tab = (LAS int*)(F.lds + AUX_OFF);
        __syncthreads();
        moe_tables(tab, (const unsigned*)(ws + WS_CTL) + CW_CNT, 4, F.G, (int)blockIdx.x);
        SchedMoe S{(const char*)(ws + WS_ACT), (const char*)(ws + WS_W2), (const int*)(ws + WS_TOK), tab, 4, F.G, (int)blockIdx.x, 0, 1024, 1};
        EpiMoe2 E{ws, p.b2};
        pg8::gemm_phase<EpiMoe2, SchedMoe, false, true>(F.lds, DE, S, E);
    });
    if (IN(9)) { __syncthreads(); p9_final(F); }
#undef PHASE
#undef IN
#undef SEAM
}
#ifndef FAST_MASK
#define FAST_MASK 0x3FFu
#endif
#ifndef ONE_LAUNCH
#define ONE_LAUNCH 1
#endif
static void launch_mega(const P& p, int lo, int hi, int grid, hipStream_t stream, int region = 0) {
    Args a{}; a.p = p; a.ph_lo = lo; a.ph_hi = hi; a.region = region; a.pad = 0;
    hipLaunchKernelGGL(mega_fwd, dim3(grid), dim3(NTHR), LDS_BYTES, stream, a);
}
extern "C" void kernel_launch(void* const* d_in, const int* in_sizes, int n_in, void* d_out, int out_size, void* d_ws, size_t ws_size, hipStream_t stream) {
    static int grid = 0;
    if (grid == 0) {
        if (n_in != 28 || out_size != M * D || ws_size < WS_END) { fprintf(stderr, "kernel_launch: unexpected shapes n_in %d out %d ws %zu\n", n_in, out_size, ws_size); grid = -1; return; }
        int dev = 0, cus = 0, per_cu = 0;
        if (hipGetDevice(&dev) != hipSuccess || hipDeviceGetAttribute(&cus, hipDeviceAttributeMultiprocessorCount, dev) != hipSuccess) { grid = -1; return; }
        if (hipFuncSetAttribute((const void*)mega_fwd, hipFuncAttributeMaxDynamicSharedMemorySize, LDS_BYTES) != hipSuccess) { fprintf(stderr, "kernel_launch: hipFuncSetAttribute failed\n"); grid = -1; return; }
        if (hipOccupancyMaxActiveBlocksPerMultiprocessor(&per_cu, (const void*)mega_fwd, NTHR, LDS_BYTES) != hipSuccess || per_cu < 1) { fprintf(stderr, "kernel_launch: occupancy query reports %d blocks per CU\n", per_cu); }
        (void)hipGetLastError();
        grid = cus;
    }
    if (grid < 0) return;
    P p{};
    const float** f = (const float**)&p;
    for (int i = 0; i < 28; ++i) f[i] = (const float*)d_in[i];
    p.out = (float*)d_out; p.ws = (unsigned char*)d_ws;
    (void)hipMemsetAsync((char*)d_ws + WS_CTL, 0, CTL_ZERO_BYTES, stream);
    const unsigned fm = FAST_MASK;
#ifdef PROBE_LO
    launch_mega(p, 0, PROBE_HI, grid, stream, 0);
    if (PROBE_LO <= 6 && 6 < PROBE_HI) (void)hipMemsetAsync((char*)d_ws + WS_CTL + CW_CNT * 4, 0, 128, stream);
#if defined(PROBE_P2VAR)
    launch_mega(p, 2, 3, grid, stream, 256 * PROBE_P2VAR + 2);
#elif defined(PROBE_P3PART)
#ifdef PROBE_P3VAR
    launch_mega(p, 3, 4, grid, stream, 256 + 8 * PROBE_P3PART + 2);
#else
    launch_mega(p, 3, 4, grid, stream, 8 * PROBE_P3PART + 2);
#endif
#else
    for (int k = PROBE_LO; k < PROBE_HI; ++k) launch_mega(p, k, k + 1, grid, stream, 2);
#endif
    if (PROBE_HI < NPHASE) launch_mega(p, PROBE_HI, NPHASE, grid, stream, 1);
    return;
#endif
    if (ONE_LAUNCH && fm == 0x3FFu) { launch_mega(p, 0, NPHASE, grid, stream); return; }
    for (int ph = 0; ph < NPHASE; ++ph) {
        if ((fm >> ph) & 1u) { launch_mega(p, ph, ph + 1, grid, stream); continue; }
        switch (ph) {
        case 0: nv_adaln<<<6144 / 256, 256, 0, stream>>>(p); if (fm & 0x1B4u) launch_mega(p, 0, 1, grid, stream); break;
        case 1: nv_hx<<<(M + MC) / 4, 256, 0, stream>>>(p); break;
        case 2: for (int mode = 0; mode < 6; ++mode) { FInProj fi{p, mode, D}; const dim3 g(D / 128, (mode == 5 ? MC : M) / 128, 1);
                    if (mode == 1 || mode == 4) nv_gemm<true, FInProj><<<g, 256, 0, stream>>>(fi); else nv_gemm<false, FInProj><<<g, 256, 0, stream>>>(fi); } break;
        case 3: nv_lru<<<NB * 2 * 16, 64, 0, stream>>>(p); nv_mix<<<(unsigned)((size_t)M * D / 256), 256, 0, stream>>>(p); break;
        case 4: { FMerge fm_{p, D, 0}; nv_gemm<true, FMerge><<<dim3(D / 128, M / 128, 1), 256, 0, stream>>>(fm_); } break;
        case 5: { FWo fw{p, D, 0}; nv_gemm<false, FWo><<<dim3(D / 128, M / 128, 1), 256, 0, stream>>>(fw); } break;
        case 6: nv_route<<<M / 4, 256, 0, stream>>>(p); break;
        case 7: { FMoe1 f1{p, D, 0}; nv_gemm<true, FMoe1><<<dim3(DE / 128, M / 128, NE), 256, 0, stream>>>(f1); } break;
        case 8: { FMoe2 f2{p, DE, 0}; nv_gemm<false, FMoe2><<<dim3(D / 128, M / 128, NE), 256, 0, stream>>>(f2); } break;
        case 9: nv_final<<<M / 4, 256, 0, stream>>>(p); break;
        }
    }
}
```
